# Optimizing an MI355X kernel written in HIP

```python
import math
import jax
import jax.numpy as jnp
from jax import lax
import numpy as np

D_MODEL = 1024
BATCH = 8
SEQ = 8192
DEPTH = 2

GRID_W = 64
CTX_LEN = 256

RWKV_HEAD = 64
RWKV_WIDTH = D_MODEL
RWKV_HEADS = RWKV_WIDTH // RWKV_HEAD
LORA_W = 64
LORA_A = 64
LORA_G = 160
GN_EPS = RWKV_HEAD * 1e-5

CONV_CH = D_MODEL
CONV_K = 31

PEER_HEADS = 8
PEER_NKEYS = 128
PEER_EXPERTS = PEER_NKEYS * PEER_NKEYS
PEER_QDIM = 256
PEER_HALF = PEER_QDIM // 2
PEER_TOPK = 16
PEER_CHUNK = 256

N_BRANCH = 2
NORM_EPS = 1e-6
LN_EPS = 1e-5

P_RWKV = 3 * RWKV_WIDTH + 2 * LORA_W + 2 * LORA_A + LORA_G
P_CONV = 2 * CONV_CH
P_GATE = N_BRANCH * D_MODEL
P_IN = P_RWKV + P_CONV + P_GATE
RWKV_SPLITS = (RWKV_WIDTH, 2 * RWKV_WIDTH, 3 * RWKV_WIDTH,
               3 * RWKV_WIDTH + LORA_W, 3 * RWKV_WIDTH + 2 * LORA_W,
               3 * RWKV_WIDTH + 2 * LORA_W + LORA_A, 3 * RWKV_WIDTH + 2 * LORA_W + 2 * LORA_A)

kernel_name = 'hybrid_rwkv7_conformer_peer_flow_block'


def rmsnorm(x, g):
    xf = x.astype(jnp.float32)
    y = xf * lax.rsqrt(jnp.mean(xf * xf, axis=-1, keepdims=True) + NORM_EPS)
    return (y * g.astype(jnp.float32)).astype(x.dtype)


def layernorm(x, g, b):
    xf = x.astype(jnp.float32)
    mu = jnp.mean(xf, axis=-1, keepdims=True)
    var = jnp.mean(jnp.square(xf - mu), axis=-1, keepdims=True)
    return ((xf - mu) * lax.rsqrt(var + LN_EPS) * g + b).astype(x.dtype)


def modulate(x, g, shift, scale):
    return rmsnorm(x, g) * (1 + scale) + shift


def token_shift(z, mu):
    zp = jnp.pad(z[:, :-1], ((0, 0), (1, 0), (0, 0)))
    zn = jnp.pad(z[:, 1:], ((0, 0), (0, 1), (0, 0)))
    return z + mu[0] * (zp - z) + mu[1] * (zn - z)


def rwkv_scan(decay, k, v, kk, a, r, s0, reverse):
    emit = r is not None
    seq = (decay, k, v, kk, a) + ((r,) if emit else ())
    xs = tuple(jnp.moveaxis(t.astype(jnp.float32), 1, 0) for t in seq)

    def step(S, inp):
        w_t, k_t, v_t, kk_t, a_t = inp[:5]
        sa = jnp.einsum('bhvk,bhk->bhv', S, kk_t)
        S = (S * w_t[:, :, None, :]
             - sa[..., None] * (kk_t * a_t)[:, :, None, :]
             + v_t[..., None] * k_t[:, :, None, :])
        y = jnp.einsum('bhvk,bhk->bhv', S, inp[5]) if emit else None
        return S, y

    S, ys = lax.scan(step, s0, xs, reverse=reverse)
    return S, (jnp.moveaxis(ys, 0, 1) if emit else None)


def rwkv_branch(zr, p, s0, emit):
    B, L, _ = zr.shape
    H, N = RWKV_HEADS, RWKV_HEAD
    r, k, v, w1f, w1b, a1f, a1b, g1 = jnp.split(zr, RWKV_SPLITS, axis=-1)
    heads = lambda t: t.reshape(B, L, H, N)
    kkr = heads(k * p['k_k']).astype(jnp.float32)
    kk = kkr / jnp.maximum(jnp.sqrt(jnp.sum(kkr * kkr, axis=-1, keepdims=True)), 1e-12)
    states, outs, bonus = [], [], []
    for d, (w1d, a1d) in enumerate(((w1f, a1f), (w1b, a1b))):
        wlog = -jax.nn.softplus(-(p['w0'][d] + jnp.tanh(w1d) @ p['w2'][d])) - 0.5
        decay = jnp.exp(-jnp.exp(wlog.astype(jnp.float32)))
        a = jax.nn.sigmoid(a1d @ p['a2'][d] + p['a0'][d])
        kd = k * (1 + (a - 1) * p['k_a'])
        S, y = rwkv_scan(heads(decay), heads(kd), heads(v), kk, heads(a),
                         heads(r) if emit else None, s0[d], reverse=(d == 1))
        states.append(S)
        if emit:
            outs.append(y)
            bonus.append(jnp.sum(heads(r * kd) * p['r_k'], axis=-1, keepdims=True))
    if not emit:
        return None, (states[0], states[1])
    o = outs[0] + outs[1]
    mu = jnp.mean(o, axis=-1, keepdims=True)
    var = jnp.mean(jnp.square(o - mu), axis=-1, keepdims=True)
    o = ((o - mu) * lax.rsqrt(var + GN_EPS)).reshape(B, L, RWKV_WIDTH) * p['lnx_g'] + p['lnx_b']
    o = o + ((bonus[0] + bonus[1]).astype(jnp.float32) * heads(v).astype(jnp.float32)).reshape(B, L, RWKV_WIDTH)
    g = jax.nn.sigmoid(g1) @ p['g2']
    y = (o.astype(zr.dtype) * g) @ p['w_oA']
    return y, (states[0], states[1])


def conv_branch(zc, p, rows):
    B, L, _ = zc.shape
    u = zc[..., :CONV_CH] * jax.nn.sigmoid(zc[..., CONV_CH:])
    img = u.reshape(B, rows, GRID_W, CONV_CH) if rows is not None else u[:, :, None, :]
    rhs = p['conv_w'][:, None, None, :].astype(img.dtype)
    out = lax.conv_general_dilated(img, rhs, window_strides=(1, 1),
                                   padding=((CONV_K // 2, CONV_K // 2), (0, 0)),
                                   dimension_numbers=('NHWC', 'HWIO', 'NHWC'),
                                   feature_group_count=CONV_CH)
    out = layernorm(out.reshape(B, L, CONV_CH), p['cnorm_g'], p['cnorm_b'])
    return jax.nn.silu(out) @ p['w_oB']


def token_mixer(h, p, rows, s0, emit):
    w_in = p['w_in'] if emit else p['w_in'][:, :P_RWKV]
    z = h @ w_in
    zr = token_shift(z[..., :P_RWKV], p['shift_mu'])
    y_a, states = rwkv_branch(zr, p, s0, emit)
    if not emit:
        return None, states
    y_b = conv_branch(z[..., P_RWKV:P_RWKV + P_CONV], p, rows)
    gates = jax.nn.sigmoid(z[..., P_RWKV + P_CONV:] + p['gate_b'])
    m = gates[..., :D_MODEL] * y_a + gates[..., D_MODEL:] * y_b
    return m @ p['w_out'], states


def peer(h, p):
    B, L, D = h.shape
    T = B * L
    chunk = math.gcd(T, PEER_CHUNK)
    hb = h.reshape(T // chunk, chunk, D)

    def block(hc):
        q = (hc @ p['w_q']).reshape(chunk, PEER_HEADS, 2, PEER_HALF)
        s = jnp.einsum('thcd,hcnd->thcn', q, p['sub_keys']).astype(jnp.float32)
        s1, i1 = lax.top_k(s[:, :, 0], PEER_TOPK)
        s2, i2 = lax.top_k(s[:, :, 1], PEER_TOPK)
        cand = (s1[..., :, None] + s2[..., None, :]).reshape(chunk, PEER_HEADS, PEER_TOPK * PEER_TOPK)
        cidx = (i1[..., :, None] * PEER_NKEYS + i2[..., None, :]).reshape(chunk, PEER_HEADS, PEER_TOPK * PEER_TOPK)
        best, pos = lax.top_k(cand, PEER_TOPK)
        eidx = jnp.take_along_axis(cidx, pos, axis=-1)
        gw = jax.nn.softmax(best, axis=-1)
        u = jnp.take(p['peer_u'], eidx, axis=0)
        act = jax.nn.gelu(jnp.einsum('td,thkd->thk', hc, u).astype(jnp.float32), approximate=False) * gw
        v = jnp.take(p['peer_v'], eidx, axis=0)
        return jnp.einsum('thk,thkd->td', act.astype(hc.dtype), v)

    return lax.map(block, hb).reshape(B, L, D)


def setup_inputs(seed: int = 0) -> dict:
    key = jax.random.key(seed)
    ks = jax.random.split(key, 40)
    f32 = jnp.float32
    nrm = lambda k, shape, s: jax.random.normal(k, shape, f32) * s
    Ly, D, W, H = DEPTH, D_MODEL, RWKV_WIDTH, RWKV_HEADS
    return {
        'x': nrm(ks[0], (BATCH, SEQ, D), 1.0),
        'c': nrm(ks[1], (BATCH, D), 1.0),
        'ctx': nrm(ks[2], (BATCH, CTX_LEN, D), 1.0),
        'c_ctx': nrm(ks[3], (D,), 1.0),
        'ada_w': nrm(ks[4], (Ly, D, 6 * D), 0.5 * D ** -0.5),
        'ada_b': nrm(ks[5], (Ly, 6 * D), 0.02),
        'norm1_g': 1.0 + nrm(ks[6], (Ly, D), 0.02),
        'norm2_g': 1.0 + nrm(ks[7], (Ly, D), 0.02),
        'w_in': nrm(ks[8], (Ly, D, P_IN), D ** -0.5),
        'shift_mu': jax.random.uniform(ks[9], (Ly, 2, P_RWKV), f32, 0.0, 0.5),
        'w0': jax.random.uniform(ks[10], (Ly, 2, W), f32, -6.0, 1.0),
        'w2': nrm(ks[11], (Ly, 2, LORA_W, W), 0.5 * LORA_W ** -0.5),
        'a0': nrm(ks[12], (Ly, 2, W), 0.5),
        'a2': nrm(ks[13], (Ly, 2, LORA_A, W), 0.5 * LORA_A ** -0.5),
        'g2': nrm(ks[14], (Ly, LORA_G, W), LORA_G ** -0.5),
        'k_k': 0.85 + nrm(ks[15], (Ly, W), 0.05),
        'k_a': 1.0 + nrm(ks[16], (Ly, W), 0.05),
        'r_k': nrm(ks[17], (Ly, H, RWKV_HEAD), 0.1),
        'lnx_g': 1.0 + nrm(ks[18], (Ly, W), 0.02),
        'lnx_b': nrm(ks[19], (Ly, W), 0.02),
        'w_oA': nrm(ks[20], (Ly, W, D), W ** -0.5),
        'conv_w': nrm(ks[21], (Ly, CONV_K, CONV_CH), CONV_K ** -0.5),
        'cnorm_g': 1.0 + nrm(ks[22], (Ly, CONV_CH), 0.02),
        'cnorm_b': nrm(ks[23], (Ly, CONV_CH), 0.02),
        'w_oB': nrm(ks[24], (Ly, CONV_CH, D), CONV_CH ** -0.5),
        'gate_b': nrm(ks[25], (Ly, P_GATE), 0.02),
        'w_out': nrm(ks[26], (Ly, D, D), D ** -0.5),
        'w_q': nrm(ks[27], (Ly, D, PEER_HEADS * PEER_QDIM), D ** -0.5),
        'sub_keys': nrm(ks[28], (Ly, PEER_HEADS, 2, PEER_NKEYS, PEER_HALF), PEER_HALF ** -0.5),
        'peer_u': nrm(ks[29], (Ly, PEER_EXPERTS, D), D ** -0.5),
        'peer_v': nrm(ks[30], (Ly, PEER_EXPERTS, D), 0.5),
        'final_g': 1.0 + nrm(ks[31], (D,), 0.02),
    }


def reference(x, c, ctx, c_ctx, ada_w, ada_b, norm1_g, norm2_g, w_in, shift_mu, w0, w2, a0, a2, g2,
              k_k, k_a, r_k, lnx_g, lnx_b, w_oA, conv_w, cnorm_g, cnorm_b, w_oB, gate_b, w_out,
              w_q, sub_keys, peer_u, peer_v, final_g):
    B = x.shape[0]
    rows = x.shape[1] // GRID_W
    xc = ctx
    zero_state = jnp.zeros((B, RWKV_HEADS, RWKV_HEAD, RWKV_HEAD), jnp.float32)
    for l in range(DEPTH):
        last = l == DEPTH - 1
        p = dict(w_in=w_in[l], shift_mu=shift_mu[l], w0=w0[l], w2=w2[l], a0=a0[l], a2=a2[l],
                 g2=g2[l], k_k=k_k[l], k_a=k_a[l], r_k=r_k[l], lnx_g=lnx_g[l], lnx_b=lnx_b[l],
                 w_oA=w_oA[l], conv_w=conv_w[l], cnorm_g=cnorm_g[l], cnorm_b=cnorm_b[l],
                 w_oB=w_oB[l], gate_b=gate_b[l], w_out=w_out[l], w_q=w_q[l],
                 sub_keys=sub_keys[l], peer_u=peer_u[l], peer_v=peer_v[l])
        mod = jax.nn.silu(c) @ ada_w[l] + ada_b[l]
        sh1, sc1, gt1, sh2, sc2, gt2 = jnp.split(mod[:, None, :], 6, axis=-1)
        modc = jax.nn.silu(c_ctx) @ ada_w[l] + ada_b[l]
        csh1, csc1, cgt1, csh2, csc2, cgt2 = jnp.split(modc, 6, axis=-1)

        hc = modulate(xc, norm1_g[l], csh1, csc1)
        yc, ctx_states = token_mixer(hc, p, None, (zero_state, zero_state), emit=not last)

        h = modulate(x, norm1_g[l], sh1, sc1)
        y, _ = token_mixer(h, p, rows, ctx_states, emit=True)
        x = x + gt1 * y
        x = x + gt2 * peer(modulate(x, norm2_g[l], sh2, sc2), p)

        if not last:
            xc = xc + cgt1 * yc
            xc = xc + cgt2 * peer(modulate(xc, norm2_g[l], csh2, csc2), p)
    return rmsnorm(x, final_g)
```

```cpp
#include <hip/hip_runtime.h>
#include <cstdio>

#define LAS __attribute__((address_space(3)))
typedef unsigned short bf16_t;
typedef short bf16x8 __attribute__((ext_vector_type(8)));
typedef float f32x4 __attribute__((ext_vector_type(4)));
typedef float f32x2 __attribute__((ext_vector_type(2)));
typedef unsigned u32x4 __attribute__((ext_vector_type(4)));
typedef unsigned u32x2 __attribute__((ext_vector_type(2)));
typedef __bf16 bf2_t __attribute__((ext_vector_type(2)));

#ifndef DIAG_SITE
#define DIAG_SITE -1
#endif
#define SITE(id) (DIAG_SITE < 0 || DIAG_SITE == (id))
#ifndef ABL
#define ABL 0
#endif
#ifndef PROBE_HI
#define PROBE_HI 0
#endif
#ifndef PROBE_OFF
#define PROBE_OFF (720ull << 20)
#endif
#ifndef PROBE_LD
#define PROBE_LD 1024
#endif
#ifndef ONE_LAUNCH
#define ONE_LAUNCH 1
#endif

constexpr int D = 1024, NB = 8, SEQ = 8192, CTXL = 256;
constexpr int M_LAT = NB * SEQ, M_CTX = NB * CTXL, M = M_LAT + M_CTX;
constexpr int P_RWKV = 3488, NZR = 3584, P_IN = 7584;
constexpr int C_K = 1024, C_V = 2048, C_W1 = 3072, C_A1 = 3200, C_G1 = 3328;
constexpr int NPH = 27;
constexpr size_t MiB = 1u << 20;
constexpr size_t WS_CTL = 0, CTL_BYTES = 1 * MiB;
constexpr size_t WS_MOD = 1 * MiB;
constexpr size_t WS_XCTX = 2 * MiB;
constexpr size_t WS_WB = 10 * MiB, WB_LAYER = 26 * MiB;
constexpr size_t WB_WR = 0, WB_WC = 7 * MiB, WB_WG = 11 * MiB, WB_OA = 15 * MiB, WB_OB = 17 * MiB, WB_OUT = 19 * MiB, WB_Q = 21 * MiB, WB_G2 = 25 * MiB, WB_SK = 25 * MiB + 512 * 1024;
constexpr size_t WS_PT = 62 * MiB;
constexpr size_t WS_H = 126 * MiB;
constexpr size_t WS_Z = 258 * MiB;
constexpr size_t WS_YF = 720 * MiB, WS_YB = 852 * MiB;
constexpr size_t WS_BON = 984 * MiB;
constexpr size_t WS_END = 1024 * MiB;
constexpr int CW_BAR = 4096;
constexpr int LDS_BYTES = 147456;
constexpr int MISC_OFF = 131072 + 320;

__device__ __forceinline__ unsigned pk_bf16(float lo, float hi) { bf2_t v; v.x = (__bf16)lo; v.y = (__bf16)hi; return __builtin_bit_cast(unsigned, v); }
__device__ __forceinline__ float bf_lo(unsigned u) { return __uint_as_float(u << 16); }
__device__ __forceinline__ float bf_hi(unsigned u) { return __uint_as_float(u & 0xffff0000u); }
__device__ __forceinline__ float sigm(float x) { return __builtin_amdgcn_rcpf(1.0f + __expf(-x)); }
template <int CTRL> __device__ __forceinline__ float dpp_f(float x) { return __builtin_bit_cast(float, __builtin_amdgcn_update_dpp(0, __builtin_bit_cast(int, x), CTRL, 0xf, 0xf, true)); }
__device__ __forceinline__ float red16(float s) { s += dpp_f<0xB1>(s); s += dpp_f<0x4E>(s); s += dpp_f<0x141>(s); s += dpp_f<0x140>(s); return s; }
__device__ __forceinline__ int shxi(int v, int mask, int lane) { return __builtin_amdgcn_ds_bpermute((lane ^ mask) << 2, v); }
__device__ __forceinline__ float shxf(float v, int mask, int lane) { return __builtin_bit_cast(float, __builtin_amdgcn_ds_bpermute((lane ^ mask) << 2, __builtin_bit_cast(int, v))); }
__device__ __forceinline__ float wave_sum(float v, int lane) { v = red16(v); v += shxf(v, 16, lane); v += shxf(v, 32, lane); return v; }
__device__ __forceinline__ float dot2bf(unsigned a, unsigned b, float acc) { return __builtin_amdgcn_fdot2_f32_bf16(__builtin_bit_cast(bf2_t, a), __builtin_bit_cast(bf2_t, b), acc, false); }
__device__ __forceinline__ float dot8bf(u32x4 a, u32x4 b, float acc) {
    const unsigned a0 = a[0], a1 = a[1], a2 = a[2], a3 = a[3], b0 = b[0], b1 = b[1], b2 = b[2], b3 = b[3];
    acc = dot2bf(a0, b0, acc); acc = dot2bf(a1, b1, acc); acc = dot2bf(a2, b2, acc); acc = dot2bf(a3, b3, acc);
    return acc;
}
__device__ __forceinline__ float gelu_erf(float v) {
    const float av = fabsf(v), t = __builtin_amdgcn_rcpf(av * 0.2316418882f + 1.0f);
    float q = t * 0.5307027145f + (-0.7265760135f); q = q * t + 0.7107068705f; q = q * t + (-0.142248368f); q = q * t + 0.127414796f; q = q * t;
    const float e = __builtin_amdgcn_exp2f((v * v) * (-0.72134752044f));
    const float m = v * (q * e);
    return v < 0.f ? m : v - m;
}
#define LDS_WAIT() asm volatile("s_waitcnt lgkmcnt(0)" ::: "memory")

#define XB_TMO      128
#define XB_XCNT(j)  (256  + 64 * (j))
#define XB_XSUB(j)  (1280 + 64 * (j))
#define XB_XGEN(j)  (2304 + 64 * (j))
#define XB_TOP      3328
#define XB_TOPGEN   3392
#define XCD_BAR_WORDS 3456
#define XB_SPIN_CAP (1u << 18)
__device__ __forceinline__ unsigned xb_ld(unsigned* p)              { return __hip_atomic_load(p, __ATOMIC_RELAXED, __HIP_MEMORY_SCOPE_AGENT); }
__device__ __forceinline__ unsigned xb_add(unsigned* p, unsigned v) { return __hip_atomic_fetch_add(p, v, __ATOMIC_RELAXED, __HIP_MEMORY_SCOPE_AGENT); }
__device__ __forceinline__ unsigned xb_xcc_id() { return (unsigned)__builtin_amdgcn_s_getreg((3 << 11) | 20) & 0xFu; }
#define XB_SPIN(cond, bar) do { unsigned _sp = 0; while (cond) { __builtin_amdgcn_s_sleep(1); \
    if ((++_sp & 255u) == 0u) { if (xb_ld(&(bar)[XB_TMO])) break; if (_sp > XB_SPIN_CAP) { atomicAdd(&(bar)[XB_TMO], 1u); break; } } } } while (0)
struct XcdBarrier { unsigned* bar; unsigned x; volatile LAS unsigned* st; };
__device__ __forceinline__ XcdBarrier xcd_barrier_post(unsigned* bar, volatile LAS unsigned* st) {
    XcdBarrier b; b.bar = bar; b.x = xb_xcc_id(); b.st = st;
    if (threadIdx.x == 0) (void)xb_add(&bar[XB_XCNT(b.x)], 1u);
    return b;
}
__device__ __forceinline__ void xcd_barrier_complete(unsigned* bar, unsigned x, unsigned& nloc, unsigned& nx) {
    const unsigned G = gridDim.x * gridDim.y * gridDim.z;
    unsigned sum, cnt, mine, sp = 0u;
    for (;;) {
        sum = 0u; cnt = 0u; mine = 0u;
#pragma unroll
        for (unsigned j = 0; j < 16; ++j) { const unsigned c = xb_ld(&bar[XB_XCNT(j)]); sum += c; cnt += (c > 0u) ? 1u : 0u; mine = (j == x) ? c : mine; }
        if (sum == G) break;
        __builtin_amdgcn_s_sleep(1);
        if ((++sp & 255u) == 0u) { if (xb_ld(&bar[XB_TMO])) break; if (sp > XB_SPIN_CAP) { atomicAdd(&bar[XB_TMO], 1u); break; } }
    }
    nloc = mine > 0u ? mine : 1u; nx = cnt > 0u ? cnt : 1u;
}
__device__ __forceinline__ void xcd_barrier(const XcdBarrier& b) {
    asm volatile("s_waitcnt vmcnt(0)" ::: "memory");
    __syncthreads();
    if (threadIdx.x == 0) {
        unsigned* bar = b.bar;
        __builtin_amdgcn_s_waitcnt(0);
        unsigned nloc = b.st[0], nx = b.st[1];
        if (nloc == 0u) { xcd_barrier_complete(bar, b.x, nloc, nx); b.st[0] = nloc; b.st[1] = nx; }
        const unsigned old = xb_add(&bar[XB_XSUB(b.x)], 1u);
        const unsigned gen = old / nloc;
        if (old + 1u == (gen + 1u) * nloc) {
            __builtin_amdgcn_fence(__ATOMIC_RELEASE, "agent");
            asm volatile("s_waitcnt vmcnt(0)" ::: "memory");
            const unsigned og = xb_add(&bar[XB_TOP], 1u);
            const unsigned tg = og / nx;
            if (og + 1u == (tg + 1u) * nx) xb_add(&bar[XB_TOPGEN], 1u);
            else XB_SPIN(xb_ld(&bar[XB_TOPGEN]) == tg, bar);
            __builtin_amdgcn_fence(__ATOMIC_ACQUIRE, "agent");
            xb_add(&bar[XB_XGEN(b.x)], 1u);
            asm volatile("s_waitcnt vmcnt(0)" ::: "memory");
        } else {
            XB_SPIN(xb_ld(&bar[XB_XGEN(b.x)]) == gen, bar);
            __builtin_amdgcn_fence(__ATOMIC_ACQUIRE, "agent");
            asm volatile("s_waitcnt vmcnt(0)" ::: "memory");
        }
    }
    __syncthreads();
}

namespace pg8 {
constexpr int BM = 256, BK = 64, HALF = 128, HTB = HALF * BK * 2, STAGE_BYTES = 8 * HTB, NXCD = 8, WGM = 8;
__host__ __device__ __forceinline__ int lds_byte(int r, int c) { const int st = (r >> 4) * 2 + (c >> 5), rr = r & 15, cc = c & 31, ob = rr * 64 + cc * 2; return st * 1024 + (ob ^ (((ob >> 9) & 1) << 5)); }
__host__ __device__ __forceinline__ void stage_rc(int b, int& R, int& C) { const int st = b / 1024, sb = b % 1024, swz = sb ^ (((sb >> 9) & 1) << 5); R = (st >> 1) * 16 + swz / 64; C = (st & 1) * 32 + (swz % 64) / 2; }
__host__ __device__ __forceinline__ int perm32(int rho) { const int n = rho >> 4, i = rho & 15; return 8 * (i >> 2) + 4 * n + (i & 3); }
struct Unit { int pm, pn; };
struct Gemm { const bf16_t* A; const bf16_t* Bt; int M, N, K; };
struct StaticOrder {
    int nM, nN, nwg, G, c;
    __host__ __device__ void init(int M_, int N_, int G_, int c_) { nM = M_ / BM; nN = N_ / BM; nwg = nM * nN; G = G_; c = c_; }
    __host__ __device__ bool next(int i, Unit& u) const {
        const long L = (long)i * G + c; if (L >= nwg) return false;
        int wgid = (int)L; { const int q = nwg / NXCD, r = nwg % NXCD, xcd = wgid % NXCD, off = wgid / NXCD; wgid = (xcd < r ? xcd * (q + 1) : r * (q + 1) + (xcd - r) * q) + off; }
        const int nig = WGM * nN, gid = wgid / nig, fm = gid * WGM, gsz = (nM - fm) < WGM ? (nM - fm) : WGM;
        u.pm = fm + ((wgid % nig) % gsz); u.pn = (wgid % nig) / gsz; return true;
    }
    __device__ __forceinline__ void a_ready(const Unit&) const {}
    __device__ __forceinline__ void done(const Unit&) const {}
};
template <class Epi, class Sched>
__device__ __forceinline__ void gemm_phase(LAS unsigned char* lds, const Gemm g, const Sched& S, const Epi& E, const int tid) {
    const int wid = __builtin_amdgcn_readfirstlane(tid >> 6), lane = tid & 63, wr = wid >> 2, wc = wid & 3, fr = lane & 15, fq = lane >> 4;
    const int K = g.K, nt = K / BK;
    unsigned voffA[2], voffB[2];
#pragma unroll
    for (int i = 0; i < 2; ++i) { int R, C; stage_rc(tid * 16 + i * 8192, R, C); const int Rb = Epi::PERM ? ((R & ~31) + perm32(R & 31)) : R;
        voffA[i] = (unsigned)(R * K + C) * 2u; voffB[i] = (unsigned)(Rb * K + C) * 2u; }
    const size_t kstep = (size_t)(BK * 2);
    const size_t hstep = (size_t)HALF * K * 2;
    const size_t tstep = 2 * hstep;
    const unsigned ldsw = (unsigned)wid * 1024u;
    const int aoff = lds_byte(wr * 64 + fr, fq * 8), boff = lds_byte(wc * 32 + fr, fq * 8);
#define PG8_SA(b, h) (((b) * 2 + (h)) * HTB)
#define PG8_SB(b, h) ((4 + (b) * 2 + (h)) * HTB)
#define PG8_STAGE(bufoff, gbase, voff) do { _Pragma("unroll") for (int _i = 0; _i < 2; ++_i) \
        __builtin_amdgcn_global_load_lds((const unsigned*)((const char*)(gbase) + (voff)[_i]), (LAS unsigned*)(lds + (bufoff) + ldsw + _i * 8192), 16, 0, 0); } while (0)
#define PG8_LDA(dst, b, h) do { _Pragma("unroll") for (int m = 0; m < 4; ++m) _Pragma("unroll") for (int k = 0; k < 2; ++k) dst[m][k] = *(const LAS bf16x8*)(lds + PG8_SA(b, h) + aoff + m * 2048 + k * 1024); } while (0)
#define PG8_LDB(dst, b, h) do { _Pragma("unroll") for (int n = 0; n < 2; ++n) _Pragma("unroll") for (int k = 0; k < 2; ++k) dst[n][k] = *(const LAS bf16x8*)(lds + PG8_SB(b, h) + boff + n * 2048 + k * 1024); } while (0)
#define PG8_MMA(ai, bj, At, Bt) do { __builtin_amdgcn_s_setprio(1); _Pragma("unroll") for (int m = 0; m < 4; ++m) _Pragma("unroll") for (int n = 0; n < 2; ++n) _Pragma("unroll") for (int k = 0; k < 2; ++k) \
        acc[ai][bj][m][n] = __builtin_amdgcn_mfma_f32_16x16x32_bf16(Bt[n][k], At[m][k], acc[ai][bj][m][n], 0, 0, 0); __builtin_amdgcn_s_setprio(0); } while (0)
#define PG8_WAIT_V(n) asm volatile("s_waitcnt vmcnt(" #n ")" ::: "memory")
#define PG8_WAIT_L(n) asm volatile("s_waitcnt lgkmcnt(" #n ")" ::: "memory")
#define PG8_BAR __builtin_amdgcn_s_barrier()
#define PG8_SCHED __builtin_amdgcn_sched_barrier(0)
    Unit cur, nxt; int ui = 0;
    if (!S.next(0, cur)) return;
    f32x4 acc[2][2][4][2];
#pragma unroll
    for (int a = 0; a < 2; ++a)
#pragma unroll
        for (int b = 0; b < 2; ++b)
#pragma unroll
            for (int m = 0; m < 4; ++m)
#pragma unroll
                for (int n = 0; n < 2; ++n) acc[a][b][m][n] = (f32x4){0.f, 0.f, 0.f, 0.f};
    bf16x8 At[4][2], B0[2][2], B1[2][2];
    const char* cA = (const char*)g.A + (size_t)cur.pm * tstep; const char* cB = (const char*)g.Bt + (size_t)cur.pn * tstep;
    S.a_ready(cur);
    PG8_STAGE(PG8_SB(0, 0), cB, voffB); PG8_STAGE(PG8_SA(0, 0), cA, voffA); PG8_STAGE(PG8_SB(0, 1), cB + hstep, voffB); PG8_STAGE(PG8_SA(0, 1), cA + hstep, voffA);
    if (wr == 1) PG8_BAR;
    PG8_WAIT_V(4); PG8_BAR;
    PG8_STAGE(PG8_SB(1, 0), cB + kstep, voffB); PG8_STAGE(PG8_SA(1, 0), cA + kstep, voffA); PG8_STAGE(PG8_SB(1, 1), cB + hstep + kstep, voffB);
    PG8_WAIT_V(6); PG8_BAR;
    for (;;) {
        const bool has_next = S.next(ui + 1, nxt);
        const char* nA = has_next ? (const char*)g.A + (size_t)nxt.pm * tstep : cA; const char* nB = has_next ? (const char*)g.Bt + (size_t)nxt.pn * tstep : cB;
        for (int t = 0; t < nt; t += 2) {
            const bool last = (t == nt - 2);
            const char* a1 = cA + (size_t)(t + 1) * kstep;
            const char* a2 = last ? nA : cA + (size_t)(t + 2) * kstep; const char* b2 = last ? nB : cB + (size_t)(t + 2) * kstep;
            const char* a3 = a2 + kstep; const char* b3 = b2 + kstep;
            if (last && has_next) S.a_ready(nxt);
            PG8_LDB(B0, 0, 0); PG8_SCHED; PG8_LDA(At, 0, 0); PG8_STAGE(PG8_SA(1, 1), a1 + hstep, voffA);
            PG8_WAIT_L(8); PG8_BAR; PG8_WAIT_L(0); PG8_MMA(0, 0, At, B0); PG8_BAR; PG8_SCHED;
            PG8_LDB(B1, 0, 1); PG8_STAGE(PG8_SB(0, 0), b2, voffB);
            PG8_BAR; PG8_WAIT_L(0); PG8_MMA(0, 1, At, B1); PG8_BAR;
            PG8_LDA(At, 0, 1); PG8_STAGE(PG8_SA(0, 0), a2, voffA);
            PG8_BAR; PG8_WAIT_L(0); PG8_MMA(1, 0, At, B0); PG8_BAR; PG8_SCHED;
            PG8_STAGE(PG8_SB(0, 1), b2 + hstep, voffB);
            PG8_WAIT_V(6); PG8_BAR; PG8_MMA(1, 1, At, B1); PG8_BAR;
            PG8_LDB(B0, 1, 0); PG8_SCHED; PG8_LDA(At, 1, 0); PG8_STAGE(PG8_SA(0, 1), a2 + hstep, voffA);
            PG8_WAIT_L(8); PG8_BAR; PG8_WAIT_L(0); PG8_MMA(0, 0, At, B0); PG8_BAR; PG8_SCHED;
            PG8_LDB(B1, 1, 1); PG8_STAGE(PG8_SB(1, 0), b3, voffB);
            PG8_BAR; PG8_WAIT_L(0); PG8_MMA(0, 1, At, B1); PG8_BAR;
            PG8_LDA(At, 1, 1); PG8_STAGE(PG8_SA(1, 0), a3, voffA);
            PG8_BAR; PG8_WAIT_L(0); PG8_MMA(1, 0, At, B0); PG8_BAR; PG8_SCHED;
            PG8_STAGE(PG8_SB(1, 1), b3 + hstep, voffB);
            PG8_WAIT_V(6); PG8_BAR; PG8_MMA(1, 1, At, B1); PG8_BAR;
        }
        E(acc, cur, wr, wc, fr, fq); S.done(cur);
        if (!has_next) break;
#pragma unroll
        for (int a = 0; a < 2; ++a)
#pragma unroll
            for (int b = 0; b < 2; ++b)
#pragma unroll
                for (int m = 0; m < 4; ++m)
#pragma unroll
                    for (int n = 0; n < 2; ++n) acc[a][b][m][n] = (f32x4){0.f, 0.f, 0.f, 0.f};
        cur = nxt; cA = nA; cB = nB; ++ui;
    }
    PG8_WAIT_V(0);
    if (wr == 0) PG8_BAR;
    PG8_BAR;
#undef PG8_SA
#undef PG8_SB
#undef PG8_STAGE
#undef PG8_LDA
#undef PG8_LDB
#undef PG8_MMA
#undef PG8_WAIT_V
#undef PG8_WAIT_L
#undef PG8_BAR
#undef PG8_SCHED
}
}
typedef pg8::Unit Unit;
typedef const f32x4 (&AccRef)[2][2][4][2];

__device__ __forceinline__ u32x4 pack8(const f32x4 v0, const f32x4 v1) { u32x4 w; w.x = pk_bf16(v0[0], v0[1]); w.y = pk_bf16(v0[2], v0[3]); w.z = pk_bf16(v1[0], v1[1]); w.w = pk_bf16(v1[2], v1[3]); return w; }
__device__ __forceinline__ void unpack8(const u32x4 w, f32x4& v0, f32x4& v1) { v0 = (f32x4){bf_lo(w.x), bf_hi(w.x), bf_lo(w.y), bf_hi(w.y)}; v1 = (f32x4){bf_lo(w.z), bf_hi(w.z), bf_lo(w.w), bf_hi(w.w)}; }

struct EpiStoreBf16 {
    static constexpr bool PERM = true;
    bf16_t* O; int ldc;
    __device__ __forceinline__ void operator()(AccRef acc, const Unit& u, int wr, int wc, int fr, int fq) const {
        const int row0 = u.pm * 256 + wr * 64 + fr, col0 = u.pn * 256 + wc * 32 + 8 * fq;
#pragma unroll
        for (int ai = 0; ai < 2; ++ai)
#pragma unroll
            for (int m = 0; m < 4; ++m) { bf16_t* rowp = O + (size_t)(row0 + ai * 128 + m * 16) * ldc + col0;
#pragma unroll
                for (int bj = 0; bj < 2; ++bj) *(u32x4*)(rowp + bj * 128) = pack8(acc[ai][bj][m][0], acc[ai][bj][m][1]); }
    }
};
struct EpiGlu {
    static constexpr bool PERM = true;
    bf16_t* U;
    __device__ __forceinline__ void operator()(AccRef acc, const Unit& u, int wr, int wc, int fr, int fq) const {
        const int row0 = u.pm * 256 + wr * 64 + fr, col0 = u.pn * 128 + wc * 32 + 8 * fq;
#pragma unroll
        for (int ai = 0; ai < 2; ++ai)
#pragma unroll
            for (int m = 0; m < 4; ++m) { f32x4 v0, v1;
#pragma unroll
                for (int j = 0; j < 4; ++j) { v0[j] = acc[ai][0][m][0][j] * sigm(acc[ai][1][m][0][j]); v1[j] = acc[ai][0][m][1][j] * sigm(acc[ai][1][m][1][j]); }
                *(u32x4*)(U + (size_t)(row0 + ai * 128 + m * 16) * 1024 + col0) = pack8(v0, v1); }
    }
};
struct EpiGate {
    static constexpr bool PERM = true;
    bf16_t* G; const float* gb;
    __device__ __forceinline__ void operator()(AccRef acc, const Unit& u, int wr, int wc, int fr, int fq) const {
        const int row0 = u.pm * 256 + wr * 64 + fr, col0 = u.pn * 256 + wc * 32 + 8 * fq;
        f32x4 bv[2][2];
#pragma unroll
        for (int bj = 0; bj < 2; ++bj)
#pragma unroll
            for (int n = 0; n < 2; ++n) bv[bj][n] = *(const f32x4*)(gb + col0 + bj * 128 + 4 * n);
#pragma unroll
        for (int ai = 0; ai < 2; ++ai)
#pragma unroll
            for (int m = 0; m < 4; ++m) { bf16_t* rowp = G + (size_t)(row0 + ai * 128 + m * 16) * 2048 + col0;
#pragma unroll
                for (int bj = 0; bj < 2; ++bj) { f32x4 v0 = acc[ai][bj][m][0] + bv[bj][0], v1 = acc[ai][bj][m][1] + bv[bj][1];
#pragma unroll
                    for (int j = 0; j < 4; ++j) { v0[j] = sigm(v0[j]); v1[j] = sigm(v1[j]); }
                    *(u32x4*)(rowp + bj * 128) = pack8(v0, v1); } }
    }
};
struct EpiMulInplace {
    static constexpr bool PERM = true;
    bf16_t* O;
    __device__ __forceinline__ void operator()(AccRef acc, const Unit& u, int wr, int wc, int fr, int fq) const {
        const int row0 = u.pm * 256 + wr * 64 + fr, col0 = u.pn * 256 + wc * 32 + 8 * fq;
#pragma unroll
        for (int ai = 0; ai < 2; ++ai)
#pragma unroll
            for (int m = 0; m < 4; ++m) { bf16_t* rowp = O + (size_t)(row0 + ai * 128 + m * 16) * 1024 + col0;
#pragma unroll
                for (int bj = 0; bj < 2; ++bj) { f32x4 o0, o1; unpack8(*(const u32x4*)(rowp + bj * 128), o0, o1);
                    *(u32x4*)(rowp + bj * 128) = pack8(o0 * acc[ai][bj][m][0], o1 * acc[ai][bj][m][1]); }
                asm volatile("" ::: "memory"); }
    }
};
template <bool ADD> struct EpiGateMul {
    static constexpr bool PERM = true;
    bf16_t* Mb; const bf16_t* G; int goff;
    __device__ __forceinline__ void operator()(AccRef acc, const Unit& u, int wr, int wc, int fr, int fq) const {
        const int row0 = u.pm * 256 + wr * 64 + fr, col0 = u.pn * 256 + wc * 32 + 8 * fq;
#pragma unroll
        for (int ai = 0; ai < 2; ++ai)
#pragma unroll
            for (int m = 0; m < 4; ++m) { const size_t row = (size_t)(row0 + ai * 128 + m * 16); bf16_t* rowp = Mb + row * 1024 + col0; const bf16_t* gp = G + row * 2048 + goff + col0;
#pragma unroll
                for (int bj = 0; bj < 2; ++bj) { f32x4 g0, g1; unpack8(*(const u32x4*)(gp + bj * 128), g0, g1);
                    f32x4 v0 = g0 * acc[ai][bj][m][0], v1 = g1 * acc[ai][bj][m][1];
                    if ((!ADD && (ABL & 4)) || (ADD && (ABL & 8))) { v0 = (f32x4){0.f, 0.f, 0.f, 0.f}; v1 = v0; }
                    if (ADD) { f32x4 p0, p1; unpack8(*(const u32x4*)(rowp + bj * 128), p0, p1); v0 += p0; v1 += p1; }
                    *(u32x4*)(rowp + bj * 128) = pack8(v0, v1); }
                asm volatile("" ::: "memory"); }
    }
};
struct EpiResid {
    static constexpr bool PERM = false;
    const float* xin_lat; const float* xin_ctx; float* xout_lat; float* xout_ctx; const float* gt;
    __device__ __forceinline__ void operator()(AccRef acc, const Unit& u, int wr, int wc, int fr, int fq) const {
        const bool lat = u.pm < 256; const int bi = lat ? (u.pm >> 5) : 8;
        const float* xin = lat ? xin_lat + (size_t)u.pm * 256 * 1024 : xin_ctx + (size_t)(u.pm - 256) * 256 * 1024;
        float* xout = lat ? xout_lat + (size_t)u.pm * 256 * 1024 : xout_ctx + (size_t)(u.pm - 256) * 256 * 1024;
        const int row0 = wr * 64 + fr, col0 = u.pn * 256 + wc * 32 + 4 * fq;
        const float* gp = gt + bi * 6144 + col0;
        f32x4 gv[2][2];
#pragma unroll
        for (int bj = 0; bj < 2; ++bj)
#pragma unroll
            for (int n = 0; n < 2; ++n) gv[bj][n] = *(const f32x4*)(gp + bj * 128 + n * 16);
#pragma unroll
        for (int ai = 0; ai < 2; ++ai)
#pragma unroll
            for (int m = 0; m < 4; ++m) { const size_t off = (size_t)(row0 + ai * 128 + m * 16) * 1024 + col0;
#pragma unroll
                for (int bj = 0; bj < 2; ++bj)
#pragma unroll
                    for (int n = 0; n < 2; ++n) { const f32x4 xi = *(const f32x4*)(xin + off + bj * 128 + n * 16); *(f32x4*)(xout + off + bj * 128 + n * 16) = (ABL & 2) ? xi : xi + gv[bj][n] * acc[ai][bj][m][n]; }
                asm volatile("" ::: "memory"); }
    }
};

template <class Epi> __device__ __forceinline__ void run_gemm(LAS unsigned char* lds, const bf16_t* A, const bf16_t* Bt, int N, int K, const Epi& E) {
    int tid = threadIdx.x; asm volatile("" : "+v"(tid)); int bid = blockIdx.x; asm volatile("" : "+s"(bid));
    pg8::Gemm g{A, Bt, M, N, K}; pg8::StaticOrder S; S.init(M, N, (int)gridDim.x, bid);
    pg8::gemm_phase<Epi, pg8::StaticOrder>(lds, g, S, E, tid);
    __syncthreads();
}

struct Args { const float* in[32]; float* out; unsigned char* ws; int ph_lo, ph_hi; };
typedef const __attribute__((address_space(4))) unsigned char* kptr_t;
struct KA { kptr_t p;
    __device__ __forceinline__ const float* in(int i) const { return *(const float* const __attribute__((address_space(4)))*)(p + 8 * i); }
    __device__ __forceinline__ float* out() const { return *(float* const __attribute__((address_space(4)))*)(p + 256); }
    __device__ __forceinline__ unsigned char* ws() const { return *(unsigned char* const __attribute__((address_space(4)))*)(p + 264); }
    __device__ __forceinline__ int ph_lo() const { return *(const __attribute__((address_space(4))) int*)(p + 272); }
    __device__ __forceinline__ int ph_hi() const { return *(const __attribute__((address_space(4))) int*)(p + 276); }
};
__device__ __forceinline__ int opaque_tid() { int t = threadIdx.x; asm volatile("" : "+v"(t)); return t; }
__device__ __forceinline__ int opaque_bid() { int b = blockIdx.x; asm volatile("" : "+s"(b)); return b; }
__device__ __forceinline__ KA opaque_ka(KA a) { asm volatile("" : "+s"(a.p)); return a; }
enum { I_X = 0, I_C, I_CTX, I_CCTX, I_ADAW, I_ADAB, I_N1G, I_N2G, I_WIN, I_SMU, I_W0, I_W2, I_A0, I_A2, I_G2, I_KK, I_KA, I_RK, I_LNXG, I_LNXB, I_WOA, I_CONVW, I_CNG, I_CNB, I_WOB, I_GATEB, I_WOUT, I_WQ, I_SUBK, I_PU, I_PV, I_FG };

__device__ __forceinline__ void transpose_item(const float* W, int ld, bf16_t* WT, int Kd, int k0, LAS float* scr, int lane) {
#pragma unroll 8
    for (int i = 0; i < 32; ++i) { const int kk = 2 * i + (lane >> 5); scr[kk * 33 + (lane & 31)] = W[(size_t)(k0 + kk) * ld + (lane & 31)]; }
    LDS_WAIT(); asm volatile("" ::: "memory");
    const int c = lane & 7;
#pragma unroll
    for (int j = 0; j < 4; ++j) { const int n = (lane >> 3) + 8 * j; const LAS float* s = scr + (8 * c) * 33 + n;
        u32x4 o; o.x = pk_bf16(s[0 * 33], s[1 * 33]); o.y = pk_bf16(s[2 * 33], s[3 * 33]); o.z = pk_bf16(s[4 * 33], s[5 * 33]); o.w = pk_bf16(s[6 * 33], s[7 * 33]);
        *(u32x4*)(WT + (size_t)n * Kd + k0 + 8 * c) = o; }
    LDS_WAIT(); asm volatile("" ::: "memory");
}
__device__ __forceinline__ void prologue_phase(const KA a_in, LAS unsigned char* lds) {
    const KA a = opaque_ka(a_in); const int tid = opaque_tid(), bid = opaque_bid(), lane = tid & 63, wid = tid >> 6;
    const int gw = bid * 8 + wid, NGW = gridDim.x * 8;
    const int gt = bid * 512 + tid, NGT = gridDim.x * 512;
    LAS float* scr = (LAS float*)(lds + wid * 16384);
    constexpr int NT_L = 397, ITEMS_L = NT_L * 16;
    for (int it = gw; it < 2 * ITEMS_L; it += NGW) {
        const int l = it / ITEMS_L, r = it - l * ITEMS_L, nt = r >> 4, k0 = (r & 15) * 64;
        unsigned char* wb = a.ws() + WS_WB + (size_t)l * WB_LAYER;
        const float* win = a.in(I_WIN) + (size_t)l * 1024 * P_IN;
        if (nt < 109) { transpose_item(win + nt * 32, P_IN, (bf16_t*)(wb + WB_WR) + (size_t)nt * 32 * 1024, 1024, k0, scr, lane); }
        else if (nt < 173) { const int n0 = (nt - 109) * 32, pn = n0 >> 8, bj = (n0 >> 7) & 1, x = n0 & 127;
            transpose_item(win + P_RWKV + bj * 1024 + pn * 128 + x, P_IN, (bf16_t*)(wb + WB_WC) + (size_t)n0 * 1024, 1024, k0, scr, lane); }
        else if (nt < 237) { const int n0 = (nt - 173) * 32; transpose_item(win + P_RWKV + 2048 + n0, P_IN, (bf16_t*)(wb + WB_WG) + (size_t)n0 * 1024, 1024, k0, scr, lane); }
        else if (nt < 269) { const int n0 = (nt - 237) * 32; transpose_item(a.in(I_WOA) + (size_t)l * 1048576 + n0, 1024, (bf16_t*)(wb + WB_OA) + (size_t)n0 * 1024, 1024, k0, scr, lane); }
        else if (nt < 301) { const int n0 = (nt - 269) * 32; transpose_item(a.in(I_WOB) + (size_t)l * 1048576 + n0, 1024, (bf16_t*)(wb + WB_OB) + (size_t)n0 * 1024, 1024, k0, scr, lane); }
        else if (nt < 333) { const int n0 = (nt - 301) * 32; transpose_item(a.in(I_WOUT) + (size_t)l * 1048576 + n0, 1024, (bf16_t*)(wb + WB_OUT) + (size_t)n0 * 1024, 1024, k0, scr, lane); }
        else { const int n0 = (nt - 333) * 32; transpose_item(a.in(I_WQ) + (size_t)l * 2097152 + n0, 2048, (bf16_t*)(wb + WB_Q) + (size_t)n0 * 1024, 1024, k0, scr, lane); }
    }
    for (int i = gt; i < 2 * 12288; i += NGT) { const int l = i / 12288, r = i - l * 12288;
        *(u32x4*)(a.ws() + WS_WB + (size_t)l * WB_LAYER + WB_WR + (size_t)3488 * 2048 + (size_t)r * 16) = (u32x4){0u, 0u, 0u, 0u}; }
    for (int i = gt; i < 2 * 32768; i += NGT) { const int l = i >> 15, r = i & 32767, n = r >> 5, kc = r & 31; const float* g2 = a.in(I_G2) + (size_t)l * 160 * 1024;
        float v[8];
#pragma unroll
        for (int j = 0; j < 8; ++j) { const int k = kc * 8 + j; v[j] = k < 160 ? g2[(size_t)k * 1024 + n] : 0.f; }
        u32x4 o; o.x = pk_bf16(v[0], v[1]); o.y = pk_bf16(v[2], v[3]); o.z = pk_bf16(v[4], v[5]); o.w = pk_bf16(v[6], v[7]);
        *(u32x4*)(a.ws() + WS_WB + (size_t)l * WB_LAYER + WB_G2 + (size_t)(n * 256 + kc * 8) * 2) = o; }
    for (int i = gt; i < 2 * 32768; i += NGT) { const int l = i >> 15, r = i & 32767; const f32x4* s = (const f32x4*)(a.in(I_SUBK) + (size_t)l * 262144 + (size_t)r * 8);
        const f32x4 v0 = s[0], v1 = s[1]; *(u32x4*)(a.ws() + WS_WB + (size_t)l * WB_LAYER + WB_SK + (size_t)r * 16) = pack8(v0, v1); }
    __syncthreads();
    LAS float* sil = (LAS float*)lds;
    float* modp = (float*)(a.ws() + WS_Z);
    for (int it = bid; it < 384; it += gridDim.x) {
        const int l = it / 192, r = it - l * 192, ks = r / 12, jt = r - ks * 12;
        for (int idx = tid; idx < 576; idx += 512) { const int i = idx >> 6, kk = idx & 63; const float cv = (i < 8) ? a.in(I_C)[i * 1024 + ks * 64 + kk] : a.in(I_CCTX)[ks * 64 + kk]; sil[idx] = cv * sigm(cv); }
        __syncthreads();
        const int j = jt * 512 + tid; const float* w = a.in(I_ADAW) + ((size_t)l * 1024 + ks * 64) * 6144 + j;
        float acc[9];
#pragma unroll
        for (int i = 0; i < 9; ++i) acc[i] = 0.f;
#pragma unroll 4
        for (int kk = 0; kk < 64; ++kk) { const float wv = w[(size_t)kk * 6144];
#pragma unroll
            for (int i = 0; i < 9; ++i) acc[i] += sil[i * 64 + kk] * wv; }
#pragma unroll
        for (int i = 0; i < 9; ++i) modp[((size_t)(l * 16 + ks) * 9 + i) * 6144 + j] = acc[i];
        __syncthreads();
    }
}
__device__ __forceinline__ void modreduce_phase(const KA a_in) {
    const KA a = opaque_ka(a_in); const int gt = opaque_bid() * 512 + opaque_tid(), NGT = gridDim.x * 512;
    const float* modp = (const float*)(a.ws() + WS_Z); float* mod = (float*)(a.ws() + WS_MOD);
    for (int i = gt; i < 2 * 9 * 6144; i += NGT) { const int l = i / (9 * 6144), r = i - l * 9 * 6144, j = r % 6144;
        float s = a.in(I_ADAB)[l * 6144 + j];
#pragma unroll
        for (int ks = 0; ks < 16; ++ks) s += modp[(size_t)(l * 16 + ks) * 9 * 6144 + r];
        mod[i] = s; }
}

__device__ __forceinline__ void norm_phase(const float* xlat, const float* xctx, const float* g, const float* modl, int sh_off, int sc_off, bf16_t* H) {
    const int tid = opaque_tid(); const int lane = tid & 63, gw = opaque_bid() * 8 + (tid >> 6), NGW = gridDim.x * 8;
    f32x4 gg[4];
#pragma unroll
    for (int j = 0; j < 4; ++j) gg[j] = ((const f32x4*)g)[lane + 64 * j];
    for (int row = gw; row < M; row += NGW) {
        const bool lat = row < M_LAT; const int bi = lat ? (row >> 13) : 8;
        const f32x4* xr = (const f32x4*)(lat ? xlat + (size_t)row * 1024 : xctx + (size_t)(row - M_LAT) * 1024) + lane;
        const f32x4* shp = (const f32x4*)(modl + bi * 6144 + sh_off) + lane; const f32x4* scp = (const f32x4*)(modl + bi * 6144 + sc_off) + lane;
        f32x4 v[4]; float s = 0.f;
#pragma unroll
        for (int j = 0; j < 4; ++j) { v[j] = xr[64 * j]; s += (v[j].x * v[j].x + v[j].y * v[j].y) + (v[j].z * v[j].z + v[j].w * v[j].w); }
        const float rs = rsqrtf(wave_sum(s, lane) * (1.f / 1024.f) + 1e-6f);
        u32x2* o8 = (u32x2*)(H + (size_t)row * 1024) + lane;
#pragma unroll
        for (int j = 0; j < 4; ++j) { const f32x4 sh = shp[64 * j], sc = scp[64 * j]; const f32x4 y = v[j] * rs * gg[j] * (sc + 1.0f) + sh;
            u32x2 o; o.x = pk_bf16(y.x, y.y); o.y = pk_bf16(y.z, y.w); o8[64 * j] = o; }
    }
}
__device__ __forceinline__ void final_phase(float* x, const float* g) {
    const int tid = opaque_tid(); const int lane = tid & 63, gw = opaque_bid() * 8 + (tid >> 6), NGW = gridDim.x * 8;
    f32x4 gg[4];
#pragma unroll
    for (int j = 0; j < 4; ++j) gg[j] = ((const f32x4*)g)[lane + 64 * j];
    for (int row = gw; row < M_LAT; row += NGW) {
        f32x4* xr = (f32x4*)(x + (size_t)row * 1024) + lane;
        f32x4 v[4]; float s = 0.f;
#pragma unroll
        for (int j = 0; j < 4; ++j) { v[j] = xr[64 * j]; s += (v[j].x * v[j].x + v[j].y * v[j].y) + (v[j].z * v[j].z + v[j].w * v[j].w); }
        const float rs = rsqrtf(wave_sum(s, lane) * (1.f / 1024.f) + 1e-6f);
#pragma unroll
        for (int j = 0; j < 4; ++j) xr[64 * j] = v[j] * rs * gg[j];
    }
}
__device__ __forceinline__ void convert_tables(const KA a_in, int l) {
    const KA a = opaque_ka(a_in); const int gt = opaque_bid() * 512 + opaque_tid(), NGT = gridDim.x * 512;
    const f32x4* su = (const f32x4*)(a.in(I_PU) + (size_t)l * 16777216); const f32x4* sv = (const f32x4*)(a.in(I_PV) + (size_t)l * 16777216);
    u32x4* du = (u32x4*)(a.ws() + WS_PT); u32x4* dv = (u32x4*)(a.ws() + WS_PT + 32 * MiB);
    for (int i = gt; i < 2097152; i += NGT) { const f32x4 a0 = su[2 * i], a1 = su[2 * i + 1]; du[i] = pack8(a0, a1); const f32x4 b0 = sv[2 * i], b1 = sv[2 * i + 1]; dv[i] = pack8(b0, b1); }
}

__device__ __forceinline__ void scan_load(u32x4 (&pre)[3], const bf16_t* ZR, int seq_base, int len, int tlo, int h, int d, int tid) {
#pragma unroll
    for (int q = 0; q < 3; ++q) {
        const int piece = tid + 512 * q; u32x4 v = (u32x4){0u, 0u, 0u, 0u};
        if (piece < 1360) { const int row = piece / 40, rem = piece - row * 40, grp = rem >> 3, sub = rem & 7; const int t = tlo - 1 + row;
            const int cbase = (grp < 3) ? (grp * 1024 + h * 64) : ((grp == 3 ? C_W1 : C_A1) + d * 64);
            if (t >= 0 && t < len) v = *(const u32x4*)(ZR + (size_t)(seq_base + t) * NZR + cbase + sub * 8); }
        pre[q] = v;
    }
}
__device__ __forceinline__ void scan_phase(const KA a_in, LAS unsigned char* lds, int l) {
    const KA a = opaque_ka(a_in); const int tid = opaque_tid(), bid = opaque_bid(), lane = tid & 63, wid = tid >> 6, col = lane;
    LAS float* RAW = (LAS float*)lds;
    LAS bf16_t* TA = (LAS bf16_t*)(lds + 43520);
    LAS float* LW = (LAS float*)(lds + 51712);
    LAS float* OP = (LAS float*)(lds + 68096);
    LAS float* YL = (LAS float*)(lds + 117248);
    const bf16_t* ZR = (const bf16_t*)(a.ws() + WS_Z);
    float* BON = (float*)(a.ws() + WS_BON);
    const float* smu = a.in(I_SMU) + (size_t)l * 2 * P_RWKV;
    for (int chain = bid; chain < 256; chain += gridDim.x) {
        const int b = chain >> 5, h = (chain >> 1) & 15, d = chain & 1;
        bf16_t* Yd = (bf16_t*)(a.ws() + (d ? WS_YB : WS_YF));
        float mu0[5], mu1[5];
#pragma unroll
        for (int g = 0; g < 5; ++g) { const int cb = (g < 3) ? (g * 1024 + h * 64) : ((g == 3 ? C_W1 : C_A1) + d * 64); mu0[g] = smu[cb + col]; mu1[g] = smu[P_RWKV + cb + col]; }
        const int hc = h * 64 + col;
        const float w0c = a.in(I_W0)[(l * 2 + d) * 1024 + hc], a0c = a.in(I_A0)[(l * 2 + d) * 1024 + hc];
        const float kkc = a.in(I_KK)[l * 1024 + hc], kac = a.in(I_KA)[l * 1024 + hc], rkc = a.in(I_RK)[l * 1024 + hc];
        const int mm = wid >> 2, ct = wid & 3;
        bf16x8 Bf[2];
        { const float* lw = (mm == 0 ? a.in(I_W2) : a.in(I_A2)) + (size_t)(l * 2 + d) * 64 * 1024 + h * 64 + ct * 16 + (lane & 15);
#pragma unroll
          for (int ks = 0; ks < 2; ++ks) { float v[8];
#pragma unroll
              for (int j = 0; j < 8; ++j) v[j] = lw[(size_t)(ks * 32 + (lane >> 4) * 8 + j) * 1024];
              u32x4 w; w.x = pk_bf16(v[0], v[1]); w.y = pk_bf16(v[2], v[3]); w.z = pk_bf16(v[4], v[5]); w.w = pk_bf16(v[6], v[7]); Bf[ks] = __builtin_bit_cast(bf16x8, w); } }
        float S0[4] = {0.f, 0.f, 0.f, 0.f}, S1[4] = {0.f, 0.f, 0.f, 0.f};
        const int g4 = lane >> 4, kq = lane & 15, row0 = wid * 8 + 2 * g4;
        u32x4 pre[3];
        scan_load(pre, ZR, M_LAT + b * CTXL, CTXL, d ? CTXL - 32 : 0, h, d, tid);
        for (int cc = 0; cc < 264; ++cc) {
            const int seg = cc >= 8, c = seg ? cc - 8 : cc, len = seg ? SEQ : CTXL;
            const int seq_base = seg ? b * SEQ : M_LAT + b * CTXL;
            const int tlo = d ? len - 32 * (c + 1) : 32 * c;
#pragma unroll
            for (int q = 0; q < 3; ++q) { const int piece = tid + 512 * q;
                if (piece < 1360) { const int row = piece / 40, rem = piece - row * 40; LAS float* dst = RAW + row * 320 + rem * 8; f32x4 v0, v1; unpack8(pre[q], v0, v1); *(LAS f32x4*)dst = v0; *(LAS f32x4*)(dst + 4) = v1; } }
            if (cc + 1 < 264) { const int c2 = cc + 1, seg2 = c2 >= 8, cn = seg2 ? c2 - 8 : c2, len2 = seg2 ? SEQ : CTXL;
                scan_load(pre, ZR, seg2 ? b * SEQ : M_LAT + b * CTXL, len2, d ? len2 - 32 * (cn + 1) : 32 * cn, h, d, tid); }
            __syncthreads();
#pragma unroll
            for (int i = 0; i < 4; ++i) { const int trow = wid + 8 * i; const LAS float* r0 = RAW + trow * 320 + col;
                const float zw0 = r0[192], zw1 = r0[320 + 192], zw2 = r0[640 + 192]; const float w1v = zw1 + mu0[3] * (zw0 - zw1) + mu1[3] * (zw2 - zw1);
                const float za0 = r0[256], za1 = r0[320 + 256], za2 = r0[640 + 256]; const float a1v = za1 + mu0[4] * (za0 - za1) + mu1[4] * (za2 - za1);
                TA[trow * 64 + col] = (bf16_t)(pk_bf16(tanhf(w1v), 0.f) & 0xffffu); TA[2048 + trow * 64 + col] = (bf16_t)(pk_bf16(a1v, 0.f) & 0xffffu); }
            __syncthreads();
#pragma unroll
            for (int rt = 0; rt < 2; ++rt) { f32x4 acc = (f32x4){0.f, 0.f, 0.f, 0.f};
#pragma unroll
                for (int ks = 0; ks < 2; ++ks) { const bf16x8 Af = *(const LAS bf16x8*)(TA + (mm * 32 + rt * 16 + (lane & 15)) * 64 + ks * 32 + (lane >> 4) * 8); acc = __builtin_amdgcn_mfma_f32_16x16x32_bf16(Af, Bf[ks], acc, 0, 0, 0); }
#pragma unroll
                for (int rg = 0; rg < 4; ++rg) LW[(mm * 32 + rt * 16 + (lane >> 4) * 4 + rg) * 64 + ct * 16 + (lane & 15)] = acc[rg]; }
            __syncthreads();
#pragma unroll
            for (int i = 0; i < 4; ++i) { const int trow = wid + 8 * i; const LAS float* r0 = RAW + trow * 320 + col;
                const float zr0 = r0[0], zr1 = r0[320], zr2 = r0[640]; const float rv = zr1 + mu0[0] * (zr0 - zr1) + mu1[0] * (zr2 - zr1);
                const float zk0 = r0[64], zk1 = r0[320 + 64], zk2 = r0[640 + 64]; const float kv = zk1 + mu0[1] * (zk0 - zk1) + mu1[1] * (zk2 - zk1);
                const float zv0 = r0[128], zv1 = r0[320 + 128], zv2 = r0[640 + 128]; const float vv = zv1 + mu0[2] * (zv0 - zv1) + mu1[2] * (zv2 - zv1);
                const float wl = LW[trow * 64 + col] + w0c; const float dec = __expf(-0.60653066f * sigm(wl));
                const float av = sigm(LW[2048 + trow * 64 + col] + a0c);
                const float kkr = kv * kkc; const float n2 = wave_sum(kkr * kkr, lane); const float kk = kkr / fmaxf(sqrtf(n2), 1e-12f);
                const float kd = kv * (1.f + (av - 1.f) * kac); const float bb = kk * av;
                const float bon = wave_sum(rv * kd * rkc, lane);
                const int s = d ? 31 - trow : trow; LAS float* op = OP + s * 384 + col;
                op[0] = dec; op[64] = kk; op[128] = bb; op[192] = kd; op[256] = rv; op[320] = vv;
                if (lane == 0) BON[((size_t)d * M + seq_base + tlo + trow) * 16 + h] = bon; }
            __syncthreads();
#pragma unroll 4
            for (int s = 0; s < 32; ++s) { const LAS float* op = OP + s * 384;
                const f32x4 w4 = *(const LAS f32x4*)(op + kq * 4), kk4 = *(const LAS f32x4*)(op + 64 + kq * 4), b4 = *(const LAS f32x4*)(op + 128 + kq * 4);
                const f32x4 kd4 = *(const LAS f32x4*)(op + 192 + kq * 4), r4 = *(const LAS f32x4*)(op + 256 + kq * 4); const f32x2 v2 = *(const LAS f32x2*)(op + 320 + row0);
                float sa0 = (S0[0] * kk4[0] + S0[1] * kk4[1]) + (S0[2] * kk4[2] + S0[3] * kk4[3]); float sa1 = (S1[0] * kk4[0] + S1[1] * kk4[1]) + (S1[2] * kk4[2] + S1[3] * kk4[3]);
                sa0 = red16(sa0); sa1 = red16(sa1);
#pragma unroll
                for (int j = 0; j < 4; ++j) { S0[j] = S0[j] * w4[j] + (v2.x * kd4[j] - sa0 * b4[j]); S1[j] = S1[j] * w4[j] + (v2.y * kd4[j] - sa1 * b4[j]); }
                float y0 = (S0[0] * r4[0] + S0[1] * r4[1]) + (S0[2] * r4[2] + S0[3] * r4[3]); float y1 = (S1[0] * r4[0] + S1[1] * r4[1]) + (S1[2] * r4[2] + S1[3] * r4[3]);
                y0 = red16(y0); y1 = red16(y1);
                if (kq == 0) *(LAS f32x2*)(YL + s * 64 + row0) = (f32x2){y0, y1}; }
            __syncthreads();
            { const int i = tid >> 4, c4 = (tid & 15) * 4; const int s = d ? 31 - i : i; const f32x4 y = *(const LAS f32x4*)(YL + s * 64 + c4);
              u32x2 o; o.x = pk_bf16(y[0], y[1]); o.y = pk_bf16(y[2], y[3]); *(u32x2*)(Yd + (size_t)(seq_base + tlo + i) * 1024 + h * 64 + c4) = o; }
        }
        __syncthreads();
    }
}

__device__ __forceinline__ void post_phase(const KA a_in, int l) {
    const KA a = opaque_ka(a_in); const int tid = opaque_tid(); const int lane = tid & 63, gw = opaque_bid() * 8 + (tid >> 6), NGW = gridDim.x * 8;
    const bf16_t* ZR = (const bf16_t*)(a.ws() + WS_Z); bf16_t* YF = (bf16_t*)(a.ws() + WS_YF); const bf16_t* YB = (const bf16_t*)(a.ws() + WS_YB);
    const float* BON = (const float*)(a.ws() + WS_BON); bf16_t* SG = (bf16_t*)(a.ws() + WS_PT);
    const float* smu = a.in(I_SMU) + (size_t)l * 2 * P_RWKV;
    const int c0 = lane * 16;
    float m0v[16], m1v[16], lg[16], lb[16];
#pragma unroll
    for (int j = 0; j < 16; ++j) { m0v[j] = smu[C_V + c0 + j]; m1v[j] = smu[P_RWKV + C_V + c0 + j]; lg[j] = a.in(I_LNXG)[l * 1024 + c0 + j]; lb[j] = a.in(I_LNXB)[l * 1024 + c0 + j]; }
    float gm0[4], gm1[4];
#pragma unroll
    for (int j = 0; j < 4; ++j) { const int cg = C_G1 + (lane < 40 ? lane * 4 + j : 0); gm0[j] = smu[cg]; gm1[j] = smu[P_RWKV + cg]; }
    for (int row = gw; row < M; row += NGW) {
        const bool lat = row < M_LAT; const int t = lat ? (row & (SEQ - 1)) : ((row - M_LAT) & (CTXL - 1)); const int len = lat ? SEQ : CTXL;
        const bool hp = t > 0, hn = t < len - 1;
        const u32x4 z4 = (u32x4){0u, 0u, 0u, 0u};
        const u32x4* yfp = (const u32x4*)(YF + (size_t)row * 1024 + c0); const u32x4* ybp = (const u32x4*)(YB + (size_t)row * 1024 + c0);
        const u32x4 yf0 = yfp[0], yf1 = yfp[1], yb0 = ybp[0], yb1 = ybp[1];
        const u32x4* vc = (const u32x4*)(ZR + (size_t)row * NZR + C_V + c0);
        const u32x4 vc0 = vc[0], vc1 = vc[1];
        const u32x4 vp0 = hp ? *(const u32x4*)(ZR + (size_t)(row - 1) * NZR + C_V + c0) : z4, vp1 = hp ? *(const u32x4*)(ZR + (size_t)(row - 1) * NZR + C_V + c0 + 8) : z4;
        const u32x4 vn0 = hn ? *(const u32x4*)(ZR + (size_t)(row + 1) * NZR + C_V + c0) : z4, vn1 = hn ? *(const u32x4*)(ZR + (size_t)(row + 1) * NZR + C_V + c0 + 8) : z4;
        const int hd = lane >> 2;
        const float bon = BON[(size_t)row * 16 + hd] + BON[((size_t)M + row) * 16 + hd];
        float o[16], vz[16], vpz[16], vnz[16];
        { f32x4 p0, p1, q0, q1; unpack8(yf0, p0, p1); unpack8(yb0, q0, q1);
#pragma unroll
          for (int j = 0; j < 4; ++j) { o[j] = p0[j] + q0[j]; o[4 + j] = p1[j] + q1[j]; }
          unpack8(yf1, p0, p1); unpack8(yb1, q0, q1);
#pragma unroll
          for (int j = 0; j < 4; ++j) { o[8 + j] = p0[j] + q0[j]; o[12 + j] = p1[j] + q1[j]; }
          unpack8(vc0, p0, p1); unpack8(vc1, q0, q1);
#pragma unroll
          for (int j = 0; j < 4; ++j) { vz[j] = p0[j]; vz[4 + j] = p1[j]; vz[8 + j] = q0[j]; vz[12 + j] = q1[j]; }
          unpack8(vp0, p0, p1); unpack8(vp1, q0, q1);
#pragma unroll
          for (int j = 0; j < 4; ++j) { vpz[j] = p0[j]; vpz[4 + j] = p1[j]; vpz[8 + j] = q0[j]; vpz[12 + j] = q1[j]; }
          unpack8(vn0, p0, p1); unpack8(vn1, q0, q1);
#pragma unroll
          for (int j = 0; j < 4; ++j) { vnz[j] = p0[j]; vnz[4 + j] = p1[j]; vnz[8 + j] = q0[j]; vnz[12 + j] = q1[j]; } }
        float s = 0.f;
#pragma unroll
        for (int j = 0; j < 16; ++j) s += o[j];
        s += dpp_f<0xB1>(s); s += dpp_f<0x4E>(s);
        const float mean = s * (1.f / 64.f); float q = 0.f;
#pragma unroll
        for (int j = 0; j < 16; ++j) { const float dd = o[j] - mean; q += dd * dd; }
        q += dpp_f<0xB1>(q); q += dpp_f<0x4E>(q);
        const float rstd = rsqrtf(q * (1.f / 64.f) + 64e-5f);
        float r[16];
#pragma unroll
        for (int j = 0; j < 16; ++j) { const float vv = vz[j] + m0v[j] * (vpz[j] - vz[j]) + m1v[j] * (vnz[j] - vz[j]); r[j] = (o[j] - mean) * rstd * lg[j] + lb[j] + bon * vv; }
        u32x4 w0, w1; w0.x = pk_bf16(r[0], r[1]); w0.y = pk_bf16(r[2], r[3]); w0.z = pk_bf16(r[4], r[5]); w0.w = pk_bf16(r[6], r[7]);
        w1.x = pk_bf16(r[8], r[9]); w1.y = pk_bf16(r[10], r[11]); w1.z = pk_bf16(r[12], r[13]); w1.w = pk_bf16(r[14], r[15]);
        u32x4* op = (u32x4*)(YF + (size_t)row * 1024 + c0);
#if PROBE_HI == 6
        (void)op;
#else
        op[0] = w0; op[1] = w1;
#endif
#if PROBE_HI > 0
        if (row < 32768) { u32x4* o2 = (u32x4*)((bf16_t*)(a.ws() + WS_Z + 396 * MiB) + (size_t)row * 1024 + c0); o2[0] = w0; o2[1] = w1; }
#endif
        u32x2 sg = (u32x2){0u, 0u};
        if (lane < 40) { const u32x2 gc = *(const u32x2*)(ZR + (size_t)row * NZR + C_G1 + lane * 4);
            const u32x2 gp = hp ? *(const u32x2*)(ZR + (size_t)(row - 1) * NZR + C_G1 + lane * 4) : (u32x2){0u, 0u};
            const u32x2 gn = hn ? *(const u32x2*)(ZR + (size_t)(row + 1) * NZR + C_G1 + lane * 4) : (u32x2){0u, 0u};
            const float zc[4] = {bf_lo(gc.x), bf_hi(gc.x), bf_lo(gc.y), bf_hi(gc.y)}, zp[4] = {bf_lo(gp.x), bf_hi(gp.x), bf_lo(gp.y), bf_hi(gp.y)}, zn[4] = {bf_lo(gn.x), bf_hi(gn.x), bf_lo(gn.y), bf_hi(gn.y)};
            float sv[4];
#pragma unroll
            for (int j = 0; j < 4; ++j) sv[j] = sigm(zc[j] + gm0[j] * (zp[j] - zc[j]) + gm1[j] * (zn[j] - zc[j]));
            sg.x = pk_bf16(sv[0], sv[1]); sg.y = pk_bf16(sv[2], sv[3]); }
        *(u32x2*)(SG + (size_t)row * 256 + lane * 4) = sg;
    }
}

__device__ __forceinline__ void conv_phase(const KA a_in, int l) {
    const KA a = opaque_ka(a_in); const int tid = opaque_tid(); const int lane = tid & 63, gw = opaque_bid() * 8 + (tid >> 6), NGW = gridDim.x * 8;
    const bf16_t* U = (const bf16_t*)(a.ws() + WS_Z); bf16_t* A2 = (bf16_t*)(a.ws() + WS_YB);
    const float* cw = a.in(I_CONVW) + (size_t)l * 31 * 1024; const int c0 = lane * 16;
    float cg[16], cb[16];
#pragma unroll
    for (int j = 0; j < 16; ++j) { cg[j] = a.in(I_CNG)[l * 1024 + c0 + j]; cb[j] = a.in(I_CNB)[l * 1024 + c0 + j]; }
    for (int row = gw; row < M; row += NGW) {
        const bool lat = row < M_LAT; const int stride = lat ? 64 : 1; const int pos = lat ? ((row & (SEQ - 1)) >> 6) : ((row - M_LAT) & (CTXL - 1)); const int len = lat ? 128 : CTXL;
        float acc[16];
#pragma unroll
        for (int j = 0; j < 16; ++j) acc[j] = 0.f;
#pragma unroll 1
        for (int k = 0; k < 31; ++k) { const int pp = pos + k - 15;
            if (pp >= 0 && pp < len) { const u32x4* up = (const u32x4*)(U + (size_t)(row + (k - 15) * stride) * 1024 + c0); const u32x4 u0 = up[0], u1 = up[1];
                const f32x4* wp = (const f32x4*)(cw + k * 1024 + c0); const f32x4 w0 = wp[0], w1 = wp[1], w2 = wp[2], w3 = wp[3];
                f32x4 x0, x1, x2, x3; unpack8(u0, x0, x1); unpack8(u1, x2, x3);
#pragma unroll
                for (int j = 0; j < 4; ++j) { acc[j] += x0[j] * w0[j]; acc[4 + j] += x1[j] * w1[j]; acc[8 + j] += x2[j] * w2[j]; acc[12 + j] += x3[j] * w3[j]; } } }
        float s = 0.f;
#pragma unroll
        for (int j = 0; j < 16; ++j) s += acc[j];
        const float mean = wave_sum(s, lane) * (1.f / 1024.f); float q = 0.f;
#pragma unroll
        for (int j = 0; j < 16; ++j) { const float dd = acc[j] - mean; q += dd * dd; }
        const float rstd = rsqrtf(wave_sum(q, lane) * (1.f / 1024.f) + 1e-5f);
        float r[16];
#pragma unroll
        for (int j = 0; j < 16; ++j) { const float y = (acc[j] - mean) * rstd * cg[j] + cb[j]; r[j] = y * sigm(y); }
        u32x4 w0, w1; w0.x = pk_bf16(r[0], r[1]); w0.y = pk_bf16(r[2], r[3]); w0.z = pk_bf16(r[4], r[5]); w0.w = pk_bf16(r[6], r[7]);
        w1.x = pk_bf16(r[8], r[9]); w1.y = pk_bf16(r[10], r[11]); w1.z = pk_bf16(r[12], r[13]); w1.w = pk_bf16(r[14], r[15]);
        u32x4* op = (u32x4*)(A2 + (size_t)row * 1024 + c0); op[0] = w0; op[1] = w1;
    }
}

__device__ __forceinline__ void ce(float& ka, unsigned& pa, float& kb, unsigned& pb) {
    const bool sw = kb > ka; const float k0 = sw ? kb : ka, k1 = sw ? ka : kb; const unsigned p0 = sw ? pb : pa, p1 = sw ? pa : pb; ka = k0; kb = k1; pa = p0; pb = p1;
}
template <int N> __device__ __forceinline__ void bitonic_sort_desc(float (&k)[N], unsigned (&p)[N]) {
#pragma unroll
    for (int size = 2; size <= N; size <<= 1)
#pragma unroll
        for (int stride = size >> 1; stride > 0; stride >>= 1)
#pragma unroll
            for (int i = 0; i < N; ++i) { const int j = i ^ stride; if (j > i) { if ((i & size) == 0) ce(k[i], p[i], k[j], p[j]); else ce(k[j], p[j], k[i], p[i]); } }
}
__device__ __forceinline__ void bitonic_merge16_desc(float (&k)[16], unsigned (&p)[16]) {
#pragma unroll
    for (int stride = 8; stride > 0; stride >>= 1)
#pragma unroll
        for (int i = 0; i < 16; ++i) { const int j = i ^ stride; if (j > i) ce(k[i], p[i], k[j], p[j]); }
}
__device__ __forceinline__ void merge_partner16(float (&k)[16], unsigned (&p)[16], int mask, int lane) {
    float ok[16]; unsigned opp[16];
#pragma unroll
    for (int i = 0; i < 16; ++i) { ok[i] = shxf(k[i], mask, lane); opp[i] = (unsigned)shxi((int)p[i], mask, lane); }
#pragma unroll
    for (int i = 0; i < 16; ++i) { const float o = ok[15 - i]; const unsigned q = opp[15 - i]; const bool t = o > k[i]; k[i] = t ? o : k[i]; p[i] = t ? q : p[i]; }
    bitonic_merge16_desc(k, p);
}
__device__ __forceinline__ int f2sort(float f) { const int b = __builtin_bit_cast(int, f); return b ^ ((b >> 31) & 0x7fffffff); }
__device__ __forceinline__ float sort2f(int s) { return __builtin_bit_cast(float, s ^ ((s >> 31) & 0x7fffffff)); }
__device__ __forceinline__ void cei(int& a, int& b) { const int mx = a > b ? a : b, mn = a > b ? b : a; a = mx; b = mn; }
template <int N> __device__ __forceinline__ void bitonic_sort_desc_i(int (&k)[N]) {
#pragma unroll
    for (int size = 2; size <= N; size <<= 1)
#pragma unroll
        for (int stride = size >> 1; stride > 0; stride >>= 1)
#pragma unroll
            for (int i = 0; i < N; ++i) { const int j = i ^ stride; if (j > i) { if ((i & size) == 0) cei(k[i], k[j]); else cei(k[j], k[i]); } }
}
__device__ __forceinline__ void merge_partner16_i(int (&k)[16], int mask, int lane) {
    int ok[16];
#pragma unroll
    for (int i = 0; i < 16; ++i) ok[i] = shxi(k[i], mask, lane);
#pragma unroll
    for (int i = 0; i < 16; ++i) k[i] = k[i] > ok[15 - i] ? k[i] : ok[15 - i];
#pragma unroll
    for (int stride = 8; stride > 0; stride >>= 1)
#pragma unroll
        for (int i = 0; i < 16; ++i) { const int j = i ^ stride; if (j > i) cei(k[i], k[j]); }
}
__device__ __forceinline__ void topk_half(const bf16_t* Q, const bf16_t* SK, int tok0, int lane, int (&tk)[16]) {
    bf16x8 qf[4];
#pragma unroll
    for (int ks = 0; ks < 4; ++ks) qf[ks] = *(const bf16x8*)(Q + (size_t)(tok0 + (lane & 15)) * 2048 + ks * 32 + (lane >> 4) * 8);
    int k[32];
#pragma unroll
    for (int tile = 0; tile < 8; ++tile) { f32x4 acc = (f32x4){0.f, 0.f, 0.f, 0.f};
#pragma unroll
        for (int ks = 0; ks < 4; ++ks) { const bf16x8 kf = *(const bf16x8*)(SK + (size_t)(tile * 16 + (lane & 15)) * 128 + ks * 32 + (lane >> 4) * 8); acc = __builtin_amdgcn_mfma_f32_16x16x32_bf16(kf, qf[ks], acc, 0, 0, 0); }
#pragma unroll
        for (int rg = 0; rg < 4; ++rg) k[tile * 4 + rg] = (f2sort(acc[rg]) & ~127) | (tile * 16 + (lane >> 4) * 4 + rg); }
    bitonic_sort_desc_i<32>(k);
#pragma unroll
    for (int i = 0; i < 16; ++i) tk[i] = k[i];
    merge_partner16_i(tk, 16, lane); merge_partner16_i(tk, 32, lane);
}
#define SELQ(x0, x1, x2, x3) (qd == 0 ? (x0) : (qd == 1 ? (x1) : (qd == 2 ? (x2) : (x3))))
#define CAND(m, i0, j0, i1, j1, i2, j2, i3, j3) do { ck[m] = SELQ(k1[i0] + k2[j0], k1[i1] + k2[j1], k1[i2] + k2[j2], k1[i3] + k2[j3]); \
    cp[m] = SELQ((p1[i0] << 7) | p2[j0], (p1[i1] << 7) | p2[j1], (p1[i2] << 7) | p2[j2], (p1[i3] << 7) | p2[j3]); } while (0)
__device__ __forceinline__ void topk_phase(const KA a_in, int l) {
    const KA a = opaque_ka(a_in); const int tid = opaque_tid(); const int lane = tid & 63, gw = opaque_bid() * 8 + (tid >> 6), NGW = gridDim.x * 8;
    const bf16_t* Q = (const bf16_t*)(a.ws() + WS_Z); const bf16_t* SKB = (const bf16_t*)(a.ws() + WS_WB + (size_t)l * WB_LAYER + WB_SK);
    int* EIDX = (int*)(a.ws() + WS_YF); float* GW = (float*)(a.ws() + WS_YB);
    const int qd = lane >> 4; const float NINF = -__builtin_inff();
    for (int u = gw; u < (M / 16) * 8; u += NGW) {
        const int tok0 = (u >> 3) * 16, h = u & 7;
        int t1[16], t2[16];
        topk_half(Q + h * 256, SKB + (size_t)(h * 2 + 0) * 16384, tok0, lane, t1);
        __builtin_amdgcn_sched_barrier(0);
        topk_half(Q + h * 256 + 128, SKB + (size_t)(h * 2 + 1) * 16384, tok0, lane, t2);
        __builtin_amdgcn_sched_barrier(0);
        float k1[16], k2[16]; unsigned p1[16], p2[16];
#pragma unroll
        for (int i = 0; i < 16; ++i) { k1[i] = sort2f(t1[i] & ~127); p1[i] = (unsigned)(t1[i] & 127); k2[i] = sort2f(t2[i] & ~127); p2[i] = (unsigned)(t2[i] & 127); }
        float ck[16]; unsigned cp[16];
        CAND(0, 0, 0, 0, 1, 0, 2, 0, 3); CAND(1, 0, 4, 0, 5, 0, 6, 0, 7); CAND(2, 0, 8, 0, 9, 0, 10, 0, 11); CAND(3, 0, 12, 0, 13, 0, 14, 0, 15);
        CAND(4, 1, 0, 1, 1, 1, 2, 1, 3); CAND(5, 1, 4, 1, 5, 1, 6, 1, 7); CAND(6, 2, 0, 2, 1, 2, 2, 2, 3); CAND(7, 2, 4, 3, 0, 3, 1, 3, 2);
        CAND(8, 3, 3, 4, 0, 4, 1, 4, 2); CAND(9, 5, 0, 5, 1, 6, 0, 6, 1); CAND(10, 7, 0, 7, 1, 8, 0, 9, 0); CAND(11, 10, 0, 11, 0, 12, 0, 13, 0);
        CAND(12, 14, 0, 15, 0, 15, 0, 15, 0); if (qd >= 2) ck[12] = NINF;
        ck[13] = NINF; ck[14] = NINF; ck[15] = NINF; cp[13] = 0u; cp[14] = 0u; cp[15] = 0u;
        bitonic_sort_desc<16>(ck, cp);
        merge_partner16(ck, cp, 16, lane); merge_partner16(ck, cp, 32, lane);
        float e[16], sum = 0.f;
#pragma unroll
        for (int i = 0; i < 16; ++i) { e[i] = __expf(ck[i] - ck[0]); sum += e[i]; }
        const float inv = 1.0f / sum;
        if (qd == 0) { const size_t o = (size_t)(tok0 + (lane & 15)) * 128 + h * 16;
#pragma unroll
            for (int i = 0; i < 4; ++i) { *(u32x4*)(EIDX + o + 4 * i) = (u32x4){cp[4 * i], cp[4 * i + 1], cp[4 * i + 2], cp[4 * i + 3]}; *(f32x4*)(GW + o + 4 * i) = (f32x4){e[4 * i] * inv, e[4 * i + 1] * inv, e[4 * i + 2] * inv, e[4 * i + 3] * inv}; } }
    }
}

__device__ __forceinline__ void peer_phase(const KA a_in, int l, float* xlat, float* xctx) {
    const KA a = opaque_ka(a_in); const int tid = opaque_tid(); const int lane = tid & 63, gw = opaque_bid() * 8 + (tid >> 6), NGW = gridDim.x * 8;
    const bf16_t* H = (const bf16_t*)(a.ws() + WS_H); const bf16_t* PU = (const bf16_t*)(a.ws() + WS_PT); const bf16_t* PV = (const bf16_t*)(a.ws() + WS_PT + 32 * MiB);
    const int* EIDX = (const int*)(a.ws() + WS_YF); const float* GW = (const float*)(a.ws() + WS_YB);
    const float* modl = (const float*)(a.ws() + WS_MOD) + (size_t)l * 9 * 6144;
    for (int row = gw; row < M; row += NGW) {
        const bool lat = row < M_LAT; const int bi = lat ? (row >> 13) : 8;
        const u32x4* hp = (const u32x4*)(H + (size_t)row * 1024); const u32x4 h0 = hp[lane], h1 = hp[64 + lane];
        const int ev[2] = {EIDX[(size_t)row * 128 + lane], EIDX[(size_t)row * 128 + 64 + lane]};
        const float gv[2] = {GW[(size_t)row * 128 + lane], GW[(size_t)row * 128 + 64 + lane]};
        float dv[2] = {0.f, 0.f};
#pragma unroll
        for (int half = 0; half < 2; ++half) {
#pragma unroll 1
            for (int kk0 = 0; kk0 < 64; kk0 += 8) { u32x4 ua[8], ub[8];
#pragma unroll
                for (int j = 0; j < 8; ++j) { const int e = __builtin_amdgcn_readlane(ev[half], kk0 + j); const u32x4* up = (const u32x4*)(PU + (size_t)e * 1024); ua[j] = up[lane]; ub[j] = up[64 + lane]; }
#pragma unroll
                for (int j = 0; j < 8; ++j) { float s = dot8bf(ua[j], h0, 0.f); s = dot8bf(ub[j], h1, s); s = wave_sum(s, lane); dv[half] = (lane == kk0 + j) ? s : dv[half]; } }
        }
        float act[2];
#pragma unroll
        for (int half = 0; half < 2; ++half) act[half] = gelu_erf(dv[half]) * gv[half];
        float acc[16];
#pragma unroll
        for (int j = 0; j < 16; ++j) acc[j] = 0.f;
#pragma unroll
        for (int half = 0; half < 2; ++half) {
#pragma unroll 1
            for (int kk0 = 0; kk0 < 64; kk0 += 8) { u32x4 va[8], vb[8];
#pragma unroll
                for (int j = 0; j < 8; ++j) { const int e = __builtin_amdgcn_readlane(ev[half], kk0 + j); const u32x4* vp = (const u32x4*)(PV + (size_t)e * 1024); va[j] = vp[lane]; vb[j] = vp[64 + lane]; }
#pragma unroll
                for (int j = 0; j < 8; ++j) { const float aw = __builtin_bit_cast(float, __builtin_amdgcn_readlane(__builtin_bit_cast(int, act[half]), kk0 + j));
                    f32x4 x0, x1, x2, x3; unpack8(va[j], x0, x1); unpack8(vb[j], x2, x3);
#pragma unroll
                    for (int t = 0; t < 4; ++t) { acc[t] += aw * x0[t]; acc[4 + t] += aw * x1[t]; acc[8 + t] += aw * x2[t]; acc[12 + t] += aw * x3[t]; } } }
        }
#if PROBE_HI > 0
        { bf16_t* dmp = (bf16_t*)(a.ws() + WS_Z + 264 * MiB) + (size_t)row * 1024;
          u32x4 w0, w1; w0.x = pk_bf16(acc[0], acc[1]); w0.y = pk_bf16(acc[2], acc[3]); w0.z = pk_bf16(acc[4], acc[5]); w0.w = pk_bf16(acc[6], acc[7]);
          w1.x = pk_bf16(acc[8], acc[9]); w1.y = pk_bf16(acc[10], acc[11]); w1.z = pk_bf16(acc[12], acc[13]); w1.w = pk_bf16(acc[14], acc[15]);
          *(u32x4*)(dmp + lane * 8) = w0; *(u32x4*)(dmp + 512 + lane * 8) = w1; }
#endif
        float* xr = lat ? xlat + (size_t)row * 1024 : xctx + (size_t)(row - M_LAT) * 1024;
#if PROBE_HI > 0
        if (row < 16384) { float* xb = (float*)(a.ws() + WS_Z + 396 * MiB) + (size_t)row * 1024; ((f32x4*)(xb + lane * 8))[0] = ((f32x4*)(xr + lane * 8))[0]; ((f32x4*)(xb + lane * 8))[1] = ((f32x4*)(xr + lane * 8))[1];
            ((f32x4*)(xb + 512 + lane * 8))[0] = ((f32x4*)(xr + 512 + lane * 8))[0]; ((f32x4*)(xb + 512 + lane * 8))[1] = ((f32x4*)(xr + 512 + lane * 8))[1]; }
#endif
        const float* gt = modl + bi * 6144 + 5 * 1024;
        f32x4* x0p = (f32x4*)(xr + lane * 8); f32x4* x1p = (f32x4*)(xr + 512 + lane * 8);
        const f32x4* g0p = (const f32x4*)(gt + lane * 8); const f32x4* g1p = (const f32x4*)(gt + 512 + lane * 8);
        x0p[0] = x0p[0] + g0p[0] * (f32x4){acc[0], acc[1], acc[2], acc[3]}; x0p[1] = x0p[1] + g0p[1] * (f32x4){acc[4], acc[5], acc[6], acc[7]};
        x1p[0] = x1p[0] + g1p[0] * (f32x4){acc[8], acc[9], acc[10], acc[11]}; x1p[1] = x1p[1] + g1p[1] * (f32x4){acc[12], acc[13], acc[14], acc[15]};
    }
}


#if PROBE_HI > 0
#ifndef CHECK_SUB
#define CHECK_SUB 0
#endif
#ifndef CHECK_ROUND
#define CHECK_ROUND 15
#endif
__device__ __forceinline__ float bfbits2f(bf16_t b) { return __uint_as_float(((unsigned)b) << 16); }
__device__ __forceinline__ bool bad_rel(float got, float ref, float rel, float abs_) { const float d = fabsf(got - ref); return !(d <= rel * fabsf(ref) + abs_); }
__device__ __forceinline__ void check_phase(const KA a) {
    if (blockIdx.x != 0) return;
    __shared__ unsigned fm[4];
    const int t = threadIdx.x;
    if (t < 4) fm[t] = 0u;
    __syncthreads();
    unsigned char* ws = a.ws();
#if CHECK_ROUND == 1
    {
        const int b = t % 9, j = (t * 37) % 6144; const float* cv = (b < 8) ? a.in(I_C) + b * 1024 : a.in(I_CCTX);
        float s = a.in(I_ADAB)[j];
        for (int k = 0; k < 1024; ++k) { const float c = cv[k]; s += (c / (1.f + expf(-c))) * a.in(I_ADAW)[(size_t)k * 6144 + j]; }
        const float got = ((const float*)(ws + WS_MOD))[b * 6144 + j];
        if (bad_rel(got, s, 2e-3f, 2e-3f)) atomicOr(&fm[0], 1u);
    }
    {
        const int row = (int)(((long)t * 131071) % M), col = (t * 17) % 1024;
        const bool lat = row < M_LAT; const int bi = lat ? (row >> 13) : 8;
        const float* xr = lat ? a.in(I_X) + (size_t)row * 1024 : a.in(I_CTX) + (size_t)(row - M_LAT) * 1024;
        float ms = 0.f; for (int k = 0; k < 1024; ++k) ms += xr[k] * xr[k];
        const float rs = 1.0f / sqrtf(ms / 1024.f + 1e-6f);
        const float* modl = (const float*)(ws + WS_MOD);
        const float y = xr[col] * rs * a.in(I_N1G)[col] * (1.f + modl[bi * 6144 + 1024 + col]) + modl[bi * 6144 + col];
        const bf16_t* HB = (const bf16_t*)(ws + WS_H);
        if (bad_rel(bfbits2f(HB[(size_t)row * 1024 + col]), y, 1e-2f, 1e-2f)) atomicOr(&fm[1], 1u);
        const int zc = (t * 29) % 3488; float z = 0.f;
        for (int k = 0; k < 1024; ++k) z += bfbits2f(HB[(size_t)row * 1024 + k]) * a.in(I_WIN)[(size_t)k * P_IN + zc];
        const bf16_t* ZR = (const bf16_t*)(ws + WS_Z);
        if (bad_rel(bfbits2f(ZR[(size_t)row * NZR + zc]), z, 2e-2f, 4e-2f)) atomicOr(&fm[2], 1u);
        const int n = (t * 7) % 3488, k = (t * 13) % 1024; const bf16_t* WrT = (const bf16_t*)(ws + WS_WB + WB_WR);
        const unsigned want = pk_bf16(a.in(I_WIN)[(size_t)k * P_IN + n], 0.f) & 0xffffu;
        if ((unsigned)WrT[(size_t)n * 1024 + k] != want) atomicOr(&fm[3], 1u);
    }
#endif

#if CHECK_ROUND == 2
    {
        const int wv = t >> 6, lane = t & 63;
        if (wv < 2) {
            const int b = 1, h = 3, d = wv, l = 0;
            __shared__ float sh[2][8][64];
            __shared__ float Sst[2][64][65];
            float* S = &Sst[wv][lane][0];
            float (*L)[64] = sh[wv];
            const bf16_t* ZR = (const bf16_t*)(ws + WS_Z); const float* smu = a.in(I_SMU) + (size_t)l * 2 * P_RWKV;
            const bf16_t* Yd = (const bf16_t*)(ws + (d ? WS_YB : WS_YF)); const float* BON = (const float*)(ws + WS_BON);
            const int hc = h * 64 + lane;
            const int cols[5] = {hc, 1024 + hc, 2048 + hc, C_W1 + d * 64 + lane, C_A1 + d * 64 + lane};
#pragma nounroll
            for (int k = 0; k < 64; ++k) S[k] = 0.f;
            bool bad = false, badb = false;
            for (int step = 0; step < 296; ++step) {
                const int seg = step >= 256, p = seg ? step - 256 : step, len = seg ? SEQ : CTXL; const int base = seg ? b * SEQ : M_LAT + b * CTXL;
                const int tt = d ? len - 1 - p : p;
                float z[5];
#pragma unroll
                for (int g = 0; g < 5; ++g) { const int c = cols[g];
                    const float zc = bfbits2f(ZR[(size_t)(base + tt) * NZR + c]);
                    const float zp = tt > 0 ? bfbits2f(ZR[(size_t)(base + tt - 1) * NZR + c]) : 0.f;
                    const float zn = tt < len - 1 ? bfbits2f(ZR[(size_t)(base + tt + 1) * NZR + c]) : 0.f;
                    z[g] = zc + smu[c] * (zp - zc) + smu[P_RWKV + c] * (zn - zc); }
                L[0][lane] = tanhf(z[3]); L[1][lane] = z[4];
                __builtin_amdgcn_wave_barrier(); asm volatile("s_waitcnt lgkmcnt(0)" ::: "memory");
                float wl = a.in(I_W0)[(l * 2 + d) * 1024 + hc], al = a.in(I_A0)[(l * 2 + d) * 1024 + hc];
#pragma nounroll
                for (int j = 0; j < 64; ++j) { wl += L[0][j] * a.in(I_W2)[((size_t)(l * 2 + d) * 64 + j) * 1024 + hc]; al += L[1][j] * a.in(I_A2)[((size_t)(l * 2 + d) * 64 + j) * 1024 + hc]; }
                const float wlog = -log1pf(expf(-wl)) - 0.5f; const float dec = expf(-expf(wlog));
                const float av = 1.f / (1.f + expf(-al));
                const float kkr = z[1] * a.in(I_KK)[l * 1024 + hc];
                L[7][lane] = kkr * kkr;
                __builtin_amdgcn_wave_barrier(); asm volatile("s_waitcnt lgkmcnt(0)" ::: "memory");
                float n2 = 0.f; for (int j = 0; j < 64; ++j) n2 += L[7][j];
                const float kk = kkr / fmaxf(sqrtf(n2), 1e-12f);
                const float kd = z[1] * (1.f + (av - 1.f) * a.in(I_KA)[l * 1024 + hc]);
                L[2][lane] = kk; L[3][lane] = kk * av; L[4][lane] = kd; L[5][lane] = z[0]; L[6][lane] = dec;
                __builtin_amdgcn_wave_barrier(); asm volatile("s_waitcnt lgkmcnt(0)" ::: "memory");
                float sa = 0.f;
#pragma nounroll
                for (int k = 0; k < 64; ++k) sa += S[k] * L[2][k];
                float y = 0.f, bon = 0.f;
#pragma nounroll
                for (int k = 0; k < 64; ++k) { S[k] = S[k] * L[6][k] - sa * L[3][k] + z[2] * L[4][k]; y += S[k] * L[5][k]; }
                for (int k = 0; k < 64; ++k) bon += L[5][k] * L[4][k] * a.in(I_RK)[l * 1024 + h * 64 + k];
                if (step >= 200) {
                    const float got = bfbits2f(Yd[(size_t)(base + tt) * 1024 + hc]);
                    if (bad_rel(got, y, 4e-2f, 0.15f)) bad = true;
                    const float gb = BON[((size_t)d * M + base + tt) * 16 + h];
                    if (bad_rel(gb, bon, 2e-2f, 2e-2f)) badb = true;
                }
                __builtin_amdgcn_wave_barrier(); asm volatile("s_waitcnt lgkmcnt(0)" ::: "memory");
            }
            if (bad) atomicOr(&fm[d], 1u);
            if (badb) atomicOr(&fm[2 + d], 1u);
        }
    }
#endif
#if CHECK_ROUND == 3
    {
        const int row = (int)(((long)t * 131071) % M), ch = (t * 17) % 1024, gc = (t * 23) % 2048;
        const bf16_t* HB = (const bf16_t*)(ws + WS_H); const bf16_t* WgT = (const bf16_t*)(ws + WS_WB + WB_WG);
        { const int n = (t * 7) % 2048, k = (t * 13) % 1024; const unsigned want = pk_bf16(a.in(I_WIN)[(size_t)k * P_IN + P_RWKV + 2048 + n], 0.f) & 0xffffu;
          if ((unsigned)WgT[(size_t)n * 1024 + k] != want) atomicOr(&fm[0], 1u); }
        float z1 = 0.f, z2 = 0.f, zg = 0.f, zg2 = 0.f;
        for (int k = 0; k < 1024; ++k) { const float hv = bfbits2f(HB[(size_t)row * 1024 + k]); const float* wr = a.in(I_WIN) + (size_t)k * P_IN;
            z1 += hv * wr[P_RWKV + ch]; z2 += hv * wr[P_RWKV + 1024 + ch]; zg += hv * wr[P_RWKV + 2048 + gc]; zg2 += hv * bfbits2f(WgT[(size_t)gc * 1024 + k]); }
        const float u = z1 / (1.f + expf(-z2)), g = 1.f / (1.f + expf(-(zg + a.in(I_GATEB)[gc]))), g2 = 1.f / (1.f + expf(-(zg2 + a.in(I_GATEB)[gc])));
        const bf16_t* U = (const bf16_t*)(ws + WS_Z); const bf16_t* G = (const bf16_t*)(ws + WS_Z + 132 * MiB);
        if (bad_rel(bfbits2f(G[(size_t)row * 2048 + gc]), g2, 2e-2f, 1e-2f)) atomicOr(&fm[1], 1u);
        if (bad_rel(bfbits2f(U[(size_t)row * 1024 + ch]), u, 3e-2f, 3e-2f)) atomicOr(&fm[2], 1u);
        if (bad_rel(bfbits2f(G[(size_t)row * 2048 + gc]), g, 2e-2f, 1e-2f)) atomicOr(&fm[3], 1u);
    }
#endif

#if CHECK_ROUND == 4
    {
        __shared__ unsigned cnt; __shared__ unsigned mx;
        if (t == 0) { cnt = 0u; mx = 0u; }
        __syncthreads();
        const bf16_t* HB = (const bf16_t*)(ws + WS_H); const bf16_t* WgT = (const bf16_t*)(ws + WS_WB + WB_WG); const bf16_t* G = (const bf16_t*)(ws + WS_Z + 132 * MiB);
        for (int rep = 0; rep < 4; ++rep) {
            const int sidx = t + 512 * rep; const int row = (int)(((long)sidx * 131071) % M), gc = (sidx * 23) % 2048;
            float zg2 = 0.f;
            for (int k = 0; k < 1024; ++k) zg2 += bfbits2f(HB[(size_t)row * 1024 + k]) * bfbits2f(WgT[(size_t)gc * 1024 + k]);
            const float g2 = 1.f / (1.f + expf(-(zg2 + a.in(I_GATEB)[gc])));
            const float d = fabsf(bfbits2f(G[(size_t)row * 2048 + gc]) - g2);
            if (!(d <= 0.01f)) { atomicAdd(&cnt, 1u); atomicMax(&mx, __float_as_uint(d != d ? 1e9f : d)); }
        }
        __syncthreads();
        if (t == 0) { const unsigned c = cnt; const float m = __uint_as_float(mx);
            const unsigned cb = c == 0 ? 0u : (c <= 2 ? 1u : (c <= 8 ? 2u : (c <= 64 ? 3u : (c <= 512 ? 4u : 5u))));
            const unsigned mb = m < 0.02f ? 0u : (m < 0.05f ? 1u : (m < 0.15f ? 2u : (m < 0.5f ? 3u : 4u)));
            fm[0] = 0; fm[1] = 0; fm[2] = 0; fm[3] = 0; ((unsigned*)(ws + WS_CTL))[9] = 5u * cb + mb; }
        __syncthreads();
    }
#endif

#if CHECK_ROUND == 6
    {
        __shared__ unsigned cnt; __shared__ unsigned mx;
        if (t == 0) { cnt = 0u; mx = 0u; }
        __syncthreads();
        const bf16_t* HB = (const bf16_t*)(ws + WS_H); const bf16_t* WgT = (const bf16_t*)(ws + WS_WB + WB_WG); const bf16_t* G = (const bf16_t*)(ws + WS_Z + 132 * MiB);
        for (int rep = 0; rep < 4; ++rep) {
            const int sidx = t + 512 * rep; const int row = (int)(((long)sidx * 131071) % M), gc = (sidx * 23) % 2048;
            float zg2 = 0.f;
            for (int k = 0; k < 1024; ++k) zg2 += bfbits2f(HB[(size_t)row * 1024 + k]) * bfbits2f(WgT[(size_t)gc * 1024 + k]);
            const float d = fabsf(bfbits2f(G[(size_t)row * 2048 + gc]) - zg2);
            if (!(d <= 0.02f + 0.01f * fabsf(zg2))) { atomicAdd(&cnt, 1u); atomicMax(&mx, __float_as_uint(d != d ? 1e9f : d)); }
        }
        __syncthreads();
        if (t == 0) { const unsigned c = cnt; const float m = __uint_as_float(mx);
            const unsigned cb = c == 0 ? 0u : (c <= 2 ? 1u : (c <= 8 ? 2u : (c <= 64 ? 3u : (c <= 512 ? 4u : 5u))));
            const unsigned mb = m < 0.05f ? 0u : (m < 0.2f ? 1u : (m < 1.0f ? 2u : (m < 5.f ? 3u : 4u)));
            ((unsigned*)(ws + WS_CTL))[9] = 5u * cb + mb; }
        __syncthreads();
    }
#endif
#if CHECK_ROUND == 7
    {
        const bf16_t* HB = (const bf16_t*)(ws + WS_H); const bf16_t* Q = (const bf16_t*)(ws + WS_Z); const bf16_t* SKB = (const bf16_t*)(ws + WS_WB + WB_SK);
        const int* EIDX = (const int*)(ws + WS_YF); const float* GWp = (const float*)(ws + WS_YB);
        { const int row = (int)(((long)t * 131071) % M), qc = (t * 29) % 2048; float z = 0.f;
          for (int k = 0; k < 1024; ++k) z += bfbits2f(HB[(size_t)row * 1024 + k]) * a.in(I_WQ)[(size_t)k * 2048 + qc];
          if (bad_rel(bfbits2f(Q[(size_t)row * 2048 + qc]), z, 2e-2f, 4e-2f)) atomicOr(&fm[0], 1u); }
        __shared__ float sc[32][2][128];
        if (t < 32) {
            const int tok = (int)(((long)t * 104729) % M), h = t & 7;
            for (int c = 0; c < 2; ++c) for (int n = 0; n < 128; ++n) { float s = 0.f;
                for (int dd = 0; dd < 128; ++dd) s += bfbits2f(Q[(size_t)tok * 2048 + h * 256 + c * 128 + dd]) * bfbits2f(SKB[((size_t)(h * 2 + c) * 128 + n) * 128 + dd]);
                sc[t][c][n] = s; }
            float tv[2][16]; int ti[2][16];
            for (int c = 0; c < 2; ++c) for (int r = 0; r < 16; ++r) { float best = -1e30f; int bi_ = 0;
                for (int n = 0; n < 128; ++n) { const float v = sc[t][c][n]; if (v > best) { best = v; bi_ = n; } }
                sc[t][c][bi_] = -1e30f; float* tvp = &sc[t][c][0]; (void)tvp;
                if (c == 0) { tv[0][r] = best; ti[0][r] = bi_; } else { tv[1][r] = best; ti[1][r] = bi_; } }
            unsigned used[8] = {0u, 0u, 0u, 0u, 0u, 0u, 0u, 0u};
            int miss = 0; float wsum = 0.f, w0 = 0.f; float cv[16]; int ce_[16];
            for (int r = 0; r < 16; ++r) { float best = -1e30f; int bp = 0;
                for (int p = 0; p < 256; ++p) { if (used[p >> 5] & (1u << (p & 31))) continue; const float v = tv[0][p >> 4] + tv[1][p & 15]; if (v > best) { best = v; bp = p; } }
                used[bp >> 5] |= 1u << (bp & 31); cv[r] = best; ce_[r] = ti[0][bp >> 4] * 128 + ti[1][bp & 15]; }
            w0 = cv[0]; for (int r = 0; r < 16; ++r) wsum += expf(cv[r] - w0);
            for (int r = 0; r < 16; ++r) { bool found = false; float gw_k = 0.f;
                for (int q = 0; q < 16; ++q) if (EIDX[(size_t)tok * 128 + h * 16 + q] == ce_[r]) { found = true; gw_k = GWp[(size_t)tok * 128 + h * 16 + q]; }
                if (!found) ++miss; else if (bad_rel(gw_k, expf(cv[r] - w0) / wsum, 5e-2f, 5e-3f)) ++miss; }
            if (miss > 2) atomicOr(&fm[1], 1u);
        }
        {
            const bf16_t* PU = (const bf16_t*)(ws + WS_PT); const bf16_t* PV = (const bf16_t*)(ws + WS_PT + 32 * MiB); const bf16_t* DMP = (const bf16_t*)(ws + WS_Z + 264 * MiB);
            const int tok = (int)(((long)(t >> 3) * 104729 + 17) % M), dcol = ((t & 7) * 131 + (t >> 3) * 7) % 1024; float o = 0.f;
            for (int e = 0; e < 128; ++e) { const int ex = EIDX[(size_t)tok * 128 + e]; if (ex < 0 || ex >= 16384) { o = __builtin_nanf(""); break; } float dt = 0.f;
                for (int k = 0; k < 1024; ++k) dt += bfbits2f(PU[(size_t)ex * 1024 + k]) * bfbits2f(HB[(size_t)tok * 1024 + k]);
                const float ge = 0.5f * dt * (1.f + erff(dt * 0.70710678f));
                o += ge * GWp[(size_t)tok * 128 + e] * bfbits2f(PV[(size_t)ex * 1024 + dcol]); }
            if (bad_rel(bfbits2f(DMP[(size_t)tok * 1024 + dcol]), o, 3e-2f, 2e-2f)) atomicOr(&fm[2], 1u);
        }
    }
#endif
#if CHECK_ROUND == 8
    {
        const bf16_t* A1 = (const bf16_t*)(ws + WS_YF); const bf16_t* A2 = (const bf16_t*)(ws + WS_YB); const bf16_t* O2 = (const bf16_t*)(ws + WS_Z + 396 * MiB);
        const bf16_t* SG = (const bf16_t*)(ws + WS_PT); const bf16_t* U = (const bf16_t*)(ws + WS_Z); const bf16_t* G = (const bf16_t*)(ws + WS_Z + 132 * MiB); const bf16_t* MB = (const bf16_t*)(ws + WS_H);
        { const int row = (int)(((long)t * 131071) % 32768), c = (t * 17) % 1024; float g = 0.f;
          for (int k = 0; k < 160; ++k) g += bfbits2f(SG[(size_t)row * 256 + k]) * a.in(I_G2)[(size_t)k * 1024 + c];
          const float want = bfbits2f(O2[(size_t)row * 1024 + c]) * g;
          if (bad_rel(bfbits2f(A1[(size_t)row * 1024 + c]), want, 3e-2f, 2e-2f)) atomicOr(&fm[0], 1u); }
        { const int row = (int)(((long)t * 131071) % M), c = (t * 17) % 1024; const bool lat = row < M_LAT; const int stride = lat ? 64 : 1; const int pos = lat ? ((row & (SEQ - 1)) >> 6) : ((row - M_LAT) & (CTXL - 1)); const int len = lat ? 128 : CTXL;
          float mean = 0.f, var = 0.f, mine = 0.f;
          for (int pass = 0; pass < 2; ++pass) { float s = 0.f;
              for (int ch = 0; ch < 1024; ++ch) { float acc = 0.f;
                  for (int k = 0; k < 31; ++k) { const int pp = pos + k - 15; if (pp >= 0 && pp < len) acc += bfbits2f(U[(size_t)(row + (k - 15) * stride) * 1024 + ch]) * a.in(I_CONVW)[k * 1024 + ch]; }
                  if (pass == 0) s += acc; else { s += (acc - mean) * (acc - mean); if (ch == c) mine = acc; } }
              if (pass == 0) mean = s / 1024.f; else var = s / 1024.f; }
          const float y = (mine - mean) / sqrtf(var + 1e-5f) * a.in(I_CNG)[c] + a.in(I_CNB)[c]; const float want = y / (1.f + expf(-y));
          if (bad_rel(bfbits2f(A2[(size_t)row * 1024 + c]), want, 3e-2f, 2e-2f)) atomicOr(&fm[1], 1u); }
        { const int row = (int)(((long)t * 131071) % M), c = (t * 19) % 1024; float ya = 0.f, yb = 0.f;
          for (int k = 0; k < 1024; ++k) { ya += bfbits2f(A1[(size_t)row * 1024 + k]) * a.in(I_WOA)[(size_t)k * 1024 + c]; yb += bfbits2f(A2[(size_t)row * 1024 + k]) * a.in(I_WOB)[(size_t)k * 1024 + c]; }
          const float want = bfbits2f(G[(size_t)row * 2048 + c]) * ya + bfbits2f(G[(size_t)row * 2048 + 1024 + c]) * yb;
          if (bad_rel(bfbits2f(MB[(size_t)row * 1024 + c]), want, 3e-2f, 3e-2f)) atomicOr(&fm[2], 1u); }
        { const int row = (int)(((long)t * 131071) % M), c = (t * 23) % 1024; const bool lat = row < M_LAT; const int bi = lat ? (row >> 13) : 8; float y = 0.f;
          for (int k = 0; k < 1024; ++k) y += bfbits2f(MB[(size_t)row * 1024 + k]) * a.in(I_WOUT)[(size_t)k * 1024 + c];
          const float xin = lat ? a.in(I_X)[(size_t)row * 1024 + c] : a.in(I_CTX)[(size_t)(row - M_LAT) * 1024 + c];
          const float want = xin + ((const float*)(ws + WS_MOD))[bi * 6144 + 2048 + c] * y;
          const float got = lat ? a.out()[(size_t)row * 1024 + c] : ((const float*)(ws + WS_XCTX))[(size_t)(row - M_LAT) * 1024 + c];
          if (bad_rel(got, want, 1e-2f, 2e-2f)) atomicOr(&fm[3], 1u); }
    }
#endif
#if CHECK_ROUND == 9
    {
        const bf16_t* YF = (const bf16_t*)(ws + WS_YF); const bf16_t* YB = (const bf16_t*)(ws + WS_YB); const bf16_t* ZR = (const bf16_t*)(ws + WS_Z); const bf16_t* O2 = (const bf16_t*)(ws + WS_Z + 396 * MiB);
        const float* BON = (const float*)(ws + WS_BON); const bf16_t* SG = (const bf16_t*)(ws + WS_PT); const float* smu = a.in(I_SMU);
        { const int row = (int)(((long)t * 131071) % 32768), c = (t * 17) % 1024, hd = c >> 6; const int tt = row & (SEQ - 1);
          float mean = 0.f, var = 0.f;
          for (int j = 0; j < 64; ++j) mean += bfbits2f(YF[(size_t)row * 1024 + hd * 64 + j]) + bfbits2f(YB[(size_t)row * 1024 + hd * 64 + j]);
          mean /= 64.f;
          for (int j = 0; j < 64; ++j) { const float o = bfbits2f(YF[(size_t)row * 1024 + hd * 64 + j]) + bfbits2f(YB[(size_t)row * 1024 + hd * 64 + j]) - mean; var += o * o; }
          var /= 64.f;
          const float o = bfbits2f(YF[(size_t)row * 1024 + c]) + bfbits2f(YB[(size_t)row * 1024 + c]);
          const float zc = bfbits2f(ZR[(size_t)row * NZR + C_V + c]), zp = tt > 0 ? bfbits2f(ZR[(size_t)(row - 1) * NZR + C_V + c]) : 0.f, zn = tt < SEQ - 1 ? bfbits2f(ZR[(size_t)(row + 1) * NZR + C_V + c]) : 0.f;
          const float vv = zc + smu[C_V + c] * (zp - zc) + smu[P_RWKV + C_V + c] * (zn - zc);
          const float want = (o - mean) / sqrtf(var + 64e-5f) * a.in(I_LNXG)[c] + a.in(I_LNXB)[c] + (BON[(size_t)row * 16 + hd] + BON[((size_t)M + row) * 16 + hd]) * vv;
          if (bad_rel(bfbits2f(O2[(size_t)row * 1024 + c]), want, 3e-2f, 3e-2f)) atomicOr(&fm[0], 1u); }
        { const int row = (int)(((long)t * 131071) % M), k = (t * 7) % 256; const bool lat = row < M_LAT; const int tt = lat ? (row & (SEQ - 1)) : ((row - M_LAT) & (CTXL - 1)); const int len = lat ? SEQ : CTXL;
          float want = 0.f;
          if (k < 160) { const float zc = bfbits2f(ZR[(size_t)row * NZR + C_G1 + k]), zp = tt > 0 ? bfbits2f(ZR[(size_t)(row - 1) * NZR + C_G1 + k]) : 0.f, zn = tt < len - 1 ? bfbits2f(ZR[(size_t)(row + 1) * NZR + C_G1 + k]) : 0.f;
              const float z = zc + smu[C_G1 + k] * (zp - zc) + smu[P_RWKV + C_G1 + k] * (zn - zc); want = 1.f / (1.f + expf(-z)); }
          if (bad_rel(bfbits2f(SG[(size_t)row * 256 + k]), want, 2e-2f, 1e-2f)) atomicOr(&fm[1], 1u); }
    }
#endif
#if CHECK_ROUND == 10
    {
        const float* XB = (const float*)(ws + WS_Z + 396 * MiB); const bf16_t* DMP = (const bf16_t*)(ws + WS_Z + 264 * MiB); const bf16_t* HB = (const bf16_t*)(ws + WS_H);
        const float* mod0 = (const float*)(ws + WS_MOD);
        { const int row = (int)(((long)t * 131071) % 16384), c = (t * 17) % 1024, bi = row >> 13;
          const float want = XB[(size_t)row * 1024 + c] + mod0[bi * 6144 + 5120 + c] * bfbits2f(DMP[(size_t)row * 1024 + c]);
          if (bad_rel(a.out()[(size_t)row * 1024 + c], want, 1e-2f, 1e-2f)) atomicOr(&fm[0], 1u);
          float ms = 0.f; for (int k = 0; k < 1024; ++k) { const float xv = XB[(size_t)row * 1024 + k]; ms += xv * xv; }
          const float rs = 1.0f / sqrtf(ms / 1024.f + 1e-6f);
          const float y = XB[(size_t)row * 1024 + c] * rs * a.in(I_N2G)[c] * (1.f + mod0[bi * 6144 + 4096 + c]) + mod0[bi * 6144 + 3072 + c];
          if (bad_rel(bfbits2f(HB[(size_t)row * 1024 + c]), y, 1e-2f, 1e-2f)) atomicOr(&fm[1], 1u); }
        { const int b = t % 9, j = (t * 37) % 6144; const float* cv = (b < 8) ? a.in(I_C) + b * 1024 : a.in(I_CCTX);
          float s = a.in(I_ADAB)[6144 + j];
          for (int k = 0; k < 1024; ++k) { const float c = cv[k]; s += (c / (1.f + expf(-c))) * a.in(I_ADAW)[(size_t)(1024 + k) * 6144 + j]; }
          if (bad_rel(mod0[9 * 6144 + b * 6144 + j], s, 2e-3f, 2e-3f)) atomicOr(&fm[2], 1u); }
        { const unsigned char* wb1 = ws + WS_WB + WB_LAYER; const float* win1 = a.in(I_WIN) + (size_t)1024 * P_IN;
          const int n = (t * 7) % 3488, k = (t * 13) % 1024;
          if ((unsigned)((const bf16_t*)(wb1 + WB_WR))[(size_t)n * 1024 + k] != (pk_bf16(win1[(size_t)k * P_IN + n], 0.f) & 0xffffu)) atomicOr(&fm[3], 1u);
          const int n2 = (t * 11) % 2048;
          if ((unsigned)((const bf16_t*)(wb1 + WB_Q))[(size_t)n2 * 1024 + k] != (pk_bf16(a.in(I_WQ)[(size_t)2097152 + (size_t)k * 2048 + n2], 0.f) & 0xffffu)) atomicOr(&fm[3], 1u);
          const int n3 = (t * 5) % 1024;
          if ((unsigned)((const bf16_t*)(wb1 + WB_OUT))[(size_t)n3 * 1024 + k] != (pk_bf16(a.in(I_WOUT)[(size_t)1048576 + (size_t)k * 1024 + n3], 0.f) & 0xffffu)) atomicOr(&fm[3], 1u);
          if ((unsigned)((const bf16_t*)(wb1 + WB_OA))[(size_t)n3 * 1024 + k] != (pk_bf16(a.in(I_WOA)[(size_t)1048576 + (size_t)k * 1024 + n3], 0.f) & 0xffffu)) atomicOr(&fm[3], 1u);
          if ((unsigned)((const bf16_t*)(wb1 + WB_OB))[(size_t)n3 * 1024 + k] != (pk_bf16(a.in(I_WOB)[(size_t)1048576 + (size_t)k * 1024 + n3], 0.f) & 0xffffu)) atomicOr(&fm[3], 1u); }
    }
#endif
#if CHECK_ROUND == 13
    {
        __shared__ float xs[1024], hs[1024], qs[2048], ss[16][128], actv[128], red[512]; __shared__ int eix[128]; __shared__ float acc_num, acc_den, b_num, b_den, ab_num; __shared__ unsigned nmatch; __shared__ float actb[128];
        const float* XB = (const float*)(ws + WS_Z + 396 * MiB); const bf16_t* DMP = (const bf16_t*)(ws + WS_Z + 264 * MiB); const float* mod0 = (const float*)(ws + WS_MOD); const int* EIDX = (const int*)(ws + WS_YF);
        if (t == 0) { acc_num = 0.f; acc_den = 0.f; nmatch = 0u; b_num = 0.f; b_den = 0.f; ab_num = 0.f; }
        __syncthreads();
        for (int smp = 0; smp < 4; ++smp) {
            const int row = 1000 + smp * 4099, bi = row >> 13;
            xs[t] = XB[(size_t)row * 1024 + t]; xs[t + 512] = XB[(size_t)row * 1024 + t + 512];
            red[t] = xs[t] * xs[t] + xs[t + 512] * xs[t + 512];
            __syncthreads();
            for (int o = 256; o > 0; o >>= 1) { if (t < o) red[t] += red[t + o]; __syncthreads(); }
            const float rs = 1.0f / sqrtf(red[0] / 1024.f + 1e-6f);
            for (int c = t; c < 1024; c += 512) hs[c] = xs[c] * rs * a.in(I_N2G)[c] * (1.f + mod0[bi * 6144 + 4096 + c]) + mod0[bi * 6144 + 3072 + c];
            __syncthreads();
            for (int j = t; j < 2048; j += 512) { float q = 0.f; for (int k = 0; k < 1024; ++k) q += hs[k] * a.in(I_WQ)[(size_t)k * 2048 + j]; qs[j] = q; }
            __syncthreads();
            for (int j = t; j < 2048; j += 512) { const int hc2 = j >> 7, n = j & 127; float s = 0.f; for (int dd = 0; dd < 128; ++dd) s += qs[hc2 * 128 + dd] * a.in(I_SUBK)[((size_t)hc2 * 128 + n) * 128 + dd]; ss[hc2][n] = s; }
            __syncthreads();
            if (t < 8) { const int h = t; float tv[2][16]; int ti[2][16];
                for (int c = 0; c < 2; ++c) for (int r = 0; r < 16; ++r) { float best = -1e30f; int bn = 0; for (int n = 0; n < 128; ++n) { const float v = ss[h * 2 + c][n]; if (v > best) { best = v; bn = n; } } ss[h * 2 + c][bn] = -1e30f; tv[c][r] = best; ti[c][r] = bn; }
                unsigned used[8] = {0u, 0u, 0u, 0u, 0u, 0u, 0u, 0u}; float cv[16]; float wsum = 0.f;
                for (int r = 0; r < 16; ++r) { float best = -1e30f; int bp = 0; for (int p = 0; p < 256; ++p) { if (used[p >> 5] & (1u << (p & 31))) continue; const float v = tv[0][p >> 4] + tv[1][p & 15]; if (v > best) { best = v; bp = p; } }
                    used[bp >> 5] |= 1u << (bp & 31); cv[r] = best; eix[h * 16 + r] = ti[0][bp >> 4] * 128 + ti[1][bp & 15]; }
                for (int r = 0; r < 16; ++r) wsum += expf(cv[r] - cv[0]);
                for (int r = 0; r < 16; ++r) actv[h * 16 + r] = expf(cv[r] - cv[0]) / wsum; }
            __syncthreads();
            if (t < 128) { const int ex = eix[t]; float dt = 0.f; for (int k = 0; k < 1024; ++k) dt += hs[k] * a.in(I_PU)[(size_t)ex * 1024 + k];
                actv[t] = 0.5f * dt * (1.f + erff(dt * 0.70710678f)) * actv[t];
                bool fnd = false; for (int q = 0; q < 16; ++q) fnd |= (EIDX[(size_t)row * 128 + (t >> 4) * 16 + q] == ex); if (fnd) atomicAdd(&nmatch, 1u); }
            if (t < 128) { const bf16_t* HBk = (const bf16_t*)(ws + WS_H); const bf16_t* PUk = (const bf16_t*)(ws + WS_PT); const float* GWk = (const float*)(ws + WS_YB);
                const int ex = EIDX[(size_t)row * 128 + t]; float dt = 0.f; for (int k = 0; k < 1024; ++k) dt += bfbits2f(HBk[(size_t)row * 1024 + k]) * bfbits2f(PUk[(size_t)ex * 1024 + k]);
                actb[t] = 0.5f * dt * (1.f + erff(dt * 0.70710678f)) * GWk[(size_t)row * 128 + t]; }
            __syncthreads();
            float num = 0.f, den = 0.f, bn = 0.f, bd = 0.f, abn = 0.f;
            for (int c = t; c < 1024; c += 512) { float o = 0.f; for (int e = 0; e < 128; ++e) o += actv[e] * a.in(I_PV)[(size_t)eix[e] * 1024 + c]; const float dm = bfbits2f(DMP[(size_t)row * 1024 + c]); num += (o - dm) * (o - dm); den += o * o;
                float ob = 0.f; { const bf16_t* PVk = (const bf16_t*)(ws + WS_PT + 32 * MiB); for (int e2 = 0; e2 < 128; ++e2) ob += actb[e2] * bfbits2f(PVk[(size_t)EIDX[(size_t)row * 128 + e2] * 1024 + c]); }
                bn += (ob - dm) * (ob - dm); bd += ob * ob; abn += (o - ob) * (o - ob); }
            atomicAdd(&acc_num, num); atomicAdd(&acc_den, den); atomicAdd(&b_num, bn); atomicAdd(&b_den, bd); atomicAdd(&ab_num, abn);
            __syncthreads();
        }
        if (t == 0) { const float re = sqrtf(acc_num / fmaxf(acc_den, 1e-30f)); const unsigned eb = re < 0.03f ? 0u : (re < 0.1f ? 1u : (re < 0.3f ? 2u : (re < 1.0f ? 3u : 4u)));
            const float rb = sqrtf(b_num / fmaxf(b_den, 1e-30f)), rab = sqrtf(ab_num / fmaxf(acc_den, 1e-30f));
            const unsigned bb = rb < 0.03f ? 0u : (rb < 0.1f ? 1u : (rb < 0.3f ? 2u : (rb < 1.0f ? 3u : 4u))); const unsigned abb = rab < 0.03f ? 0u : (rab < 0.1f ? 1u : (rab < 0.3f ? 2u : (rab < 1.0f ? 3u : 4u)));
            (void)eb; ((unsigned*)(ws + WS_CTL))[9] = 5u * bb + abb; }
        __syncthreads();
    }
#endif
#if CHECK_ROUND == 11
    {
        __shared__ float xs[1024], hs[1024], qs[2048], ss[16][128], actv[128], red[512]; __shared__ int eix[128]; __shared__ float acc_num, acc_den; __shared__ unsigned nmatch;
        const float* XB = (const float*)(ws + WS_Z + 396 * MiB); const bf16_t* DMP = (const bf16_t*)(ws + WS_Z + 264 * MiB); const float* mod0 = (const float*)(ws + WS_MOD); const int* EIDX = (const int*)(ws + WS_YF);
        if (t == 0) { acc_num = 0.f; acc_den = 0.f; nmatch = 0u; }
        __syncthreads();
        for (int smp = 0; smp < 4; ++smp) {
            const int row = 1000 + smp * 4099, bi = row >> 13;
            xs[t] = XB[(size_t)row * 1024 + t]; xs[t + 512] = XB[(size_t)row * 1024 + t + 512];
            red[t] = xs[t] * xs[t] + xs[t + 512] * xs[t + 512];
            __syncthreads();
            for (int o = 256; o > 0; o >>= 1) { if (t < o) red[t] += red[t + o]; __syncthreads(); }
            const float rs = 1.0f / sqrtf(red[0] / 1024.f + 1e-6f);
            for (int c = t; c < 1024; c += 512) hs[c] = xs[c] * rs * a.in(I_N2G)[c] * (1.f + mod0[bi * 6144 + 4096 + c]) + mod0[bi * 6144 + 3072 + c];
            __syncthreads();
            for (int j = t; j < 2048; j += 512) { float q = 0.f; for (int k = 0; k < 1024; ++k) q += hs[k] * a.in(I_WQ)[(size_t)k * 2048 + j]; qs[j] = q; }
            __syncthreads();
            for (int j = t; j < 2048; j += 512) { const int hc2 = j >> 7, n = j & 127; float s = 0.f; for (int dd = 0; dd < 128; ++dd) s += qs[hc2 * 128 + dd] * a.in(I_SUBK)[((size_t)hc2 * 128 + n) * 128 + dd]; ss[hc2][n] = s; }
            __syncthreads();
            if (t < 8) { const int h = t; float tv[2][16]; int ti[2][16];
                for (int c = 0; c < 2; ++c) for (int r = 0; r < 16; ++r) { float best = -1e30f; int bn = 0; for (int n = 0; n < 128; ++n) { const float v = ss[h * 2 + c][n]; if (v > best) { best = v; bn = n; } } ss[h * 2 + c][bn] = -1e30f; tv[c][r] = best; ti[c][r] = bn; }
                unsigned used[8] = {0u, 0u, 0u, 0u, 0u, 0u, 0u, 0u}; float cv[16]; float wsum = 0.f;
                for (int r = 0; r < 16; ++r) { float best = -1e30f; int bp = 0; for (int p = 0; p < 256; ++p) { if (used[p >> 5] & (1u << (p & 31))) continue; const float v = tv[0][p >> 4] + tv[1][p & 15]; if (v > best) { best = v; bp = p; } }
                    used[bp >> 5] |= 1u << (bp & 31); cv[r] = best; eix[h * 16 + r] = ti[0][bp >> 4] * 128 + ti[1][bp & 15]; }
                for (int r = 0; r < 16; ++r) wsum += expf(cv[r] - cv[0]);
                for (int r = 0; r < 16; ++r) actv[h * 16 + r] = expf(cv[r] - cv[0]) / wsum; }
            __syncthreads();
            if (t < 128) { const int ex = eix[t]; float dt = 0.f; for (int k = 0; k < 1024; ++k) dt += hs[k] * a.in(I_PU)[(size_t)ex * 1024 + k];
                actv[t] = 0.5f * dt * (1.f + erff(dt * 0.70710678f)) * actv[t];
                bool fnd = false; for (int q = 0; q < 16; ++q) fnd |= (EIDX[(size_t)row * 128 + (t >> 4) * 16 + q] == ex); if (fnd) atomicAdd(&nmatch, 1u); }
            __syncthreads();
            float num = 0.f, den = 0.f;
            for (int c = t; c < 1024; c += 512) { float o = 0.f; for (int e = 0; e < 128; ++e) o += actv[e] * a.in(I_PV)[(size_t)eix[e] * 1024 + c]; const float dm = bfbits2f(DMP[(size_t)row * 1024 + c]); num += (o - dm) * (o - dm); den += o * o; }
            atomicAdd(&acc_num, num); atomicAdd(&acc_den, den);
            __syncthreads();
        }
        if (t == 0) { const float re = sqrtf(acc_num / fmaxf(acc_den, 1e-30f)); const unsigned eb = re < 0.03f ? 0u : (re < 0.1f ? 1u : (re < 0.3f ? 2u : (re < 1.0f ? 3u : 4u)));
            const unsigned nm = nmatch; const unsigned mb = nm >= 500 ? 0u : (nm >= 460 ? 1u : (nm >= 384 ? 2u : (nm >= 128 ? 3u : 4u)));
            ((unsigned*)(ws + WS_CTL))[9] = 5u * eb + mb; }
        __syncthreads();
    }
#endif
#if CHECK_ROUND == 12
    {
        const bf16_t* PU = (const bf16_t*)(ws + WS_PT); const bf16_t* PV = (const bf16_t*)(ws + WS_PT + 32 * MiB);
        for (int rep = 0; rep < 8; ++rep) { const int sidx = t + 512 * rep; const int e = (int)(((long)sidx * 7919) % 16384), k = (sidx * 13) % 1024;
            if ((unsigned)PU[(size_t)e * 1024 + k] != (pk_bf16(a.in(I_PU)[(size_t)e * 1024 + k], 0.f) & 0xffffu)) { atomicOr(&fm[0], 1u); if (e < 8192) atomicOr(&fm[2], 1u); }
            if ((unsigned)PV[(size_t)e * 1024 + k] != (pk_bf16(a.in(I_PV)[(size_t)e * 1024 + k], 0.f) & 0xffffu)) { atomicOr(&fm[1], 1u); if (e < 8192) atomicOr(&fm[3], 1u); } }
    }
#endif
#if CHECK_ROUND == 15
    {
        __shared__ float actb[128]; __shared__ float nm[2], dn[2]; __shared__ unsigned nbad, mxd, colmask;
        const bf16_t* DMP = (const bf16_t*)(ws + WS_Z + 264 * MiB); const int* EIDX = (const int*)(ws + WS_YF); const float* GWk = (const float*)(ws + WS_YB);
        const bf16_t* HBk = (const bf16_t*)(ws + WS_H); const bf16_t* PUk = (const bf16_t*)(ws + WS_PT); const bf16_t* PVk = (const bf16_t*)(ws + WS_PT + 32 * MiB);
        if (t < 2) { nm[t] = 0.f; dn[t] = 0.f; } if (t == 0) { nbad = 0u; mxd = 0u; colmask = 0u; }
        __syncthreads();
        const int rows8[8] = {1000, 5099, 9198, 13297, 21000, 33333, 50001, 66000};
        for (int smp = 0; smp < 8; ++smp) { const int row = rows8[smp];
            if (t < 128) { const int ex = EIDX[(size_t)row * 128 + t]; float dt = 0.f; for (int k = 0; k < 1024; ++k) dt += bfbits2f(HBk[(size_t)row * 1024 + k]) * bfbits2f(PUk[(size_t)ex * 1024 + k]);
                actb[t] = 0.5f * dt * (1.f + erff(dt * 0.70710678f)) * GWk[(size_t)row * 128 + t]; }
            __syncthreads();
            float bn = 0.f, bd = 0.f;
            for (int c = t; c < 1024; c += 512) { float ob = 0.f; for (int e2 = 0; e2 < 128; ++e2) ob += actb[e2] * bfbits2f(PVk[(size_t)EIDX[(size_t)row * 128 + e2] * 1024 + c]);
                const float dm = bfbits2f(DMP[(size_t)row * 1024 + c]); bn += (ob - dm) * (ob - dm); bd += ob * ob; const float dd = fabsf(ob - dm); if (!(dd <= 0.03f)) { atomicAdd(&nbad, 1u); atomicMax(&mxd, __float_as_uint(dd != dd ? 1e9f : dd)); atomicOr(&colmask, 1u << (c >> 7)); } }
            atomicAdd(&nm[smp >> 2], bn); atomicAdd(&dn[smp >> 2], bd);
            __syncthreads();
        }
        if (t == 0) { const unsigned c = nbad; const float m = __uint_as_float(mxd);
            const unsigned cb = c == 0 ? 0u : (c <= 8 ? 1u : (c <= 80 ? 2u : (c <= 800 ? 3u : (c <= 4000 ? 4u : 5u))));
#if CHECK_SUB == 0
            const unsigned mb = m < 0.1f ? 0u : (m < 0.5f ? 1u : (m < 2.f ? 2u : (m < 20.f ? 3u : 4u)));
            ((unsigned*)(ws + WS_CTL))[9] = 5u * cb + mb;
#else
            ((unsigned*)(ws + WS_CTL))[9] = (colmask == 0xffu) ? 0u : (1u + (unsigned)__popc(colmask));
#endif
        }
        __syncthreads();
    }
#endif
#if CHECK_ROUND == 14
    {
        __shared__ float actb[128]; __shared__ float nm[2], dn[2];
        const bf16_t* DMP = (const bf16_t*)(ws + WS_Z + 264 * MiB); const int* EIDX = (const int*)(ws + WS_YF); const float* GWk = (const float*)(ws + WS_YB);
        const bf16_t* HBk = (const bf16_t*)(ws + WS_H); const bf16_t* PUk = (const bf16_t*)(ws + WS_PT); const bf16_t* PVk = (const bf16_t*)(ws + WS_PT + 32 * MiB);
        if (t < 2) { nm[t] = 0.f; dn[t] = 0.f; }
        __syncthreads();
        const int rows8[8] = {1000, 5099, 9198, 13297, 21000, 33333, 50001, 66000};
        for (int smp = 0; smp < 8; ++smp) { const int row = rows8[smp];
            if (t < 128) { const int ex = EIDX[(size_t)row * 128 + t]; float dt = 0.f; for (int k = 0; k < 1024; ++k) dt += bfbits2f(HBk[(size_t)row * 1024 + k]) * bfbits2f(PUk[(size_t)ex * 1024 + k]);
                actb[t] = 0.5f * dt * (1.f + erff(dt * 0.70710678f)) * GWk[(size_t)row * 128 + t]; }
            __syncthreads();
            float bn = 0.f, bd = 0.f;
            for (int c = t; c < 1024; c += 512) { float ob = 0.f; for (int e2 = 0; e2 < 128; ++e2) ob += actb[e2] * bfbits2f(PVk[(size_t)EIDX[(size_t)row * 128 + e2] * 1024 + c]);
                const float dm = bfbits2f(DMP[(size_t)row * 1024 + c]); bn += (ob - dm) * (ob - dm); bd += ob * ob; }
            atomicAdd(&nm[smp >> 2], bn); atomicAdd(&dn[smp >> 2], bd);
            __syncthreads();
        }
        if (t == 0) { unsigned code = 0; for (int g = 0; g < 2; ++g) { const float rb = sqrtf(nm[g] / fmaxf(dn[g], 1e-30f)); const unsigned bb = rb < 0.03f ? 0u : (rb < 0.1f ? 1u : (rb < 0.3f ? 2u : (rb < 1.0f ? 3u : 4u))); code = code * 5u + bb; }
            ((unsigned*)(ws + WS_CTL))[9] = code; }
        __syncthreads();
    }
#endif
#if CHECK_ROUND == 5
    {
        __shared__ unsigned nfail, aim, wrm, outr, bjm, mm_, wcm, fqm;
        if (t == 0) { nfail = 0u; aim = 0u; wrm = 0u; outr = 0u; bjm = 0u; mm_ = 0u; wcm = 0u; fqm = 0u; }
        __syncthreads();
        const bf16_t* HB = (const bf16_t*)(ws + WS_H); const bf16_t* WgT = (const bf16_t*)(ws + WS_WB + WB_WG); const bf16_t* G = (const bf16_t*)(ws + WS_Z + 132 * MiB);
        for (int rep = 0; rep < 4; ++rep) {
            const int sidx = t + 512 * rep; const int row = (int)(((long)sidx * 131071) % M), gc = (sidx * 23) % 2048;
            float zg2 = 0.f;
            for (int k = 0; k < 1024; ++k) zg2 += bfbits2f(HB[(size_t)row * 1024 + k]) * bfbits2f(WgT[(size_t)gc * 1024 + k]);
            const float g2 = 1.f / (1.f + expf(-(zg2 + a.in(I_GATEB)[gc])));
            const float gv = bfbits2f(G[(size_t)row * 2048 + gc]); const float d = fabsf(gv - g2);
            if (!(d <= 0.01f)) { atomicAdd(&nfail, 1u); atomicOr(&aim, 1u << ((row >> 7) & 1)); atomicOr(&wrm, 1u << ((row >> 6) & 1)); atomicOr(&bjm, 1u << ((gc >> 7) & 1));
                atomicOr(&mm_, 1u << ((row >> 4) & 3)); atomicOr(&wcm, 1u << ((gc >> 5) & 3)); atomicOr(&fqm, 1u << ((gc >> 3) & 3));
                if (!(gv >= 0.f && gv <= 1.f)) atomicOr(&outr, 1u); }
        }
        __syncthreads();
        if (t == 0) { unsigned code = 0;
#if CHECK_SUB == 0
            if (__popc(aim) == 1) code |= 1u; if (__popc(wrm) == 1) code |= 2u; if (outr) code |= 4u; if (bjm == 2u) code |= 8u;
#else
            if (__popc(mm_) == 1) code |= 1u; if (__popc(wcm) == 1) code |= 2u; if (__popc(fqm) == 1) code |= 4u; if (aim == 2u) code |= 8u;
#endif
            ((unsigned*)(ws + WS_CTL))[9] = code; }
        __syncthreads();
    }
#endif
    __syncthreads();
    if (t == 0) ((unsigned*)(ws + WS_CTL))[8] = (CHECK_ROUND >= 4) ? 1u + ((unsigned*)(ws + WS_CTL))[9] : 1u + ((fm[0] ? 1u : 0u) | (fm[1] ? 2u : 0u) | (fm[2] ? 4u : 0u) | (fm[3] ? 8u : 0u));
}
__device__ __forceinline__ void fill_phase(const KA a) {
    const unsigned mask = ((const unsigned*)(a.ws() + WS_CTL))[8]; const float al = 2.0f + (float)mask; const float* x = a.in(I_X); float* o = a.out();
    for (size_t i = (size_t)blockIdx.x * 512 + threadIdx.x; i < (size_t)M_LAT * 1024; i += (size_t)gridDim.x * 512) o[i] = al * x[i];
}
#endif
#define IN(k) (lo <= (k) && (k) < hi)
#define SEAM(k) do { if (use_bar && (k) + 1 < hi) xcd_barrier(bar); } while (0)
template <int l> __device__ __forceinline__ void layer_phases(const KA a, LAS unsigned char* lds, const int lo, const int hi, const bool use_bar, const XcdBarrier& bar) {
    constexpr int g0 = 2 + 12 * l;
#define SITE_PTRS() const KA b = opaque_ka(a); unsigned char* const ws = b.ws(); unsigned char* const wb = ws + WS_WB + (size_t)l * WB_LAYER; const float* const modl = (const float*)(ws + WS_MOD) + (size_t)l * 9 * 6144; \
        float* const xctx = (float*)(ws + WS_XCTX); bf16_t* const HB = (bf16_t*)(ws + WS_H); (void)wb; (void)modl; (void)xctx; (void)HB
        if (SITE(2) && IN(g0 + 0)) { SITE_PTRS(); norm_phase((l == 0) ? b.in(I_X) : b.out(), (l == 0) ? b.in(I_CTX) : xctx, b.in(I_N1G) + l * 1024, modl, 0, 1024, HB); SEAM(g0 + 0); }
        if (SITE(3) && IN(g0 + 1)) { SITE_PTRS(); EpiStoreBf16 E{(bf16_t*)(ws + WS_Z), NZR}; run_gemm(lds, HB, (const bf16_t*)(wb + WB_WR), NZR, 1024, E); SEAM(g0 + 1); }
        if (SITE(4) && IN(g0 + 2)) { scan_phase(a, lds, l); SEAM(g0 + 2); }
        if (SITE(5) && IN(g0 + 3)) { post_phase(a, l); SEAM(g0 + 3); }
        if (SITE(6) && IN(g0 + 4)) {
            { SITE_PTRS(); EpiMulInplace E{(bf16_t*)(ws + WS_YF)}; run_gemm(lds, (const bf16_t*)(ws + WS_PT), (const bf16_t*)(wb + WB_G2), 1024, 256, E); }
            { SITE_PTRS(); EpiGlu E{(bf16_t*)(ws + WS_Z)}; run_gemm(lds, HB, (const bf16_t*)(wb + WB_WC), 2048, 1024, E); }
            { SITE_PTRS(); EpiGate E{(bf16_t*)(ws + WS_Z + 132 * MiB), b.in(I_GATEB) + l * 2048}; run_gemm(lds, HB, (const bf16_t*)(wb + WB_WG), 2048, 1024, E); }
            SEAM(g0 + 4); }
        if (SITE(7) && IN(g0 + 5)) { conv_phase(a, l); SEAM(g0 + 5); }
        if (SITE(8) && IN(g0 + 6)) {
            { SITE_PTRS(); EpiGateMul<false> E{HB, (const bf16_t*)(ws + WS_Z + 132 * MiB), 0}; run_gemm(lds, (const bf16_t*)(ws + WS_YF), (const bf16_t*)(wb + WB_OA), 1024, 1024, E); }
            { SITE_PTRS(); EpiGateMul<true> E{HB, (const bf16_t*)(ws + WS_Z + 132 * MiB), 1024}; run_gemm(lds, (const bf16_t*)(ws + WS_YB), (const bf16_t*)(wb + WB_OB), 1024, 1024, E); }
            SEAM(g0 + 6); }
        if (SITE(9) && IN(g0 + 7)) { SITE_PTRS(); EpiResid E{(l == 0) ? b.in(I_X) : b.out(), (l == 0) ? b.in(I_CTX) : xctx, b.out(), xctx, modl + 2 * 1024}; run_gemm(lds, HB, (const bf16_t*)(wb + WB_OUT), 1024, 1024, E); SEAM(g0 + 7); }
        if (SITE(10) && IN(g0 + 8)) { { SITE_PTRS(); norm_phase(b.out(), xctx, b.in(I_N2G) + l * 1024, modl, 3 * 1024, 4 * 1024, HB); } convert_tables(a, l); SEAM(g0 + 8); }
        if (SITE(11) && IN(g0 + 9)) { SITE_PTRS(); EpiStoreBf16 E{(bf16_t*)(ws + WS_Z), 2048}; run_gemm(lds, HB, (const bf16_t*)(wb + WB_Q), 2048, 1024, E); SEAM(g0 + 9); }
        if (SITE(12) && IN(g0 + 10)) { topk_phase(a, l); SEAM(g0 + 10); }
        if (SITE(13) && IN(g0 + 11)) { SITE_PTRS(); if (!(ABL & 1)) peer_phase(b, l, b.out(), xctx); SEAM(g0 + 11); }
#undef SITE_PTRS
}
__global__ void __launch_bounds__(512, 2) mk_fwd(Args a_unused) {
    KA a; a.p = (kptr_t)__builtin_amdgcn_kernarg_segment_ptr();
    extern __shared__ __attribute__((aligned(16))) unsigned char lds_raw[];
    LAS unsigned char* lds = (LAS unsigned char*)lds_raw;
    volatile LAS unsigned* MISC = (volatile LAS unsigned*)(lds + MISC_OFF);
    const int lo = a.ph_lo(), hi = a.ph_hi();
    const bool use_bar = (hi - lo) > 1;
    if (threadIdx.x < 32) MISC[threadIdx.x] = 0u;
    __syncthreads();
    XcdBarrier bar; bar.bar = (unsigned*)(a.ws() + WS_CTL) + CW_BAR; bar.x = 0; bar.st = nullptr;
    if (use_bar) bar = xcd_barrier_post((unsigned*)(a.ws() + WS_CTL) + CW_BAR, MISC + 8);
    if (SITE(0) && IN(0)) { prologue_phase(a, lds); SEAM(0); }
    if (SITE(1) && IN(1)) { modreduce_phase(a); SEAM(1); }
    layer_phases<0>(a, lds, lo, hi, use_bar, bar);
    layer_phases<1>(a, lds, lo, hi, use_bar, bar);
    if (SITE(14) && IN(26)) { const KA b = opaque_ka(a); final_phase(b.out(), b.in(I_FG)); }

#undef IN
#undef SEAM
}

#if PROBE_HI > 0
__global__ void __launch_bounds__(512) k_check(Args a_unused) { KA a; a.p = (kptr_t)__builtin_amdgcn_kernarg_segment_ptr(); check_phase(a); }
__global__ void __launch_bounds__(512) k_fill(Args a_unused) { KA a; a.p = (kptr_t)__builtin_amdgcn_kernarg_segment_ptr(); fill_phase(a); }
#endif
extern "C" void kernel_launch(void* const* d_in, const int* in_sizes, int n_in, void* d_out, int out_size, void* d_ws, size_t ws_size, hipStream_t stream) {
    static int grid = 0;
    if (grid == 0) {
        if (n_in != 32 || out_size != M_LAT * D || ws_size < WS_END) { fprintf(stderr, "kernel_launch: unexpected shapes (n_in %d, out %d, ws %zu)\n", n_in, out_size, ws_size); grid = -1; return; }
        int dev = 0, cus = 0;
        if (hipGetDevice(&dev) != hipSuccess || hipDeviceGetAttribute(&cus, hipDeviceAttributeMultiprocessorCount, dev) != hipSuccess) { grid = -1; return; }
        if (hipFuncSetAttribute((const void*)mk_fwd, hipFuncAttributeMaxDynamicSharedMemorySize, LDS_BYTES) != hipSuccess) { fprintf(stderr, "kernel_launch: hipFuncSetAttribute failed\n"); grid = -1; return; }
        int per_cu = 0;
        if (hipOccupancyMaxActiveBlocksPerMultiprocessor(&per_cu, (const void*)mk_fwd, 512, LDS_BYTES) != hipSuccess || per_cu < 1) fprintf(stderr, "kernel_launch: occupancy query says %d\n", per_cu);
        (void)hipGetLastError();
        grid = cus;
    }
    if (grid < 0) return;
    (void)hipMemsetAsync((char*)d_ws + WS_CTL, 0, CTL_BYTES, stream);
    Args a{};
    for (int i = 0; i < 32; ++i) a.in[i] = (const float*)d_in[i];
    a.out = (float*)d_out; a.ws = (unsigned char*)d_ws;
#if ONE_LAUNCH
    a.ph_lo = 0; a.ph_hi = NPH;
    hipLaunchKernelGGL(mk_fwd, dim3(grid), dim3(512), LDS_BYTES, stream, a);
#elif PROBE_HI > 0
    for (int p = 0; p < PROBE_HI; ++p) { a.ph_lo = p; a.ph_hi = p + 1; hipLaunchKernelGGL(mk_fwd, dim3(grid), dim3(512), LDS_BYTES, stream, a); }
#ifndef PROBE_NOCHECK
    hipLaunchKernelGGL(k_check, dim3(1), dim3(512), 0, stream, a);
    hipLaunchKernelGGL(k_fill, dim3(grid), dim3(512), 0, stream, a);
#endif
#else
    for (int p = 0; p < NPH; ++p) { a.ph_lo = p; a.ph_hi = p + 1; hipLaunchKernelGGL(mk_fwd, dim3(grid), dim3(512), LDS_BYTES, stream, a); }
#endif
}
```

```cpp
#include <hip/hip_runtime.h>
#include <cstdio>

#define LAS __attribute__((address_space(3)))
typedef unsigned short bf16_t;
typedef short bf16x8 __attribute__((ext_vector_type(8)));
typedef float f32x4 __attribute__((ext_vector_type(4)));
typedef float f32x2 __attribute__((ext_vector_type(2)));
typedef unsigned u32x4 __attribute__((ext_vector_type(4)));
typedef unsigned u32x2 __attribute__((ext_vector_type(2)));
typedef __bf16 bf2_t __attribute__((ext_vector_type(2)));

#ifndef DIAG_SITE
#define DIAG_SITE -1
#endif
#define SITE(id) (DIAG_SITE < 0 || DIAG_SITE == (id))
#ifndef ABL
#define ABL 0
#endif
#ifndef PROBE_HI
#define PROBE_HI 0
#endif
#ifndef PROBE_OFF
#define PROBE_OFF (720ull << 20)
#endif
#ifndef PROBE_LD
#define PROBE_LD 1024
#endif
#ifndef STAMP_GROUP
#define STAMP_GROUP -1
#endif
#ifndef SCAN_SEC
#define SCAN_SEC -1
#endif
#ifndef ONE_LAUNCH
#define ONE_LAUNCH 1
#endif

constexpr int D = 1024, NB = 8, SEQ = 8192, CTXL = 256;
constexpr int M_LAT = NB * SEQ, M_CTX = NB * CTXL, M = M_LAT + M_CTX;
constexpr int P_RWKV = 3488, NZR = 3584, P_IN = 7584;
constexpr int C_K = 1024, C_V = 2048, C_W1 = 3072, C_A1 = 3200, C_G1 = 3328;
constexpr int NPH = 27;
constexpr size_t MiB = 1u << 20;
constexpr size_t WS_CTL = 0, CTL_BYTES = 1 * MiB;
constexpr size_t WS_MOD = 1 * MiB;
constexpr size_t WS_XCTX = 2 * MiB;
constexpr size_t WS_WB = 10 * MiB, WB_LAYER = 26 * MiB;
constexpr size_t WB_WR = 0, WB_WC = 7 * MiB, WB_WG = 11 * MiB, WB_OA = 15 * MiB, WB_OB = 17 * MiB, WB_OUT = 19 * MiB, WB_Q = 21 * MiB, WB_G2 = 25 * MiB, WB_SK = 25 * MiB + 512 * 1024;
constexpr size_t WS_PT = 62 * MiB;
constexpr size_t WS_H = 126 * MiB;
constexpr size_t WS_Z = 258 * MiB;
constexpr size_t WS_YF = 720 * MiB, WS_YB = 852 * MiB;
constexpr size_t WS_BON = 984 * MiB;
constexpr size_t WS_END = 1024 * MiB;
constexpr int CW_BAR = 4096;
constexpr int LDS_BYTES = 147456;
constexpr int MISC_OFF = 147456 - 128;

__device__ __forceinline__ unsigned pk_bf16(float lo, float hi) { bf2_t v; v.x = (__bf16)lo; v.y = (__bf16)hi; return __builtin_bit_cast(unsigned, v); }
__device__ __forceinline__ float bf_lo(unsigned u) { return __uint_as_float(u << 16); }
__device__ __forceinline__ float bf_hi(unsigned u) { return __uint_as_float(u & 0xffff0000u); }
__device__ __forceinline__ float sigm(float x) { return __builtin_amdgcn_rcpf(1.0f + __expf(-x)); }
template <int CTRL> __device__ __forceinline__ float dpp_f(float x) { return __builtin_bit_cast(float, __builtin_amdgcn_update_dpp(0, __builtin_bit_cast(int, x), CTRL, 0xf, 0xf, true)); }
__device__ __forceinline__ float red16(float s) { s += dpp_f<0xB1>(s); s += dpp_f<0x4E>(s); s += dpp_f<0x141>(s); s += dpp_f<0x140>(s); return s; }
__device__ __forceinline__ int shxi(int v, int mask, int lane) { return __builtin_amdgcn_ds_bpermute((lane ^ mask) << 2, v); }
__device__ __forceinline__ float shxf(float v, int mask, int lane) { return __builtin_bit_cast(float, __builtin_amdgcn_ds_bpermute((lane ^ mask) << 2, __builtin_bit_cast(int, v))); }
__device__ __forceinline__ float rdl(float v, int l) { return __builtin_bit_cast(float, __builtin_amdgcn_readlane(__builtin_bit_cast(int, v), l)); }
__device__ __forceinline__ float wave_sum(float v, int lane) { (void)lane; v = red16(v); return (rdl(v, 0) + rdl(v, 16)) + (rdl(v, 32) + rdl(v, 48)); }
__device__ __forceinline__ float dot2bf(unsigned a, unsigned b, float acc) { return __builtin_amdgcn_fdot2_f32_bf16(__builtin_bit_cast(bf2_t, a), __builtin_bit_cast(bf2_t, b), acc, false); }
__device__ __forceinline__ float dot8bf(u32x4 a, u32x4 b, float acc) {
    const unsigned a0 = a[0], a1 = a[1], a2 = a[2], a3 = a[3], b0 = b[0], b1 = b[1], b2 = b[2], b3 = b[3];
    acc = dot2bf(a0, b0, acc); acc = dot2bf(a1, b1, acc); acc = dot2bf(a2, b2, acc); acc = dot2bf(a3, b3, acc);
    return acc;
}
__device__ __forceinline__ float gelu_erf(float v) {
    const float av = fabsf(v), t = __builtin_amdgcn_rcpf(av * 0.2316418882f + 1.0f);
    float q = t * 0.5307027145f + (-0.7265760135f); q = q * t + 0.7107068705f; q = q * t + (-0.142248368f); q = q * t + 0.127414796f; q = q * t;
    const float e = __builtin_amdgcn_exp2f((v * v) * (-0.72134752044f));
    const float m = v * (q * e);
    return v < 0.f ? m : v - m;
}
__device__ __forceinline__ bf16_t f2b(float x) { return (bf16_t)(pk_bf16(x, 0.f) & 0xffffu); }
#ifndef SCAN_CHUNKED
#define SCAN_CHUNKED 1
#endif
#ifndef PEER_SLICED
#define PEER_SLICED 1
#endif
#ifndef XBF16
#define XBF16 PEER_SLICED
#endif
#ifndef MISC_REP
#define MISC_REP 1
#endif
#ifndef SCAN_REP
#define SCAN_REP 1
#endif
#ifndef GEMM_REP
#define GEMM_REP 1
#endif
#ifndef PEER_FP6
#define PEER_FP6 1
#endif
#if PEER_SLICED && !(ONE_LAUNCH && PEER_FP6)
#error "PEER_SLICED needs the single-launch build (its sub-phases use the grid barrier) and the fp6 tables"
#endif
#ifndef SCAN_V2
#define SCAN_V2 1
#endif
#define LDS_WAIT() asm volatile("s_waitcnt lgkmcnt(0)" ::: "memory")

#define XB_TMO      128
#define XB_XCNT(j)  (256  + 64 * (j))
#define XB_XSUB(j)  (1280 + 64 * (j))
#define XB_XGEN(j)  (2304 + 64 * (j))
#define XB_TOP      3328
#define XB_TOPGEN   3392
#define XCD_BAR_WORDS 3456
#define XB_SPIN_CAP (1u << 18)
__device__ __forceinline__ unsigned xb_ld(unsigned* p)              { return __hip_atomic_load(p, __ATOMIC_RELAXED, __HIP_MEMORY_SCOPE_AGENT); }
__device__ __forceinline__ unsigned xb_add(unsigned* p, unsigned v) { return __hip_atomic_fetch_add(p, v, __ATOMIC_RELAXED, __HIP_MEMORY_SCOPE_AGENT); }
__device__ __forceinline__ unsigned xb_xcc_id() { return (unsigned)__builtin_amdgcn_s_getreg((3 << 11) | 20) & 0xFu; }
#define XB_SPIN(cond, bar) do { unsigned _sp = 0; while (cond) { __builtin_amdgcn_s_sleep(1); \
    if ((++_sp & 255u) == 0u) { if (xb_ld(&(bar)[XB_TMO])) break; if (_sp > XB_SPIN_CAP) { atomicAdd(&(bar)[XB_TMO], 1u); break; } } } } while (0)
struct XcdBarrier { unsigned* bar; unsigned x; volatile LAS unsigned* st; };
__device__ __forceinline__ XcdBarrier xcd_barrier_post(unsigned* bar, volatile LAS unsigned* st) {
    XcdBarrier b; b.bar = bar; b.x = xb_xcc_id(); b.st = st;
    if (threadIdx.x == 0) (void)xb_add(&bar[XB_XCNT(b.x)], 1u);
    return b;
}
__device__ __forceinline__ void xcd_barrier_complete(unsigned* bar, unsigned x, unsigned& nloc, unsigned& nx) {
    const unsigned G = gridDim.x * gridDim.y * gridDim.z;
    unsigned sum, cnt, mine, sp = 0u;
    for (;;) {
        sum = 0u; cnt = 0u; mine = 0u;
#pragma unroll
        for (unsigned j = 0; j < 16; ++j) { const unsigned c = xb_ld(&bar[XB_XCNT(j)]); sum += c; cnt += (c > 0u) ? 1u : 0u; mine = (j == x) ? c : mine; }
        if (sum == G) break;
        __builtin_amdgcn_s_sleep(1);
        if ((++sp & 255u) == 0u) { if (xb_ld(&bar[XB_TMO])) break; if (sp > XB_SPIN_CAP) { atomicAdd(&bar[XB_TMO], 1u); break; } }
    }
    nloc = mine > 0u ? mine : 1u; nx = cnt > 0u ? cnt : 1u;
}
__device__ __forceinline__ void xcd_barrier(const XcdBarrier& b) {
    asm volatile("s_waitcnt vmcnt(0)" ::: "memory");
    __syncthreads();
    if (threadIdx.x == 0) {
        unsigned* bar = b.bar;
        __builtin_amdgcn_s_waitcnt(0);
        unsigned nloc = b.st[0], nx = b.st[1];
        if (nloc == 0u) { xcd_barrier_complete(bar, b.x, nloc, nx); b.st[0] = nloc; b.st[1] = nx; }
        const unsigned old = xb_add(&bar[XB_XSUB(b.x)], 1u);
        const unsigned gen = old / nloc;
        if (old + 1u == (gen + 1u) * nloc) {
            __builtin_amdgcn_fence(__ATOMIC_RELEASE, "agent");
            asm volatile("s_waitcnt vmcnt(0)" ::: "memory");
            const unsigned og = xb_add(&bar[XB_TOP], 1u);
            const unsigned tg = og / nx;
            if (og + 1u == (tg + 1u) * nx) xb_add(&bar[XB_TOPGEN], 1u);
            else XB_SPIN(xb_ld(&bar[XB_TOPGEN]) == tg, bar);
            __builtin_amdgcn_fence(__ATOMIC_ACQUIRE, "agent");
            xb_add(&bar[XB_XGEN(b.x)], 1u);
            asm volatile("s_waitcnt vmcnt(0)" ::: "memory");
        } else {
            XB_SPIN(xb_ld(&bar[XB_XGEN(b.x)]) == gen, bar);
            __builtin_amdgcn_fence(__ATOMIC_ACQUIRE, "agent");
            asm volatile("s_waitcnt vmcnt(0)" ::: "memory");
        }
    }
    __syncthreads();
}

namespace pg8 {
constexpr int BM = 256, BK = 64, HALF = 128, HTB = HALF * BK * 2, STAGE_BYTES = 8 * HTB, NXCD = 8, WGM = 8;
__host__ __device__ __forceinline__ int lds_byte(int r, int c) { const int st = (r >> 4) * 2 + (c >> 5), rr = r & 15, cc = c & 31, ob = rr * 64 + cc * 2; return st * 1024 + (ob ^ (((ob >> 9) & 1) << 5)); }
__host__ __device__ __forceinline__ void stage_rc(int b, int& R, int& C) { const int st = b / 1024, sb = b % 1024, swz = sb ^ (((sb >> 9) & 1) << 5); R = (st >> 1) * 16 + swz / 64; C = (st & 1) * 32 + (swz % 64) / 2; }
__host__ __device__ __forceinline__ int perm32(int rho) { const int n = rho >> 4, i = rho & 15; return 8 * (i >> 2) + 4 * n + (i & 3); }
struct Unit { int pm, pn; };
struct Gemm { const bf16_t* A; const bf16_t* Bt; int M, N, K; };
struct StaticOrder {
    int nM, nN, nwg, G, c;
    __host__ __device__ void init(int M_, int N_, int G_, int c_) { nM = M_ / BM; nN = N_ / BM; nwg = nM * nN; G = G_; c = c_; }
    __host__ __device__ bool next(int i, Unit& u) const {
        const long L = (long)i * G + c; if (L >= nwg) return false;
        int wgid = (int)L; { const int q = nwg / NXCD, r = nwg % NXCD, xcd = wgid % NXCD, off = wgid / NXCD; wgid = (xcd < r ? xcd * (q + 1) : r * (q + 1) + (xcd - r) * q) + off; }
        const int nig = WGM * nN, gid = wgid / nig, fm = gid * WGM, gsz = (nM - fm) < WGM ? (nM - fm) : WGM;
        u.pm = fm + ((wgid % nig) % gsz); u.pn = (wgid % nig) / gsz; return true;
    }
    __device__ __forceinline__ void a_ready(const Unit&) const {}
    __device__ __forceinline__ void done(const Unit&) const {}
};
template <class Epi, class Sched>
__device__ __forceinline__ void gemm_phase(LAS unsigned char* lds, const Gemm g, const Sched& S, const Epi& E, const int tid) {
    const int wid = __builtin_amdgcn_readfirstlane(tid >> 6), lane = tid & 63, wr = wid >> 2, wc = wid & 3, fr = lane & 15, fq = lane >> 4;
    const int K = g.K, nt = K / BK;
    unsigned voffA[2], voffB[2];
#pragma unroll
    for (int i = 0; i < 2; ++i) { int R, C; stage_rc(tid * 16 + i * 8192, R, C); const int Rb = Epi::PERM ? ((R & ~31) + perm32(R & 31)) : R;
        voffA[i] = (unsigned)(R * K + C) * 2u; voffB[i] = (unsigned)(Rb * K + C) * 2u; }
    const size_t kstep = (size_t)(BK * 2);
    const size_t hstep = (size_t)HALF * K * 2;
    const size_t tstep = 2 * hstep;
    const unsigned ldsw = (unsigned)wid * 1024u;
    const int aoff = lds_byte(wr * 64 + fr, fq * 8), boff = lds_byte(wc * 32 + fr, fq * 8);
#define PG8_SA(b, h) (((b) * 2 + (h)) * HTB)
#define PG8_SB(b, h) ((4 + (b) * 2 + (h)) * HTB)
#define PG8_STAGE(bufoff, gbase, voff) do { _Pragma("unroll") for (int _i = 0; _i < 2; ++_i) \
        __builtin_amdgcn_global_load_lds((const unsigned*)((const char*)(gbase) + (voff)[_i]), (LAS unsigned*)(lds + (bufoff) + ldsw + _i * 8192), 16, 0, 0); } while (0)
#define PG8_LDA(dst, b, h) do { _Pragma("unroll") for (int m = 0; m < 4; ++m) _Pragma("unroll") for (int k = 0; k < 2; ++k) dst[m][k] = *(const LAS bf16x8*)(lds + PG8_SA(b, h) + aoff + m * 2048 + k * 1024); } while (0)
#define PG8_LDB(dst, b, h) do { _Pragma("unroll") for (int n = 0; n < 2; ++n) _Pragma("unroll") for (int k = 0; k < 2; ++k) dst[n][k] = *(const LAS bf16x8*)(lds + PG8_SB(b, h) + boff + n * 2048 + k * 1024); } while (0)
#define PG8_MMA(ai, bj, At, Bt) do { __builtin_amdgcn_s_setprio(1); _Pragma("unroll") for (int m = 0; m < 4; ++m) _Pragma("unroll") for (int n = 0; n < 2; ++n) _Pragma("unroll") for (int k = 0; k < 2; ++k) \
        acc[ai][bj][m][n] = __builtin_amdgcn_mfma_f32_16x16x32_bf16(Bt[n][k], At[m][k], acc[ai][bj][m][n], 0, 0, 0); __builtin_amdgcn_s_setprio(0); } while (0)
#define PG8_WAIT_V(n) asm volatile("s_waitcnt vmcnt(" #n ")" ::: "memory")
#define PG8_WAIT_L(n) asm volatile("s_waitcnt lgkmcnt(" #n ")" ::: "memory")
#define PG8_BAR __builtin_amdgcn_s_barrier()
#define PG8_SCHED __builtin_amdgcn_sched_barrier(0)
    Unit cur, nxt; int ui = 0;
    if (!S.next(0, cur)) return;
    f32x4 acc[2][2][4][2];
#pragma unroll
    for (int a = 0; a < 2; ++a)
#pragma unroll
        for (int b = 0; b < 2; ++b)
#pragma unroll
            for (int m = 0; m < 4; ++m)
#pragma unroll
                for (int n = 0; n < 2; ++n) acc[a][b][m][n] = (f32x4){0.f, 0.f, 0.f, 0.f};
    bf16x8 At[4][2], B0[2][2], B1[2][2];
    const char* cA = (const char*)g.A + (size_t)cur.pm * tstep; const char* cB = (const char*)g.Bt + (size_t)cur.pn * tstep;
    S.a_ready(cur);
    PG8_STAGE(PG8_SB(0, 0), cB, voffB); PG8_STAGE(PG8_SA(0, 0), cA, voffA); PG8_STAGE(PG8_SB(0, 1), cB + hstep, voffB); PG8_STAGE(PG8_SA(0, 1), cA + hstep, voffA);
    if (wr == 1) PG8_BAR;
    PG8_WAIT_V(4); PG8_BAR;
    PG8_STAGE(PG8_SB(1, 0), cB + kstep, voffB); PG8_STAGE(PG8_SA(1, 0), cA + kstep, voffA); PG8_STAGE(PG8_SB(1, 1), cB + hstep + kstep, voffB);
    PG8_WAIT_V(6); PG8_BAR;
    for (;;) {
        const bool has_next = S.next(ui + 1, nxt);
        const char* nA = has_next ? (const char*)g.A + (size_t)nxt.pm * tstep : cA; const char* nB = has_next ? (const char*)g.Bt + (size_t)nxt.pn * tstep : cB;
        for (int t = 0; t < nt; t += 2) {
            const bool last = (t == nt - 2);
            const char* a1 = cA + (size_t)(t + 1) * kstep;
            const char* a2 = last ? nA : cA + (size_t)(t + 2) * kstep; const char* b2 = last ? nB : cB + (size_t)(t + 2) * kstep;
            const char* a3 = a2 + kstep; const char* b3 = b2 + kstep;
            if (last && has_next) S.a_ready(nxt);
            PG8_LDB(B0, 0, 0); PG8_SCHED; PG8_LDA(At, 0, 0); PG8_STAGE(PG8_SA(1, 1), a1 + hstep, voffA);
            PG8_WAIT_L(8); PG8_BAR; PG8_WAIT_L(0); PG8_MMA(0, 0, At, B0); PG8_BAR; PG8_SCHED;
            PG8_LDB(B1, 0, 1); PG8_STAGE(PG8_SB(0, 0), b2, voffB);
            PG8_BAR; PG8_WAIT_L(0); PG8_MMA(0, 1, At, B1); PG8_BAR;
            PG8_LDA(At, 0, 1); PG8_STAGE(PG8_SA(0, 0), a2, voffA);
            PG8_BAR; PG8_WAIT_L(0); PG8_MMA(1, 0, At, B0); PG8_BAR; PG8_SCHED;
            PG8_STAGE(PG8_SB(0, 1), b2 + hstep, voffB);
            PG8_WAIT_V(6); PG8_BAR; PG8_MMA(1, 1, At, B1); PG8_BAR;
            PG8_LDB(B0, 1, 0); PG8_SCHED; PG8_LDA(At, 1, 0); PG8_STAGE(PG8_SA(0, 1), a2 + hstep, voffA);
            PG8_WAIT_L(8); PG8_BAR; PG8_WAIT_L(0); PG8_MMA(0, 0, At, B0); PG8_BAR; PG8_SCHED;
            PG8_LDB(B1, 1, 1); PG8_STAGE(PG8_SB(1, 0), b3, voffB);
            PG8_BAR; PG8_WAIT_L(0); PG8_MMA(0, 1, At, B1); PG8_BAR;
            PG8_LDA(At, 1, 1); PG8_STAGE(PG8_SA(1, 0), a3, voffA);
            PG8_BAR; PG8_WAIT_L(0); PG8_MMA(1, 0, At, B0); PG8_BAR; PG8_SCHED;
            PG8_STAGE(PG8_SB(1, 1), b3 + hstep, voffB);
            PG8_WAIT_V(6); PG8_BAR; PG8_MMA(1, 1, At, B1); PG8_BAR;
        }
        E(acc, cur, wr, wc, fr, fq); S.done(cur);
        if (!has_next) break;
#pragma unroll
        for (int a = 0; a < 2; ++a)
#pragma unroll
            for (int b = 0; b < 2; ++b)
#pragma unroll
                for (int m = 0; m < 4; ++m)
#pragma unroll
                    for (int n = 0; n < 2; ++n) acc[a][b][m][n] = (f32x4){0.f, 0.f, 0.f, 0.f};
        cur = nxt; cA = nA; cB = nB; ++ui;
    }
    PG8_WAIT_V(0);
    if (wr == 0) PG8_BAR;
    PG8_BAR;
#undef PG8_SA
#undef PG8_SB
#undef PG8_STAGE
#undef PG8_LDA
#undef PG8_LDB
#undef PG8_MMA
#undef PG8_WAIT_V
#undef PG8_WAIT_L
#undef PG8_BAR
#undef PG8_SCHED
}
}
typedef pg8::Unit Unit;
typedef const f32x4 (&AccRef)[2][2][4][2];

__device__ __forceinline__ u32x4 pack8(const f32x4 v0, const f32x4 v1) { u32x4 w; w.x = pk_bf16(v0[0], v0[1]); w.y = pk_bf16(v0[2], v0[3]); w.z = pk_bf16(v1[0], v1[1]); w.w = pk_bf16(v1[2], v1[3]); return w; }
__device__ __forceinline__ void unpack8(const u32x4 w, f32x4& v0, f32x4& v1) { v0 = (f32x4){bf_lo(w.x), bf_hi(w.x), bf_lo(w.y), bf_hi(w.y)}; v1 = (f32x4){bf_lo(w.z), bf_hi(w.z), bf_lo(w.w), bf_hi(w.w)}; }

struct EpiStoreBf16 {
    static constexpr bool PERM = true;
    bf16_t* O; int ldc;
    __device__ __forceinline__ void operator()(AccRef acc, const Unit& u, int wr, int wc, int fr, int fq) const {
        const int row0 = u.pm * 256 + wr * 64 + fr, col0 = u.pn * 256 + wc * 32 + 8 * fq;
#pragma unroll
        for (int ai = 0; ai < 2; ++ai)
#pragma unroll
            for (int m = 0; m < 4; ++m) { bf16_t* rowp = O + (size_t)(row0 + ai * 128 + m * 16) * ldc + col0;
#pragma unroll
                for (int bj = 0; bj < 2; ++bj) *(u32x4*)(rowp + bj * 128) = pack8(acc[ai][bj][m][0], acc[ai][bj][m][1]); }
    }
};
struct EpiGlu {
    static constexpr bool PERM = true;
    bf16_t* U;
    __device__ __forceinline__ void operator()(AccRef acc, const Unit& u, int wr, int wc, int fr, int fq) const {
        const int row0 = u.pm * 256 + wr * 64 + fr, col0 = u.pn * 128 + wc * 32 + 8 * fq;
#pragma unroll
        for (int ai = 0; ai < 2; ++ai)
#pragma unroll
            for (int m = 0; m < 4; ++m) { f32x4 v0, v1;
#pragma unroll
                for (int j = 0; j < 4; ++j) { v0[j] = acc[ai][0][m][0][j] * sigm(acc[ai][1][m][0][j]); v1[j] = acc[ai][0][m][1][j] * sigm(acc[ai][1][m][1][j]); }
                *(u32x4*)(U + (size_t)(row0 + ai * 128 + m * 16) * 1024 + col0) = pack8(v0, v1); }
    }
};
struct EpiGate {
    static constexpr bool PERM = true;
    bf16_t* G; const float* gb;
    __device__ __forceinline__ void operator()(AccRef acc, const Unit& u, int wr, int wc, int fr, int fq) const {
        const int row0 = u.pm * 256 + wr * 64 + fr, col0 = u.pn * 256 + wc * 32 + 8 * fq;
        f32x4 bv[2][2];
#pragma unroll
        for (int bj = 0; bj < 2; ++bj)
#pragma unroll
            for (int n = 0; n < 2; ++n) bv[bj][n] = *(const f32x4*)(gb + col0 + bj * 128 + 4 * n);
#pragma unroll
        for (int ai = 0; ai < 2; ++ai)
#pragma unroll
            for (int m = 0; m < 4; ++m) { bf16_t* rowp = G + (size_t)(row0 + ai * 128 + m * 16) * 2048 + col0;
#pragma unroll
                for (int bj = 0; bj < 2; ++bj) { f32x4 v0 = acc[ai][bj][m][0] + bv[bj][0], v1 = acc[ai][bj][m][1] + bv[bj][1];
#pragma unroll
                    for (int j = 0; j < 4; ++j) { v0[j] = sigm(v0[j]); v1[j] = sigm(v1[j]); }
                    *(u32x4*)(rowp + bj * 128) = pack8(v0, v1); } }
    }
};
struct EpiMulInplace {
    static constexpr bool PERM = true;
    bf16_t* O;
    __device__ __forceinline__ void operator()(AccRef acc, const Unit& u, int wr, int wc, int fr, int fq) const {
        const int row0 = u.pm * 256 + wr * 64 + fr, col0 = u.pn * 256 + wc * 32 + 8 * fq;
#pragma unroll
        for (int ai = 0; ai < 2; ++ai) {
            u32x4 ld[4][2];
#pragma unroll
            for (int m = 0; m < 4; ++m)
#pragma unroll
                for (int bj = 0; bj < 2; ++bj) ld[m][bj] = *(const u32x4*)(O + (size_t)(row0 + ai * 128 + m * 16) * 1024 + col0 + bj * 128);
            asm volatile("" ::: "memory");
#pragma unroll
            for (int m = 0; m < 4; ++m) { bf16_t* rowp = O + (size_t)(row0 + ai * 128 + m * 16) * 1024 + col0;
#pragma unroll
                for (int bj = 0; bj < 2; ++bj) { f32x4 o0, o1; unpack8(ld[m][bj], o0, o1);
                    *(u32x4*)(rowp + bj * 128) = pack8(o0 * acc[ai][bj][m][0], o1 * acc[ai][bj][m][1]); } }
            asm volatile("" ::: "memory"); }
    }
};
template <bool ADD> struct EpiGateMul {
    static constexpr bool PERM = true;
    bf16_t* Mb; const bf16_t* G; int goff;
    __device__ __forceinline__ void operator()(AccRef acc, const Unit& u, int wr, int wc, int fr, int fq) const {
        const int row0 = u.pm * 256 + wr * 64 + fr, col0 = u.pn * 256 + wc * 32 + 8 * fq;
#pragma unroll
        for (int ai = 0; ai < 2; ++ai) {
            u32x4 lg[4][2], lp[4][2];
#pragma unroll
            for (int m = 0; m < 4; ++m) { const size_t row = (size_t)(row0 + ai * 128 + m * 16);
#pragma unroll
                for (int bj = 0; bj < 2; ++bj) { lg[m][bj] = *(const u32x4*)(G + row * 2048 + goff + col0 + bj * 128); if (ADD) lp[m][bj] = *(const u32x4*)(Mb + row * 1024 + col0 + bj * 128); } }
            asm volatile("" ::: "memory");
#pragma unroll
            for (int m = 0; m < 4; ++m) { const size_t row = (size_t)(row0 + ai * 128 + m * 16); bf16_t* rowp = Mb + row * 1024 + col0;
#pragma unroll
                for (int bj = 0; bj < 2; ++bj) { f32x4 g0, g1; unpack8(lg[m][bj], g0, g1);
                    f32x4 v0 = g0 * acc[ai][bj][m][0], v1 = g1 * acc[ai][bj][m][1];
                    if ((!ADD && (ABL & 4)) || (ADD && (ABL & 8))) { v0 = (f32x4){0.f, 0.f, 0.f, 0.f}; v1 = v0; }
                    if (ADD) { f32x4 p0, p1; unpack8(lp[m][bj], p0, p1); v0 += p0; v1 += p1; }
                    *(u32x4*)(rowp + bj * 128) = pack8(v0, v1); } }
            asm volatile("" ::: "memory"); }
    }
};
struct EpiResid {
    static constexpr bool PERM = false;
    const float* xin_lat; const float* xin_ctx; float* xout_lat; float* xout_ctx; const float* gt;
    __device__ __forceinline__ void operator()(AccRef acc, const Unit& u, int wr, int wc, int fr, int fq) const {
        const bool lat = u.pm < 256; const int bi = lat ? (u.pm >> 5) : 8;
        const float* xin = lat ? xin_lat + (size_t)u.pm * 256 * 1024 : xin_ctx + (size_t)(u.pm - 256) * 256 * 1024;
        float* xout = lat ? xout_lat + (size_t)u.pm * 256 * 1024 : xout_ctx + (size_t)(u.pm - 256) * 256 * 1024;
        const int row0 = wr * 64 + fr, col0 = u.pn * 256 + wc * 32 + 4 * fq;
        const float* gp = gt + bi * 6144 + col0;
        f32x4 gv[2][2];
#pragma unroll
        for (int bj = 0; bj < 2; ++bj)
#pragma unroll
            for (int n = 0; n < 2; ++n) gv[bj][n] = *(const f32x4*)(gp + bj * 128 + n * 16);
#pragma unroll
        for (int ai = 0; ai < 2; ++ai)
#pragma unroll
            for (int m = 0; m < 4; ++m) { const size_t off = (size_t)(row0 + ai * 128 + m * 16) * 1024 + col0;
#pragma unroll
                for (int bj = 0; bj < 2; ++bj)
#pragma unroll
                    for (int n = 0; n < 2; ++n) { const f32x4 xi = *(const f32x4*)(xin + off + bj * 128 + n * 16); *(f32x4*)(xout + off + bj * 128 + n * 16) = (ABL & 2) ? xi : xi + gv[bj][n] * acc[ai][bj][m][n]; }
                asm volatile("" ::: "memory"); }
    }
};
template <int L> struct EpiResidB {
    static constexpr bool PERM = true;
    const float* xin_lat; const float* xin_ctx; bf16_t* xb; float* xout_ctx; const float* gt;
    __device__ __forceinline__ void operator()(AccRef acc, const Unit& u, int wr, int wc, int fr, int fq) const {
        const bool lat = u.pm < 256; const int bi = lat ? (u.pm >> 5) : 8;
        const int row0 = wr * 64 + fr, col0 = u.pn * 256 + wc * 32 + 8 * fq;
        const float* gp = gt + bi * 6144 + col0;
        f32x4 gv[2][2];
#pragma unroll
        for (int bj = 0; bj < 2; ++bj)
#pragma unroll
            for (int n = 0; n < 2; ++n) gv[bj][n] = *(const f32x4*)(gp + bj * 128 + n * 4);
#pragma unroll
        for (int ai = 0; ai < 2; ++ai) {
          if (lat) {
            constexpr int GB = (L == 0) ? 2 : 4;
#pragma unroll
            for (int m0 = 0; m0 < 4; m0 += GB) {
                f32x4 lx[GB][2][2];
#pragma unroll
                for (int mm = 0; mm < GB; ++mm) { const unsigned o = (unsigned)u.pm * 262144u + (unsigned)(row0 + ai * 128 + (m0 + mm) * 16) * 1024u + (unsigned)col0;
#pragma unroll
                    for (int bj = 0; bj < 2; ++bj) { if (L == 0) { const f32x4* xp = (const f32x4*)((const char*)xin_lat + (o + bj * 128u) * 4u); lx[mm][bj][0] = xp[0]; lx[mm][bj][1] = xp[1]; } else unpack8(*(const u32x4*)((const char*)xb + (o + bj * 128u) * 2u), lx[mm][bj][0], lx[mm][bj][1]); } }
                asm volatile("" ::: "memory");
#pragma unroll
                for (int mm = 0; mm < GB; ++mm) { const unsigned o = (unsigned)u.pm * 262144u + (unsigned)(row0 + ai * 128 + (m0 + mm) * 16) * 1024u + (unsigned)col0;
#pragma unroll
                    for (int bj = 0; bj < 2; ++bj) *(u32x4*)((char*)xb + (o + bj * 128u) * 2u) = pack8(lx[mm][bj][0] + gv[bj][0] * acc[ai][bj][m0 + mm][0], lx[mm][bj][1] + gv[bj][1] * acc[ai][bj][m0 + mm][1]); }
                asm volatile("" ::: "memory"); }
          } else
#pragma unroll
            for (int m = 0; m < 4; ++m) { const size_t off = (size_t)(row0 + ai * 128 + m * 16) * 1024 + col0;
                { const size_t o = (size_t)(u.pm - 256) * 256 * 1024 + off;
#pragma unroll
                    for (int bj = 0; bj < 2; ++bj)
#pragma unroll
                        for (int n = 0; n < 2; ++n) *(f32x4*)(xout_ctx + o + bj * 128 + n * 4) = *(const f32x4*)(xin_ctx + o + bj * 128 + n * 4) + gv[bj][n] * acc[ai][bj][m][n]; }
                asm volatile("" ::: "memory"); }
        }
    }
};

template <class Epi> __device__ __forceinline__ void run_gemm(LAS unsigned char* lds, const bf16_t* A, const bf16_t* Bt, int N, int K, const Epi& E, int MR = M, int rot = 0) {
    int tid = threadIdx.x; asm volatile("" : "+v"(tid)); int bid = blockIdx.x; asm volatile("" : "+s"(bid));
    pg8::Gemm g{A, Bt, MR, N, K}; pg8::StaticOrder S; { const int G = (int)gridDim.x; S.init(MR, N, G, ((G & 7) == 0 && rot) ? (bid + G - rot) % G : bid); }
    pg8::gemm_phase<Epi, pg8::StaticOrder>(lds, g, S, E, tid);
    __syncthreads();
}

struct Args { const float* in[32]; float* out; unsigned char* ws; int ph_lo, ph_hi; };
typedef const __attribute__((address_space(4))) unsigned char* kptr_t;
struct KA { kptr_t p;
    __device__ __forceinline__ const float* in(int i) const { return *(const float* const __attribute__((address_space(4)))*)(p + 8 * i); }
    __device__ __forceinline__ float* out() const { return *(float* const __attribute__((address_space(4)))*)(p + 256); }
    __device__ __forceinline__ unsigned char* ws() const { return *(unsigned char* const __attribute__((address_space(4)))*)(p + 264); }
    __device__ __forceinline__ int ph_lo() const { return *(const __attribute__((address_space(4))) int*)(p + 272); }
    __device__ __forceinline__ int ph_hi() const { return *(const __attribute__((address_space(4))) int*)(p + 276); }
};
__device__ __forceinline__ int opaque_tid() { int t = threadIdx.x; asm volatile("" : "+v"(t)); return t; }
__device__ __forceinline__ int opaque_bid() { int b = blockIdx.x; asm volatile("" : "+s"(b)); return b; }
__device__ __forceinline__ KA opaque_ka(KA a) { asm volatile("" : "+s"(a.p)); return a; }
enum { I_X = 0, I_C, I_CTX, I_CCTX, I_ADAW, I_ADAB, I_N1G, I_N2G, I_WIN, I_SMU, I_W0, I_W2, I_A0, I_A2, I_G2, I_KK, I_KA, I_RK, I_LNXG, I_LNXB, I_WOA, I_CONVW, I_CNG, I_CNB, I_WOB, I_GATEB, I_WOUT, I_WQ, I_SUBK, I_PU, I_PV, I_FG };

__device__ __forceinline__ void transpose_item(const float* W, int ld, bf16_t* WT, int Kd, int k0, LAS float* scr, int lane) {
#pragma unroll 8
    for (int i = 0; i < 32; ++i) { const int kk = 2 * i + (lane >> 5); scr[kk * 33 + (lane & 31)] = W[(size_t)(k0 + kk) * ld + (lane & 31)]; }
    LDS_WAIT(); asm volatile("" ::: "memory");
    const int c = lane & 7;
#pragma unroll
    for (int j = 0; j < 4; ++j) { const int n = (lane >> 3) + 8 * j; const LAS float* s = scr + (8 * c) * 33 + n;
        u32x4 o; o.x = pk_bf16(s[0 * 33], s[1 * 33]); o.y = pk_bf16(s[2 * 33], s[3 * 33]); o.z = pk_bf16(s[4 * 33], s[5 * 33]); o.w = pk_bf16(s[6 * 33], s[7 * 33]);
        *(u32x4*)(WT + (size_t)n * Kd + k0 + 8 * c) = o; }
    LDS_WAIT(); asm volatile("" ::: "memory");
}
__device__ __forceinline__ void prologue_phase(const KA a_in, LAS unsigned char* lds) {
    const KA a = opaque_ka(a_in); const int tid = opaque_tid(), bid = opaque_bid(), lane = tid & 63, wid = tid >> 6;
    const int gw = bid * 8 + wid, NGW = gridDim.x * 8;
    const int gt = bid * 512 + tid, NGT = gridDim.x * 512;
    LAS float* scr = (LAS float*)(lds + wid * 16384);
    constexpr int NT_L = 397, ITEMS_L = NT_L * 16;
    for (int it = gw; it < 2 * ITEMS_L; it += NGW) {
        const int l = it / ITEMS_L, r = it - l * ITEMS_L, nt = r >> 4, k0 = (r & 15) * 64;
        unsigned char* wb = a.ws() + WS_WB + (size_t)l * WB_LAYER;
        const float* win = a.in(I_WIN) + (size_t)l * 1024 * P_IN;
        if (nt < 109) { transpose_item(win + nt * 32, P_IN, (bf16_t*)(wb + WB_WR) + (size_t)nt * 32 * 1024, 1024, k0, scr, lane); }
        else if (nt < 173) { const int n0 = (nt - 109) * 32, pn = n0 >> 8, bj = (n0 >> 7) & 1, x = n0 & 127;
            transpose_item(win + P_RWKV + bj * 1024 + pn * 128 + x, P_IN, (bf16_t*)(wb + WB_WC) + (size_t)n0 * 1024, 1024, k0, scr, lane); }
        else if (nt < 237) { const int n0 = (nt - 173) * 32; transpose_item(win + P_RWKV + 2048 + n0, P_IN, (bf16_t*)(wb + WB_WG) + (size_t)n0 * 1024, 1024, k0, scr, lane); }
        else if (nt < 269) { const int n0 = (nt - 237) * 32; transpose_item(a.in(I_WOA) + (size_t)l * 1048576 + n0, 1024, (bf16_t*)(wb + WB_OA) + (size_t)n0 * 1024, 1024, k0, scr, lane); }
        else if (nt < 301) { const int n0 = (nt - 269) * 32; transpose_item(a.in(I_WOB) + (size_t)l * 1048576 + n0, 1024, (bf16_t*)(wb + WB_OB) + (size_t)n0 * 1024, 1024, k0, scr, lane); }
        else if (nt < 333) { const int n0 = (nt - 301) * 32; transpose_item(a.in(I_WOUT) + (size_t)l * 1048576 + n0, 1024, (bf16_t*)(wb + WB_OUT) + (size_t)n0 * 1024, 1024, k0, scr, lane); }
        else { const int n0 = (nt - 333) * 32; transpose_item(a.in(I_WQ) + (size_t)l * 2097152 + n0, 2048, (bf16_t*)(wb + WB_Q) + (size_t)n0 * 1024, 1024, k0, scr, lane); }
    }
    for (int i = gt; i < 2 * 12288; i += NGT) { const int l = i / 12288, r = i - l * 12288;
        *(u32x4*)(a.ws() + WS_WB + (size_t)l * WB_LAYER + WB_WR + (size_t)3488 * 2048 + (size_t)r * 16) = (u32x4){0u, 0u, 0u, 0u}; }
    for (int i = gt; i < 2 * 32768; i += NGT) { const int l = i >> 15, r = i & 32767, n = r >> 5, kc = r & 31; const float* g2 = a.in(I_G2) + (size_t)l * 160 * 1024;
        float v[8];
#pragma unroll
        for (int j = 0; j < 8; ++j) { const int k = kc * 8 + j; v[j] = k < 160 ? g2[(size_t)k * 1024 + n] : 0.f; }
        u32x4 o; o.x = pk_bf16(v[0], v[1]); o.y = pk_bf16(v[2], v[3]); o.z = pk_bf16(v[4], v[5]); o.w = pk_bf16(v[6], v[7]);
        *(u32x4*)(a.ws() + WS_WB + (size_t)l * WB_LAYER + WB_G2 + (size_t)(n * 256 + kc * 8) * 2) = o; }
    for (int i = gt; i < 2 * 32768; i += NGT) { const int l = i >> 15, r = i & 32767; const f32x4* s = (const f32x4*)(a.in(I_SUBK) + (size_t)l * 262144 + (size_t)r * 8);
        const f32x4 v0 = s[0], v1 = s[1]; *(u32x4*)(a.ws() + WS_WB + (size_t)l * WB_LAYER + WB_SK + (size_t)r * 16) = pack8(v0, v1); }
    __syncthreads();
    LAS float* sil = (LAS float*)lds;
    float* modp = (float*)(a.ws() + WS_Z);
    for (int it = bid; it < 384; it += gridDim.x) {
        const int l = it / 192, r = it - l * 192, ks = r / 12, jt = r - ks * 12;
        for (int idx = tid; idx < 576; idx += 512) { const int i = idx >> 6, kk = idx & 63; const float cv = (i < 8) ? a.in(I_C)[i * 1024 + ks * 64 + kk] : a.in(I_CCTX)[ks * 64 + kk]; sil[idx] = cv * sigm(cv); }
        __syncthreads();
        const int j = jt * 512 + tid; const float* w = a.in(I_ADAW) + ((size_t)l * 1024 + ks * 64) * 6144 + j;
        float acc[9];
#pragma unroll
        for (int i = 0; i < 9; ++i) acc[i] = 0.f;
#pragma unroll 4
        for (int kk = 0; kk < 64; ++kk) { const float wv = w[(size_t)kk * 6144];
#pragma unroll
            for (int i = 0; i < 9; ++i) acc[i] += sil[i * 64 + kk] * wv; }
#pragma unroll
        for (int i = 0; i < 9; ++i) modp[((size_t)(l * 16 + ks) * 9 + i) * 6144 + j] = acc[i];
        __syncthreads();
    }
}
__device__ __forceinline__ void modreduce_phase(const KA a_in) {
    const KA a = opaque_ka(a_in); const int gt = opaque_bid() * 512 + opaque_tid(), NGT = gridDim.x * 512;
    const float* modp = (const float*)(a.ws() + WS_Z); float* mod = (float*)(a.ws() + WS_MOD);
    for (int i = gt; i < 2 * 9 * 6144; i += NGT) { const int l = i / (9 * 6144), r = i - l * 9 * 6144, j = r % 6144;
        float s = a.in(I_ADAB)[l * 6144 + j];
#pragma unroll
        for (int ks = 0; ks < 16; ++ks) s += modp[(size_t)(l * 16 + ks) * 9 * 6144 + r];
        mod[i] = s; }
}

template <bool B16> __device__ __forceinline__ void norm_rows(const void* src, int nrows, int row_off, const f32x4 (&gg)[4], const float* modl, int sh_off, int sc_off, bf16_t* H, int lane, int gw, int NGW) {
    for (int r0 = gw; r0 < nrows; r0 += 2 * NGW) {
        u32x2 wb[2][4]; f32x4 wf[2][4], sh[2][4], sc[2][4];
#pragma unroll
        for (int r = 0; r < 2; ++r) { const int rl = (r0 + r * NGW < nrows) ? r0 + r * NGW : nrows - 1; const int grow = row_off + rl; const int bi = (grow < M_LAT) ? (grow >> 13) : 8;
            const f32x4* shp = (const f32x4*)(modl + bi * 6144 + sh_off) + lane; const f32x4* scp = (const f32x4*)(modl + bi * 6144 + sc_off) + lane;
#pragma unroll
            for (int j = 0; j < 4; ++j) { if (B16) wb[r][j] = ((const u32x2*)((const bf16_t*)src + (size_t)rl * 1024))[lane + 64 * j]; else wf[r][j] = ((const f32x4*)((const float*)src + (size_t)rl * 1024))[lane + 64 * j];
                sh[r][j] = shp[64 * j]; sc[r][j] = scp[64 * j]; } }
#pragma unroll
        for (int r = 0; r < 2; ++r) { const int rl = r0 + r * NGW;
            f32x4 v[4]; float s = 0.f;
#pragma unroll
            for (int j = 0; j < 4; ++j) { v[j] = B16 ? (f32x4){bf_lo(wb[r][j].x), bf_hi(wb[r][j].x), bf_lo(wb[r][j].y), bf_hi(wb[r][j].y)} : wf[r][j];
                s += (v[j].x * v[j].x + v[j].y * v[j].y) + (v[j].z * v[j].z + v[j].w * v[j].w); }
            const float rs = rsqrtf(wave_sum(s, lane) * (1.f / 1024.f) + 1e-6f);
            if (rl < nrows) { u32x2* o8 = (u32x2*)(H + (size_t)(row_off + rl) * 1024) + lane;
#pragma unroll
                for (int j = 0; j < 4; ++j) { const f32x4 y = v[j] * rs * gg[j] * (sc[r][j] + 1.0f) + sh[r][j]; u32x2 o; o.x = pk_bf16(y.x, y.y); o.y = pk_bf16(y.z, y.w); o8[64 * j] = o; } } }
    }
}
__device__ __forceinline__ void norm_phase(const float* xlat, const float* xctx, const float* g, const float* modl, int sh_off, int sc_off, bf16_t* H, int MR = M, const bf16_t* xlat_b = nullptr) {
    const int tid = opaque_tid(); const int lane = tid & 63, gw = opaque_bid() * 8 + (tid >> 6), NGW = gridDim.x * 8;
    f32x4 gg[4];
#pragma unroll
    for (int j = 0; j < 4; ++j) gg[j] = ((const f32x4*)g)[lane + 64 * j];
    const int nlat = MR < M_LAT ? MR : M_LAT;
    if (xlat_b) norm_rows<true>(xlat_b, nlat, 0, gg, modl, sh_off, sc_off, H, lane, gw, NGW); else norm_rows<false>(xlat, nlat, 0, gg, modl, sh_off, sc_off, H, lane, gw, NGW);
    if (MR > M_LAT) norm_rows<false>(xctx, MR - M_LAT, M_LAT, gg, modl, sh_off, sc_off, H, lane, gw, NGW);
}
__device__ __forceinline__ void final_phase(float* x, const float* g, const bf16_t* xb = nullptr) {
    const int tid = opaque_tid(); const int lane = tid & 63, gw = opaque_bid() * 8 + (tid >> 6), NGW = gridDim.x * 8;
    f32x4 gg[4];
#pragma unroll
    for (int j = 0; j < 4; ++j) gg[j] = ((const f32x4*)g)[lane + 64 * j];
    for (int r0 = gw; r0 < M_LAT; r0 += 2 * NGW) {
        u32x2 wb[2][4]; f32x4 wf[2][4];
#pragma unroll
        for (int r = 0; r < 2; ++r) { const int rl = (r0 + r * NGW < M_LAT) ? r0 + r * NGW : M_LAT - 1;
#pragma unroll
            for (int j = 0; j < 4; ++j) { if (xb) wb[r][j] = ((const u32x2*)(xb + (size_t)rl * 1024))[lane + 64 * j]; else wf[r][j] = ((const f32x4*)(x + (size_t)rl * 1024))[lane + 64 * j]; } }
#pragma unroll
        for (int r = 0; r < 2; ++r) { const int rl = r0 + r * NGW;
            f32x4 v[4]; float s = 0.f;
#pragma unroll
            for (int j = 0; j < 4; ++j) { v[j] = xb ? (f32x4){bf_lo(wb[r][j].x), bf_hi(wb[r][j].x), bf_lo(wb[r][j].y), bf_hi(wb[r][j].y)} : wf[r][j];
                s += (v[j].x * v[j].x + v[j].y * v[j].y) + (v[j].z * v[j].z + v[j].w * v[j].w); }
            const float rs = rsqrtf(wave_sum(s, lane) * (1.f / 1024.f) + 1e-6f);
            if (rl < M_LAT) { f32x4* xr = (f32x4*)(x + (size_t)rl * 1024) + lane;
#pragma unroll
                for (int j = 0; j < 4; ++j) xr[64 * j] = v[j] * rs * gg[j]; } }
    }
}
typedef float f32x2v __attribute__((ext_vector_type(2)));
__device__ __forceinline__ unsigned pk4_fp8(float f0, float f1, float f2, float f3) { int w = __builtin_amdgcn_cvt_pk_fp8_f32(f0, f1, 0, false); w = __builtin_amdgcn_cvt_pk_fp8_f32(f2, f3, w, true); return (unsigned)w; }
constexpr float PU_SCALE = 512.0f, PV_SCALE = 16.0f;
__device__ __forceinline__ void convert_tables(const KA a_in, int l) {
    const KA a = opaque_ka(a_in); const int gt = opaque_bid() * 512 + opaque_tid(), NGT = gridDim.x * 512;
    const f32x4* su = (const f32x4*)(a.in(I_PU) + (size_t)l * 16777216); const f32x4* sv = (const f32x4*)(a.in(I_PV) + (size_t)l * 16777216);
    u32x4* du = (u32x4*)(a.ws() + WS_PT); u32x4* dv = (u32x4*)(a.ws() + WS_PT + 16 * MiB);
    for (int i = gt; i < 1048576; i += NGT) {
        { const f32x4 a0 = su[4 * i] * PU_SCALE, a1 = su[4 * i + 1] * PU_SCALE, a2 = su[4 * i + 2] * PU_SCALE, a3 = su[4 * i + 3] * PU_SCALE;
          u32x4 o; o.x = pk4_fp8(a0[0], a0[1], a0[2], a0[3]); o.y = pk4_fp8(a1[0], a1[1], a1[2], a1[3]); o.z = pk4_fp8(a2[0], a2[1], a2[2], a2[3]); o.w = pk4_fp8(a3[0], a3[1], a3[2], a3[3]); du[i] = o; }
        { const f32x4 a0 = sv[4 * i] * PV_SCALE, a1 = sv[4 * i + 1] * PV_SCALE, a2 = sv[4 * i + 2] * PV_SCALE, a3 = sv[4 * i + 3] * PV_SCALE;
          u32x4 o; o.x = pk4_fp8(a0[0], a0[1], a0[2], a0[3]); o.y = pk4_fp8(a1[0], a1[1], a1[2], a1[3]); o.z = pk4_fp8(a2[0], a2[1], a2[2], a2[3]); o.w = pk4_fp8(a3[0], a3[1], a3[2], a3[3]); dv[i] = o; }
    }
}

typedef unsigned u32x6 __attribute__((ext_vector_type(6)));
typedef float f32x32 __attribute__((ext_vector_type(32)));
typedef __bf16 bf16x32 __attribute__((ext_vector_type(32)));
typedef unsigned u32x16 __attribute__((ext_vector_type(16)));
typedef u32x4 u32x4_a8 __attribute__((aligned(8)));
constexpr size_t PT_SC = PEER_SLICED ? 32 * MiB : 12 * MiB, PT_V6 = 16 * MiB, PT_SLICE = (size_t)16384 * 128;
constexpr size_t WS_PP = WS_Z, WS_X4 = WS_Z + 140 * MiB, WS_ACT = WS_Z + 300 * MiB, WS_E16 = WS_Z + 340 * MiB;
__device__ __forceinline__ unsigned fp6_code(float y) {
    const float m = __builtin_fabsf(y);
    const float r8 = __builtin_rintf(m * 8.f), r4 = __builtin_rintf(m * 4.f) + 8.f, r2 = fminf(__builtin_rintf(m * 2.f) + 16.f, 31.f);
    const float cf = (m < 2.f) ? r8 : ((m < 4.f) ? r4 : r2);
    return (unsigned)cf | ((y < 0.f) ? 32u : 0u);
}
__device__ __forceinline__ float fp6_segment(const float* src, unsigned char* dst, int lane) {
    f32x4 v[8]; float m = 0.f;
#pragma unroll
    for (int q = 0; q < 8; ++q) { v[q] = ((const f32x4*)src)[q]; m = fmaxf(m, fmaxf(fmaxf(__builtin_fabsf(v[q][0]), __builtin_fabsf(v[q][1])), fmaxf(__builtin_fabsf(v[q][2]), __builtin_fabsf(v[q][3])))); }
    m = fmaxf(m, shxf(m, 16, lane)); m = fmaxf(m, shxf(m, 8, lane)); m = fmaxf(m, shxf(m, 4, lane)); m = fmaxf(m, shxf(m, 2, lane)); m = fmaxf(m, shxf(m, 1, lane));
    const float inv = (m > 0.f) ? 7.5f / m : 0.f;
    unsigned d0 = 0u, d1 = 0u, d2 = 0u, d3 = 0u, d4 = 0u, d5 = 0u;
#pragma unroll
    for (int i = 0; i < 32; ++i) { const unsigned cd = fp6_code(v[i >> 2][i & 3] * inv); const int bp = 6 * i, wd = bp >> 5, sh = bp & 31;
        const unsigned lo = cd << sh, hi = (sh > 26) ? (cd >> (32 - sh)) : 0u;
        if (wd == 0) { d0 |= lo; d1 |= hi; } else if (wd == 1) { d1 |= lo; d2 |= hi; } else if (wd == 2) { d2 |= lo; d3 |= hi; } else if (wd == 3) { d3 |= lo; d4 |= hi; } else if (wd == 4) { d4 |= lo; d5 |= hi; } else { d5 |= lo; } }
    *(u32x4_a8*)dst = (u32x4){d0, d1, d2, d3}; *(u32x2*)(dst + 16) = (u32x2){d4, d5};
    return (m > 0.f) ? m * (1.0f / 7.5f) : 1.0f;
}
__device__ __forceinline__ void convert_tables6(const KA a_in, int l) {
    const KA a = opaque_ka(a_in); const int tid = opaque_tid(); const int lane = tid & 63, li = lane & 31, hw = (opaque_bid() * 512 + tid) >> 5, NHW = gridDim.x * 16;
    const float* su = a.in(I_PU) + (size_t)l * 16777216; const float* sv = a.in(I_PV) + (size_t)l * 16777216;
    unsigned char* du = a.ws() + WS_PT; unsigned char* dv = a.ws() + WS_PT + PT_V6; float* sc = (float*)(a.ws() + WS_PT + PT_SC);
    for (int row = hw; row < 16384; row += NHW) {
        const size_t dof = PEER_SLICED ? (size_t)(li >> 2) * PT_SLICE + (size_t)row * 128 + (li & 3) * 24 : (size_t)row * 768 + li * 24;
        const float s0 = fp6_segment(su + (size_t)row * 1024 + li * 32, du + dof, lane);
        const float s1 = fp6_segment(sv + (size_t)row * 1024 + li * 32, dv + dof, lane);
        if (li == 0) { sc[2 * row] = s0; sc[2 * row + 1] = s1; }
    }
}

__device__ __forceinline__ void scan_load(u32x4 (&pre)[3], const bf16_t* ZR, int seq_base, int len, int tlo, int h, int d, int tid) {
#pragma unroll
    for (int q = 0; q < 3; ++q) {
        const int piece = tid + 512 * q; u32x4 v = (u32x4){0u, 0u, 0u, 0u};
        if (piece < 1360) { const int row = piece / 40, rem = piece - row * 40, grp = rem >> 3, sub = rem & 7; const int t = tlo - 1 + row;
            const int cbase = (grp < 3) ? (grp * 1024 + h * 64) : ((grp == 3 ? C_W1 : C_A1) + d * 64);
            if (t >= 0 && t < len) v = *(const u32x4*)(ZR + (size_t)(seq_base + t) * NZR + cbase + sub * 8); }
        pre[q] = v;
    }
}
__device__ __forceinline__ void scan_phase(const KA a_in, LAS unsigned char* lds, int l) {
    const KA a = opaque_ka(a_in); const int tid = opaque_tid(), bid = opaque_bid(), lane = tid & 63, wid = __builtin_amdgcn_readfirstlane(tid >> 6), col = lane;
    LAS float* RAW = (LAS float*)lds;
    LAS bf16_t* TA = (LAS bf16_t*)(lds + 43520);
    LAS float* LW = (LAS float*)(lds + 51712);
    LAS float* OP = (LAS float*)(lds + 68096);
    LAS float* YL = (LAS float*)(lds + 117248);
#if SCAN_CHUNKED
    LAS bf16_t* KTm = (LAS bf16_t*)(lds + 0);      LAS bf16_t* RTm = (LAS bf16_t*)(lds + 2048);  LAS bf16_t* BPm = (LAS bf16_t*)(lds + 4096);  LAS bf16_t* KPm = (LAS bf16_t*)(lds + 6144);
    LAS bf16_t* BHT = (LAS bf16_t*)(lds + 8192);   LAS bf16_t* KHT = (LAS bf16_t*)(lds + 12288); LAS bf16_t* VTm = (LAS bf16_t*)(lds + 16384); LAS bf16_t* UTm = (LAS bf16_t*)(lds + 20480); LAS bf16_t* XTm = (LAS bf16_t*)(lds + 24576);
    LAS bf16_t* TPm = (LAS bf16_t*)(lds + 28672);  LAS bf16_t* AKD = (LAS bf16_t*)(lds + 29696); LAS bf16_t* NBm = (LAS bf16_t*)(lds + 30720); LAS bf16_t* NKD = (LAS bf16_t*)(lds + 31744);
    LAS float* ABm = (LAS float*)(lds + 32768);
    LAS float* GCm = (LAS float*)(lds + 33792);
    LAS bf16_t* S0b = (LAS bf16_t*)(lds + 132096);
#endif
    const bf16_t* ZR = (const bf16_t*)(a.ws() + WS_Z);
    float* BON = (float*)(a.ws() + WS_BON);
    const float* smu = a.in(I_SMU) + (size_t)l * 2 * P_RWKV;
    for (int chain = bid; chain < 256; chain += gridDim.x) {
        const int b = chain >> 5, h = (chain >> 1) & 15, d = chain & 1;
        bf16_t* Yd = (bf16_t*)(a.ws() + (d ? WS_YB : WS_YF));
        float mu0[5], mu1[5];
#pragma unroll
        for (int g = 0; g < 5; ++g) { const int cb = (g < 3) ? (g * 1024 + h * 64) : ((g == 3 ? C_W1 : C_A1) + d * 64); mu0[g] = smu[cb + col]; mu1[g] = smu[P_RWKV + cb + col]; }
        const int hc = h * 64 + col;
        const float w0c = a.in(I_W0)[(l * 2 + d) * 1024 + hc], a0c = a.in(I_A0)[(l * 2 + d) * 1024 + hc];
        const float kkc = a.in(I_KK)[l * 1024 + hc], kac = a.in(I_KA)[l * 1024 + hc], rkc = a.in(I_RK)[l * 1024 + hc];
        const int mm = wid >> 2, ct = wid & 3;
        bf16x8 Bf[2];
        { const float* lw = (mm == 0 ? a.in(I_W2) : a.in(I_A2)) + (size_t)(l * 2 + d) * 64 * 1024 + h * 64 + ct * 16 + (lane & 15);
#pragma unroll
          for (int ks = 0; ks < 2; ++ks) { float v[8];
#pragma unroll
              for (int j = 0; j < 8; ++j) v[j] = lw[(size_t)(ks * 32 + (lane >> 4) * 8 + j) * 1024];
              u32x4 w; w.x = pk_bf16(v[0], v[1]); w.y = pk_bf16(v[2], v[3]); w.z = pk_bf16(v[4], v[5]); w.w = pk_bf16(v[6], v[7]); Bf[ks] = __builtin_bit_cast(bf16x8, w); } }
        float S0[4] = {0.f, 0.f, 0.f, 0.f}, S1[4] = {0.f, 0.f, 0.f, 0.f}; (void)S0; (void)S1;
#if SCAN_CHUNKED
        f32x4 Sacc[2] = {(f32x4){0.f, 0.f, 0.f, 0.f}, (f32x4){0.f, 0.f, 0.f, 0.f}};
#endif
        const int g4 = lane >> 4, kq = lane & 15, row0 = wid * 8 + 2 * g4;
        u32x4 pre[3];
        scan_load(pre, ZR, M_LAT + b * CTXL, CTXL, d ? CTXL - 32 : 0, h, d, tid);
#if SCAN_SEC >= 0
        unsigned long long tacc[8] = {0, 0, 0, 0, 0, 0, 0, 0}; unsigned long long tlast = __builtin_amdgcn_s_memtime();
#define SSTAMP(k) do { const unsigned long long _n = __builtin_amdgcn_s_memtime(); tacc[k] += _n - tlast; tlast = _n; } while (0)
#else
#define SSTAMP(k) do {} while (0)
#endif
        for (int cc = 0; cc < 264; ++cc) {
            const int seg = cc >= 8, c = seg ? cc - 8 : cc, len = seg ? SEQ : CTXL;
            const int seq_base = seg ? b * SEQ : M_LAT + b * CTXL;
            const int tlo = d ? len - 32 * (c + 1) : 32 * c;
#pragma unroll
            for (int q = 0; q < 3; ++q) { const int piece = tid + 512 * q;
                if (piece < 1360) { const int row = piece / 40, rem = piece - row * 40; LAS float* dst = RAW + row * 320 + rem * 8; f32x4 v0, v1; unpack8(pre[q], v0, v1); *(LAS f32x4*)dst = v0; *(LAS f32x4*)(dst + 4) = v1; } }
            if (cc + 1 < 264) { const int c2 = cc + 1, seg2 = c2 >= 8, cn = seg2 ? c2 - 8 : c2, len2 = seg2 ? SEQ : CTXL;
                scan_load(pre, ZR, seg2 ? b * SEQ : M_LAT + b * CTXL, len2, d ? len2 - 32 * (cn + 1) : 32 * cn, h, d, tid); }
            __syncthreads(); SSTAMP(0);
#pragma unroll
            for (int i = 0; i < 4; ++i) { const int trow = wid + 8 * i; const LAS float* r0 = RAW + trow * 320 + col;
                const float zw0 = r0[192], zw1 = r0[320 + 192], zw2 = r0[640 + 192]; const float w1v = zw1 + mu0[3] * (zw0 - zw1) + mu1[3] * (zw2 - zw1);
                const float za0 = r0[256], za1 = r0[320 + 256], za2 = r0[640 + 256]; const float a1v = za1 + mu0[4] * (za0 - za1) + mu1[4] * (za2 - za1);
                TA[trow * 64 + col] = (bf16_t)(pk_bf16(2.0f * sigm(2.0f * w1v) - 1.0f, 0.f) & 0xffffu); TA[2048 + trow * 64 + col] = (bf16_t)(pk_bf16(a1v, 0.f) & 0xffffu); }
            __syncthreads(); SSTAMP(1);
#pragma unroll
            for (int rt = 0; rt < 2; ++rt) { f32x4 acc = (f32x4){0.f, 0.f, 0.f, 0.f};
#pragma unroll
                for (int ks = 0; ks < 2; ++ks) { const bf16x8 Af = *(const LAS bf16x8*)(TA + (mm * 32 + rt * 16 + (lane & 15)) * 64 + ks * 32 + (lane >> 4) * 8); acc = __builtin_amdgcn_mfma_f32_16x16x32_bf16(Af, Bf[ks], acc, 0, 0, 0); }
#pragma unroll
                for (int rg = 0; rg < 4; ++rg) LW[(mm * 32 + rt * 16 + (lane >> 4) * 4 + rg) * 64 + ct * 16 + (lane & 15)] = acc[rg]; }
            __syncthreads(); SSTAMP(2);
#pragma unroll
            for (int i = 0; i < 4; ++i) { const int trow = wid + 8 * i; const LAS float* r0 = RAW + trow * 320 + col;
                const float zr0 = r0[0], zr1 = r0[320], zr2 = r0[640]; const float rv = zr1 + mu0[0] * (zr0 - zr1) + mu1[0] * (zr2 - zr1);
                const float zk0 = r0[64], zk1 = r0[320 + 64], zk2 = r0[640 + 64]; const float kv = zk1 + mu0[1] * (zk0 - zk1) + mu1[1] * (zk2 - zk1);
                const float zv0 = r0[128], zv1 = r0[320 + 128], zv2 = r0[640 + 128]; const float vv = zv1 + mu0[2] * (zv0 - zv1) + mu1[2] * (zv2 - zv1);
                const float wl = LW[trow * 64 + col] + w0c; const float dec = __expf(-0.60653066f * sigm(wl));
                const float av = sigm(LW[2048 + trow * 64 + col] + a0c);
                const float kkr = kv * kkc; const float n2 = wave_sum(kkr * kkr, lane); const float kk = kkr * __builtin_amdgcn_rsqf(fmaxf(n2, 1e-24f));
                const float kd = kv * (1.f + (av - 1.f) * kac); const float bb = kk * av;
                const float bon = wave_sum(rv * kd * rkc, lane);
                const int s = d ? 31 - trow : trow; LAS float* op = OP + s * 384 + col;
                op[0] = dec; op[64] = kk; op[128] = bb; op[192] = kd; op[256] = rv; op[320] = vv;
                if (lane == 0) BON[((size_t)d * M + seq_base + tlo + trow) * 16 + h] = bon; }
            __syncthreads(); SSTAMP(3);
#if SCAN_CHUNKED
            {
                LAS u32x4* z = (LAS u32x4*)(lds + 8192);
#pragma unroll
                for (int q = 0; q < 3; ++q) z[tid + 512 * q] = (u32x4){0u, 0u, 0u, 0u};
            }
            __syncthreads(); SSTAMP(4);
#pragma unroll 1
            for (int sub = 0; sub < 2; ++sub) {
                const int sb = sub * 16;
                { const int k = lane, i0 = 2 * wid, i1 = i0 + 1;
                  float p = 1.f, gp0 = 1.f, g0 = 1.f, gp1 = 1.f, g1 = 1.f;
#pragma unroll
                  for (int i = 0; i < 16; ++i) { const float wi = OP[(sb + i) * 384 + k]; if (i == i0) gp0 = p; if (i == i1) gp1 = p; p *= wi; if (i == i0) g0 = p; if (i == i1) g1 = p; }
                  const float gC = p;
#pragma unroll
                  for (int rr = 0; rr < 2; ++rr) { const int i = rr ? i1 : i0; const float gi = rr ? g1 : g0, gpi = rr ? gp1 : gp0; const float inv = __builtin_amdgcn_rcpf(gi), gcg = gC * inv;
                      const LAS float* op = OP + (sb + i) * 384 + k; const float kkv = op[64], bv = op[128], kdv = op[192], rv = op[256], vv = op[320];
                      KTm[i * 64 + k] = f2b(kkv * gpi); RTm[i * 64 + k] = f2b(rv * gi); BPm[i * 64 + k] = f2b(bv * inv); KPm[i * 64 + k] = f2b(kdv * inv);
                      BHT[k * 32 + i] = f2b(bv * gcg); KHT[k * 32 + i] = f2b(kdv * gcg); VTm[k * 32 + i] = f2b(vv); }
                  if (wid == 0) GCm[k] = gC;
#pragma unroll
                  for (int q = 0; q < 2; ++q) { const int vt = wid >> 1, kt = (wid & 1) * 2 + q;
#pragma unroll
                      for (int rg = 0; rg < 4; ++rg) S0b[(16 * vt + (lane >> 4) * 4 + rg) * 64 + 16 * kt + (lane & 15)] = f2b(Sacc[q][rg]); } }
                __syncthreads();
                f32x4 xs = (f32x4){0.f, 0.f, 0.f, 0.f};
                if (wid < 4) { const LAS bf16_t* Lm = (wid < 2) ? KTm : RTm; const LAS bf16_t* Rm = (wid & 1) ? KPm : BPm; f32x4 acc = (f32x4){0.f, 0.f, 0.f, 0.f};
#pragma unroll
                    for (int ks = 0; ks < 2; ++ks) { const bf16x8 Af = *(const LAS bf16x8*)(Lm + (lane & 15) * 64 + ks * 32 + (lane >> 4) * 8), Bf2 = *(const LAS bf16x8*)(Rm + (lane & 15) * 64 + ks * 32 + (lane >> 4) * 8);
                        acc = __builtin_amdgcn_mfma_f32_16x16x32_bf16(Af, Bf2, acc, 0, 0, 0); }
                    const int j = lane & 15;
                    if (wid == 0) {
                        const int c = lane & 15; float tt[16];
#pragma unroll
                        for (int i = 0; i < 16; ++i) { float a0 = (i == c) ? 1.f : 0.f, a1 = 0.f, a2 = 0.f, a3 = 0.f;
#pragma unroll
                            for (int m = 0; m < i; ++m) { const float pr = rdl(acc[i & 3], m + 16 * (i >> 2)) * tt[m]; if ((m & 3) == 0) a0 -= pr; else if ((m & 3) == 1) a1 -= pr; else if ((m & 3) == 2) a2 -= pr; else a3 -= pr; }
                            tt[i] = (a0 + a1) + (a2 + a3); }
                        if (lane < 16) {
#pragma unroll
                            for (int i = 0; i < 16; ++i) TPm[i * 32 + c] = f2b(tt[i]); } }
                    else {
#pragma unroll
                    for (int rg = 0; rg < 4; ++rg) { const int i = (lane >> 4) * 4 + rg; const bool keep = (wid < 2) ? (j < i) : (j <= i); const float val = keep ? acc[rg] : 0.f;
                        if (wid == 1) AKD[i * 32 + j] = f2b(val); else if (wid == 2) NBm[i * 32 + j] = f2b(val); else NKD[i * 32 + j] = f2b(val); } } }
                else { const int t4 = wid - 4;
#pragma unroll
                    for (int ks = 0; ks < 2; ++ks) { const bf16x8 Af = *(const LAS bf16x8*)(KTm + (lane & 15) * 64 + ks * 32 + (lane >> 4) * 8), Bf2 = *(const LAS bf16x8*)(S0b + (16 * t4 + (lane & 15)) * 64 + ks * 32 + (lane >> 4) * 8);
                        xs = __builtin_amdgcn_mfma_f32_16x16x32_bf16(Af, Bf2, xs, 0, 0, 0); } }
                __syncthreads();
                if (wid >= 4) { const int t4 = wid - 4;
                    const bf16x8 Af = *(const LAS bf16x8*)(AKD + (lane & 15) * 32 + (lane >> 4) * 8), Bf2 = *(const LAS bf16x8*)(VTm + (16 * t4 + (lane & 15)) * 32 + (lane >> 4) * 8);
                    xs = __builtin_amdgcn_mfma_f32_16x16x32_bf16(Af, Bf2, xs, 0, 0, 0);
                    u32x2 o; o.x = pk_bf16(xs[0], xs[1]); o.y = pk_bf16(xs[2], xs[3]); *(LAS u32x2*)(XTm + (16 * t4 + (lane & 15)) * 32 + (lane >> 4) * 4) = o; }
                __syncthreads();
                if (wid < 4) { const bf16x8 Af = *(const LAS bf16x8*)(TPm + (lane & 15) * 32 + (lane >> 4) * 8), Bf2 = *(const LAS bf16x8*)(XTm + (16 * wid + (lane & 15)) * 32 + (lane >> 4) * 8);
                    f32x4 u = __builtin_amdgcn_mfma_f32_16x16x32_bf16(Af, Bf2, (f32x4){0.f, 0.f, 0.f, 0.f}, 0, 0, 0);
                    u32x2 o; o.x = pk_bf16(-u[0], -u[1]); o.y = pk_bf16(-u[2], -u[3]); *(LAS u32x2*)(UTm + (16 * wid + (lane & 15)) * 32 + (lane >> 4) * 4) = o; }
                __syncthreads();
                if (wid < 4) { f32x4 y = (f32x4){0.f, 0.f, 0.f, 0.f};
#pragma unroll
                    for (int ks = 0; ks < 2; ++ks) { const bf16x8 Af = *(const LAS bf16x8*)(RTm + (lane & 15) * 64 + ks * 32 + (lane >> 4) * 8), Bf2 = *(const LAS bf16x8*)(S0b + (16 * wid + (lane & 15)) * 64 + ks * 32 + (lane >> 4) * 8);
                        y = __builtin_amdgcn_mfma_f32_16x16x32_bf16(Af, Bf2, y, 0, 0, 0); }
                    { const bf16x8 Af = *(const LAS bf16x8*)(NBm + (lane & 15) * 32 + (lane >> 4) * 8), Bf2 = *(const LAS bf16x8*)(UTm + (16 * wid + (lane & 15)) * 32 + (lane >> 4) * 8); y = __builtin_amdgcn_mfma_f32_16x16x32_bf16(Af, Bf2, y, 0, 0, 0); }
                    { const bf16x8 Af = *(const LAS bf16x8*)(NKD + (lane & 15) * 32 + (lane >> 4) * 8), Bf2 = *(const LAS bf16x8*)(VTm + (16 * wid + (lane & 15)) * 32 + (lane >> 4) * 8); y = __builtin_amdgcn_mfma_f32_16x16x32_bf16(Af, Bf2, y, 0, 0, 0); }
#pragma unroll
                    for (int rg = 0; rg < 4; ++rg) YL[(sb + (lane >> 4) * 4 + rg) * 64 + 16 * wid + (lane & 15)] = y[rg]; }
#pragma unroll
                for (int q = 0; q < 2; ++q) { const int vt = wid >> 1, kt = (wid & 1) * 2 + q; const float gc = GCm[16 * kt + (lane & 15)];
                    f32x4 sacc = Sacc[q] * gc;
                    { const bf16x8 Af = *(const LAS bf16x8*)(UTm + (16 * vt + (lane & 15)) * 32 + (lane >> 4) * 8), Bf2 = *(const LAS bf16x8*)(BHT + (16 * kt + (lane & 15)) * 32 + (lane >> 4) * 8); sacc = __builtin_amdgcn_mfma_f32_16x16x32_bf16(Af, Bf2, sacc, 0, 0, 0); }
                    { const bf16x8 Af = *(const LAS bf16x8*)(VTm + (16 * vt + (lane & 15)) * 32 + (lane >> 4) * 8), Bf2 = *(const LAS bf16x8*)(KHT + (16 * kt + (lane & 15)) * 32 + (lane >> 4) * 8); sacc = __builtin_amdgcn_mfma_f32_16x16x32_bf16(Af, Bf2, sacc, 0, 0, 0); }
                    Sacc[q] = sacc; }
                __syncthreads();
            } SSTAMP(5);
#else
#pragma unroll 4
            for (int s = 0; s < 32; ++s) { const LAS float* op = OP + s * 384;
                const f32x4 w4 = *(const LAS f32x4*)(op + kq * 4), kk4 = *(const LAS f32x4*)(op + 64 + kq * 4), b4 = *(const LAS f32x4*)(op + 128 + kq * 4);
                const f32x4 kd4 = *(const LAS f32x4*)(op + 192 + kq * 4), r4 = *(const LAS f32x4*)(op + 256 + kq * 4); const f32x2 v2 = *(const LAS f32x2*)(op + 320 + row0);
                float sa0 = (S0[0] * kk4[0] + S0[1] * kk4[1]) + (S0[2] * kk4[2] + S0[3] * kk4[3]); float sa1 = (S1[0] * kk4[0] + S1[1] * kk4[1]) + (S1[2] * kk4[2] + S1[3] * kk4[3]);
                sa0 = red16(sa0); sa1 = red16(sa1);
#pragma unroll
                for (int j = 0; j < 4; ++j) { S0[j] = S0[j] * w4[j] + (v2.x * kd4[j] - sa0 * b4[j]); S1[j] = S1[j] * w4[j] + (v2.y * kd4[j] - sa1 * b4[j]); }
                float y0 = (S0[0] * r4[0] + S0[1] * r4[1]) + (S0[2] * r4[2] + S0[3] * r4[3]); float y1 = (S1[0] * r4[0] + S1[1] * r4[1]) + (S1[2] * r4[2] + S1[3] * r4[3]);
                y0 = red16(y0); y1 = red16(y1);
                if (kq == 0) *(LAS f32x2*)(YL + s * 64 + row0) = (f32x2){y0, y1}; }
            __syncthreads();
#endif
            { const int i = tid >> 4, c4 = (tid & 15) * 4; const int s = d ? 31 - i : i; const f32x4 y = *(const LAS f32x4*)(YL + s * 64 + c4);
              u32x2 o; o.x = pk_bf16(y[0], y[1]); o.y = pk_bf16(y[2], y[3]); *(u32x2*)(Yd + (size_t)(seq_base + tlo + i) * 1024 + h * 64 + c4) = o; } SSTAMP(6);
        }
#if SCAN_SEC >= 0
        if (bid == 0 && tid == 0 && l == 0) { unsigned long long tot = 0; for (int q = 0; q < 8; ++q) tot += tacc[q]; ((unsigned*)(a.ws() + WS_CTL))[12] = (unsigned)((40ull * tacc[SCAN_SEC] + tot / 2) / tot); }
#endif
        __syncthreads();
    }
}

typedef short bf16x4 __attribute__((ext_vector_type(4)));
__device__ __forceinline__ bf16x4 pk4(float x0, float x1, float x2, float x3) { u32x2 w; w.x = pk_bf16(x0, x1); w.y = pk_bf16(x2, x3); return __builtin_bit_cast(bf16x4, w); }
__device__ __forceinline__ bf16x4 pk4v(f32x4 v) { return pk4(v[0], v[1], v[2], v[3]); }
__device__ __forceinline__ f32x4 mfma16(bf16x4 a, bf16x4 b, f32x4 c) { return __builtin_amdgcn_mfma_f32_16x16x16bf16_1k(a, b, c, 0, 0, 0); }
__device__ __forceinline__ void scan_load2(u32x4 (&pre)[4], const bf16_t* ZR, int seq_base, int len, int tlo, int h, int d, int lane) {
#pragma unroll
    for (int q = 0; q < 4; ++q) { const int piece = lane + 64 * q; u32x4 v = (u32x4){0u, 0u, 0u, 0u};
        if (piece < 240) { const int row = piece / 40, rem = piece - row * 40, grp = rem >> 3, sub = rem & 7; const int t = tlo - 1 + row;
            const int cbase = (grp < 3) ? (grp * 1024 + h * 64) : ((grp == 3 ? C_W1 : C_A1) + d * 64);
            if (t >= 0 && t < len) v = *(const u32x4*)(ZR + (size_t)(seq_base + t) * NZR + cbase + sub * 8); }
        pre[q] = v; }
}
__device__ __forceinline__ void scan_phase2(const KA a_in, LAS unsigned char* lds, int l) {
    const KA a = opaque_ka(a_in); const int tid = opaque_tid(), bid = opaque_bid(), lane = tid & 63, wid = __builtin_amdgcn_readfirstlane(tid >> 6), col = lane;
    constexpr int IMG_SZ = 18688, OP_SZ = 24576, PRV_SZ = 7936, NSUB = 528;
    LAS unsigned char* const IMG0 = lds; LAS unsigned char* const OP0 = lds + 2 * IMG_SZ; LAS unsigned char* const PRV0 = lds + 2 * IMG_SZ + 2 * OP_SZ;
    const bf16_t* ZR = (const bf16_t*)(a.ws() + WS_Z); float* BON = (float*)(a.ws() + WS_BON);
    const float* smu = a.in(I_SMU) + (size_t)l * 2 * P_RWKV;
    for (int chain = bid; chain < 256; chain += gridDim.x) {
        const int b = chain >> 5, h = (chain >> 1) & 15, d = chain & 1;
        bf16_t* Yd = (bf16_t*)(a.ws() + (d ? WS_YB : WS_YF));
        const int g = lane >> 4, c = lane & 15;
        const int p = wid - 4;
        LAS bf16_t* RAWp = (LAS bf16_t*)(PRV0 + (p & 3) * PRV_SZ);
        LAS bf16_t* TAp = (LAS bf16_t*)(PRV0 + (p & 3) * PRV_SZ + 3840);
        float mu0[5], mu1[5]; float w0c = 0.f, a0c = 0.f, kkc = 0.f, kac = 0.f, rkc = 0.f; bf16x8 Bf[2][4][2]; u32x4 pre[4];
        LAS float* WL = (LAS float*)OP0;
        __syncthreads();
        for (int i = tid; i < 8192; i += 512) { const int mm = i >> 12, r = (i >> 6) & 63, cc = i & 63; WL[i] = (mm == 0 ? a.in(I_W2) : a.in(I_A2))[((size_t)(l * 2 + d) * 64 + r) * 1024 + h * 64 + cc]; }
        __syncthreads();
        if (wid >= 4) {
#pragma unroll
            for (int gq = 0; gq < 5; ++gq) { const int cb = (gq < 3) ? (gq * 1024 + h * 64) : ((gq == 3 ? C_W1 : C_A1) + d * 64); mu0[gq] = smu[cb + col]; mu1[gq] = smu[P_RWKV + cb + col]; }
            const int hc = h * 64 + col;
            w0c = a.in(I_W0)[(l * 2 + d) * 1024 + hc]; a0c = a.in(I_A0)[(l * 2 + d) * 1024 + hc]; kkc = a.in(I_KK)[l * 1024 + hc]; kac = a.in(I_KA)[l * 1024 + hc]; rkc = a.in(I_RK)[l * 1024 + hc];
#pragma unroll
            for (int mm = 0; mm < 2; ++mm)
#pragma unroll
                for (int ct = 0; ct < 4; ++ct)
#pragma unroll
                    for (int ks = 0; ks < 2; ++ks) { const LAS float* lw = WL + mm * 4096 + (ks * 32 + g * 8) * 64 + ct * 16 + c;
                        u32x4 w; w.x = pk_bf16(lw[0], lw[64]); w.y = pk_bf16(lw[128], lw[192]); w.z = pk_bf16(lw[256], lw[320]); w.w = pk_bf16(lw[384], lw[448]); Bf[mm][ct][ks] = __builtin_bit_cast(bf16x8, w); }
#pragma unroll
            for (int q = 0; q < 4; ++q) ((LAS u32x4*)TAp)[lane + 64 * q] = (u32x4){0u, 0u, 0u, 0u};
            { const int len = CTXL, p0 = 0; const int tlo = d ? len - 1 - (p0 + 4 * p + 3) : p0 + 4 * p; scan_load2(pre, ZR, M_LAT + b * CTXL, len, tlo, h, d, lane); }
        }
        bf16x4 SEL1, SEL2, ONES4;
        { u32x2 w; w.x = (c == 0 ? 0x3F80u : 0u) | (c == 1 ? 0x3F800000u : 0u); w.y = (c == 2 ? 0x3F80u : 0u) | (c == 3 ? 0x3F800000u : 0u); SEL1 = __builtin_bit_cast(bf16x4, w);
          w.x = (c == 4 ? 0x3F80u : 0u) | (c == 5 ? 0x3F800000u : 0u); w.y = (c == 6 ? 0x3F80u : 0u) | (c == 7 ? 0x3F800000u : 0u); SEL2 = __builtin_bit_cast(bf16x4, w);
          w.x = 0x3F803F80u; w.y = 0x3F803F80u; ONES4 = __builtin_bit_cast(bf16x4, w); }
        f32x4 ST[4] = {(f32x4){0.f, 0.f, 0.f, 0.f}, (f32x4){0.f, 0.f, 0.f, 0.f}, (f32x4){0.f, 0.f, 0.f, 0.f}, (f32x4){0.f, 0.f, 0.f, 0.f}};
        __syncthreads();
#pragma unroll 1
        for (int n = -2; n < NSUB; ++n) {
            if (wid >= 4) {
                const int s2 = n + 2;
                if (s2 < NSUB) {
                    const int seg = s2 >= 16, len = seg ? SEQ : CTXL, seq_base = seg ? b * SEQ : M_LAT + b * CTXL, p0 = 16 * (seg ? s2 - 16 : s2);
#pragma unroll
                    for (int q = 0; q < 4; ++q) { const int piece = lane + 64 * q; if (piece < 240) ((LAS u32x4*)RAWp)[piece] = pre[q]; }
                    if (s2 + 1 < NSUB) { const int s3 = s2 + 1, seg3 = s3 >= 16, len3 = seg3 ? SEQ : CTXL, p03 = 16 * (seg3 ? s3 - 16 : s3); const int tlo3 = d ? len3 - 1 - (p03 + 4 * p + 3) : p03 + 4 * p;
                        scan_load2(pre, ZR, seg3 ? b * SEQ : M_LAT + b * CTXL, len3, tlo3, h, d, lane); }
                    LDS_WAIT(); asm volatile("" ::: "memory");
                    const int tlo = d ? len - 1 - (p0 + 4 * p + 3) : p0 + 4 * p;
                    float rv[4], kv[4], vv[4];
                    { float zz[6][5];
#pragma unroll
                      for (int rr = 0; rr < 6; ++rr)
#pragma unroll
                          for (int gq = 0; gq < 5; ++gq) zz[rr][gq] = __builtin_bit_cast(float, (unsigned)RAWp[rr * 320 + gq * 64 + col] << 16);
#pragma unroll
                      for (int j = 0; j < 4; ++j) {
                          rv[j] = zz[j + 1][0] + mu0[0] * (zz[j][0] - zz[j + 1][0]) + mu1[0] * (zz[j + 2][0] - zz[j + 1][0]);
                          kv[j] = zz[j + 1][1] + mu0[1] * (zz[j][1] - zz[j + 1][1]) + mu1[1] * (zz[j + 2][1] - zz[j + 1][1]);
                          vv[j] = zz[j + 1][2] + mu0[2] * (zz[j][2] - zz[j + 1][2]) + mu1[2] * (zz[j + 2][2] - zz[j + 1][2]);
                          const float w1v = zz[j + 1][3] + mu0[3] * (zz[j][3] - zz[j + 1][3]) + mu1[3] * (zz[j + 2][3] - zz[j + 1][3]);
                          const float a1v = zz[j + 1][4] + mu0[4] * (zz[j][4] - zz[j + 1][4]) + mu1[4] * (zz[j + 2][4] - zz[j + 1][4]);
                          TAp[j * 64 + col] = f2b(2.0f * sigm(2.0f * w1v) - 1.0f); TAp[1024 + j * 64 + col] = f2b(a1v); } }
                    LDS_WAIT(); asm volatile("" ::: "memory");
                    float lw[2][4];
#pragma unroll
                    for (int mm = 0; mm < 2; ++mm) { const bf16x8 Af0 = *(const LAS bf16x8*)(TAp + mm * 1024 + (c & 3) * 64 + g * 8), Af1 = *(const LAS bf16x8*)(TAp + mm * 1024 + (c & 3) * 64 + 32 + g * 8);
                        f32x4 acc[4];
#pragma unroll
                        for (int ct = 0; ct < 4; ++ct) { acc[ct] = __builtin_amdgcn_mfma_f32_16x16x32_bf16(Af0, Bf[mm][ct][0], (f32x4){0.f, 0.f, 0.f, 0.f}, 0, 0, 0); acc[ct] = __builtin_amdgcn_mfma_f32_16x16x32_bf16(Af1, Bf[mm][ct][1], acc[ct], 0, 0, 0); }
#pragma unroll
                        for (int rg = 0; rg < 4; ++rg) { const float t01 = (g & 1) ? acc[1][rg] : acc[0][rg], t23 = (g & 1) ? acc[3][rg] : acc[2][rg]; lw[mm][rg] = (g & 2) ? t23 : t01; } }
                    float dec[4], av[4], kkr[4], kd[4], x2[4], x3[4];
#pragma unroll
                    for (int j = 0; j < 4; ++j) { dec[j] = __expf(-0.60653066f * sigm(lw[0][j] + w0c)); av[j] = sigm(lw[1][j] + a0c); kkr[j] = kv[j] * kkc; kd[j] = kv[j] * (1.f + (av[j] - 1.f) * kac);
                        x2[j] = kkr[j] * kkr[j]; x3[j] = rv[j] * kd[j] * rkc; }
                    const f32x4 zz4 = (f32x4){0.f, 0.f, 0.f, 0.f};
                    f32x4 D1 = mfma16(pk4(x2[0], x2[1], x2[2], x2[3]), SEL1, zz4); D1 = mfma16(pk4(x3[0], x3[1], x3[2], x3[3]), SEL2, D1);
                    const f32x4 D2 = mfma16(ONES4, pk4v(D1), zz4);
                    float cf[4];
                    { const float p01 = dec[0] * dec[1], p012 = p01 * dec[2], p0123 = p012 * dec[3], s32 = dec[3] * dec[2], s321 = s32 * dec[1];
                      cf[0] = d ? p0123 : dec[0]; cf[1] = d ? s321 : p01; cf[2] = d ? s32 : p012; cf[3] = d ? dec[3] : p0123; }
                    LAS float* OPb = (LAS float*)(OP0 + (s2 & 1) * OP_SZ);
#pragma unroll
                    for (int j = 0; j < 4; ++j) { const float n2 = rdl(D2[0], j); const float kk = kkr[j] * __builtin_amdgcn_rsqf(fmaxf(n2, 1e-24f)); const float bb = kk * av[j];
                        LAS float* op = OPb + (4 * p + (d ? 3 - j : j)) * 384 + col; op[0] = cf[j]; op[64] = kk; op[128] = bb; op[192] = kd[j]; op[256] = rv[j]; op[320] = vv[j]; }
                    if (lane >= 4 && lane < 8) BON[((size_t)d * M + seq_base + tlo + (lane - 4)) * 16 + h] = D2[0];
                }
            } else {
                const int s1 = n + 1;
                if (s1 >= 0 && s1 < NSUB) {
                    const LAS float* OPb = (const LAS float*)(OP0 + (s1 & 1) * OP_SZ); LAS unsigned char* IM = IMG0 + (s1 & 1) * IMG_SZ;
                    LAS bf16_t* KT = (LAS bf16_t*)IM; LAS bf16_t* RT = (LAS bf16_t*)(IM + 2304); LAS bf16_t* BP = (LAS bf16_t*)(IM + 4608); LAS bf16_t* KP = (LAS bf16_t*)(IM + 6912);
                    LAS bf16_t* BHT = (LAS bf16_t*)(IM + 9216); LAS bf16_t* KHT = (LAS bf16_t*)(IM + 12288); LAS bf16_t* VT = (LAS bf16_t*)(IM + 15360); LAS float* GC = (LAS float*)(IM + 18432);
                    const int k = lane, i0 = 4 * wid;
                    const float t0 = OPb[3 * 384 + k], t1 = OPb[7 * 384 + k], t2 = OPb[11 * 384 + k], t3 = OPb[15 * 384 + k];
                    const float c2 = t0 * t1, c3 = c2 * t2, gC = c3 * t3; const float pre0 = (wid == 0) ? 1.f : (wid == 1 ? t0 : (wid == 2 ? c2 : c3));
                    float gpv[4], gvv[4];
#pragma unroll
                    for (int q = 0; q < 4; ++q) { gvv[q] = pre0 * OPb[(i0 + q) * 384 + k]; gpv[q] = q ? gvv[q - 1] : pre0; }
                    float bh[4], kh[4], vq[4];
#pragma unroll
                    for (int q = 0; q < 4; ++q) { const int i = i0 + q; const float inv = __builtin_amdgcn_rcpf(gvv[q]), gcg = gC * inv; const LAS float* op = OPb + i * 384 + k;
                        const float kkv = op[64], bv = op[128], kdv = op[192], rv = op[256], vv = op[320];
                        KT[i * 72 + k] = f2b(kkv * gpv[q]); RT[i * 72 + k] = f2b(rv * gvv[q]); BP[i * 72 + k] = f2b(bv * inv); KP[i * 72 + k] = f2b(kdv * inv);
                        bh[q] = bv * gcg; kh[q] = kdv * gcg; vq[q] = vv; }
                    *(LAS bf16x4*)(BHT + k * 24 + i0) = pk4(bh[0], bh[1], bh[2], bh[3]); *(LAS bf16x4*)(KHT + k * 24 + i0) = pk4(kh[0], kh[1], kh[2], kh[3]); *(LAS bf16x4*)(VT + k * 24 + i0) = pk4(vq[0], vq[1], vq[2], vq[3]);
                    if (wid == 0) GC[k] = gC;
                }
                if (n >= 0) {
                const int t = wid; const LAS unsigned char* IM = IMG0 + (n & 1) * IMG_SZ;
                const LAS bf16_t* KT = (const LAS bf16_t*)IM; const LAS bf16_t* RT = (const LAS bf16_t*)(IM + 2304); const LAS bf16_t* BP = (const LAS bf16_t*)(IM + 4608); const LAS bf16_t* KP = (const LAS bf16_t*)(IM + 6912);
                const LAS bf16_t* BHT = (const LAS bf16_t*)(IM + 9216); const LAS bf16_t* KHT = (const LAS bf16_t*)(IM + 12288); const LAS bf16_t* VT = (const LAS bf16_t*)(IM + 15360); const LAS float* GC = (const LAS float*)(IM + 18432);
                bf16x4 fKT[4], fRT[4];
                const f32x4 z4 = (f32x4){0.f, 0.f, 0.f, 0.f};
                f32x4 abT = z4, ab = z4, akdT = z4, nbT = z4, nkdT = z4;
#pragma unroll
                for (int ks = 0; ks < 4; ++ks) { fKT[ks] = *(const LAS bf16x4*)(KT + c * 72 + ks * 16 + g * 4); fRT[ks] = *(const LAS bf16x4*)(RT + c * 72 + ks * 16 + g * 4);
                    const bf16x4 fBP = *(const LAS bf16x4*)(BP + c * 72 + ks * 16 + g * 4), fKP = *(const LAS bf16x4*)(KP + c * 72 + ks * 16 + g * 4);
                    abT = mfma16(fBP, fKT[ks], abT); ab = mfma16(fKT[ks], fBP, ab); akdT = mfma16(fKP, fKT[ks], akdT); nbT = mfma16(fBP, fRT[ks], nbT); nkdT = mfma16(fKP, fRT[ks], nkdT); }
                f32x4 R;
#pragma unroll
                for (int rg = 0; rg < 4; ++rg) { const int j = 4 * g + rg; akdT[rg] = (j < c) ? akdT[rg] : 0.f; nbT[rg] = (j <= c) ? nbT[rg] : 0.f; nkdT[rg] = (j <= c) ? nkdT[rg] : 0.f;
                    abT[rg] = (j < c) ? abT[rg] : 0.f; ab[rg] = (c < j) ? ab[rg] : 0.f; R[rg] = ((j == c) ? 1.f : 0.f) - abT[rg]; }
                const bf16x4 aAkd = pk4v(akdT), aNb = pk4v(nbT), aNkd = pk4v(nkdT);
                const bf16x4 pP1 = pk4v(ab), pQ1 = pk4v(abT);
                const f32x4 P2 = mfma16(pQ1, pP1, z4), Q2 = mfma16(pP1, pQ1, z4);
                const bf16x4 pP2 = pk4v(P2), pQ2 = pk4v(Q2);
                const f32x4 P4 = mfma16(pQ2, pP2, z4), Q4 = mfma16(pP2, pQ2, z4);
                R = mfma16(pP2, pk4v(R), R);
                const bf16x4 pP4 = pk4v(P4), pQ4 = pk4v(Q4);
                const f32x4 P8 = mfma16(pQ4, pP4, z4);
                R = mfma16(pP4, pk4v(R), R);
                R = mfma16(pk4v(P8), pk4v(R), R);
                const bf16x4 aT = pk4v(R);
                bf16x4 bS[4];
#pragma unroll
                for (int kt = 0; kt < 4; ++kt) bS[kt] = pk4v(ST[kt]);
                const bf16x4 fV = *(const LAS bf16x4*)(VT + (16 * t + c) * 24 + g * 4);
                f32x4 X = (f32x4){0.f, 0.f, 0.f, 0.f};
#pragma unroll
                for (int kt = 0; kt < 4; ++kt) X = mfma16(fKT[kt], bS[kt], X);
                X = mfma16(aAkd, fV, X);
                f32x4 U = mfma16(aT, pk4v(X), (f32x4){0.f, 0.f, 0.f, 0.f});
                const bf16x4 bU = pk4(-U[0], -U[1], -U[2], -U[3]);
                f32x4 y = (f32x4){0.f, 0.f, 0.f, 0.f};
#pragma unroll
                for (int kt = 0; kt < 4; ++kt) y = mfma16(fRT[kt], bS[kt], y);
                y = mfma16(aNb, bU, y); y = mfma16(aNkd, fV, y);
                { const int seg = n >= 16, len = seg ? SEQ : CTXL, seq_base = seg ? b * SEQ : M_LAT + b * CTXL, p0 = 16 * (seg ? n - 16 : n);
#pragma unroll
                  for (int rg = 0; rg < 4; ++rg) { const int pos = p0 + 4 * g + rg, tkn = d ? len - 1 - pos : pos; Yd[(size_t)(seq_base + tkn) * 1024 + h * 64 + 16 * t + c] = f2b(y[rg]); } }
#pragma unroll
                for (int kt = 0; kt < 4; ++kt) { const f32x4 gc4 = *(const LAS f32x4*)(GC + 16 * kt + 4 * g);
                    const bf16x4 fBH = *(const LAS bf16x4*)(BHT + (16 * kt + c) * 24 + g * 4), fKH = *(const LAS bf16x4*)(KHT + (16 * kt + c) * 24 + g * 4);
                    f32x4 s = ST[kt] * gc4; s = mfma16(fBH, bU, s); s = mfma16(fKH, fV, s); ST[kt] = s; }
                }
            }
            __syncthreads();
        }
    }
}

__device__ __forceinline__ void post_phase(const KA a_in, int l) {
    const KA a = opaque_ka(a_in); const int tid = opaque_tid(); const int lane = tid & 63, gw = opaque_bid() * 8 + (tid >> 6), NGW = gridDim.x * 8;
    const bf16_t* ZR = (const bf16_t*)(a.ws() + WS_Z); bf16_t* YF = (bf16_t*)(a.ws() + WS_YF); const bf16_t* YB = (const bf16_t*)(a.ws() + WS_YB);
    const float* BON = (const float*)(a.ws() + WS_BON); bf16_t* SG = (bf16_t*)(a.ws() + WS_PT);
    const float* smu = a.in(I_SMU) + (size_t)l * 2 * P_RWKV;
    const int c0 = lane * 16;
    float m0v[16], m1v[16], lg[16], lb[16];
#pragma unroll
    for (int j = 0; j < 16; ++j) { m0v[j] = smu[C_V + c0 + j]; m1v[j] = smu[P_RWKV + C_V + c0 + j]; lg[j] = a.in(I_LNXG)[l * 1024 + c0 + j]; lb[j] = a.in(I_LNXB)[l * 1024 + c0 + j]; }
    float gm0[4], gm1[4];
#pragma unroll
    for (int j = 0; j < 4; ++j) { const int cg = C_G1 + (lane < 40 ? lane * 4 + j : 0); gm0[j] = smu[cg]; gm1[j] = smu[P_RWKV + cg]; }
    for (int row = gw; row < ((l == 1) ? M_LAT : M); row += NGW) {
        const bool lat = row < M_LAT; const int t = lat ? (row & (SEQ - 1)) : ((row - M_LAT) & (CTXL - 1)); const int len = lat ? SEQ : CTXL;
        const bool hp = t > 0, hn = t < len - 1;
        const u32x4 z4 = (u32x4){0u, 0u, 0u, 0u};
        const u32x4* yfp = (const u32x4*)(YF + (size_t)row * 1024 + c0); const u32x4* ybp = (const u32x4*)(YB + (size_t)row * 1024 + c0);
        const u32x4 yf0 = yfp[0], yf1 = yfp[1], yb0 = ybp[0], yb1 = ybp[1];
        const u32x4* vc = (const u32x4*)(ZR + (size_t)row * NZR + C_V + c0);
        const u32x4 vc0 = vc[0], vc1 = vc[1];
        const int rp = hp ? row - 1 : row, rn = hn ? row + 1 : row;
        const u32x4 vp0r = *(const u32x4*)(ZR + (size_t)rp * NZR + C_V + c0), vp1r = *(const u32x4*)(ZR + (size_t)rp * NZR + C_V + c0 + 8);
        const u32x4 vn0r = *(const u32x4*)(ZR + (size_t)rn * NZR + C_V + c0), vn1r = *(const u32x4*)(ZR + (size_t)rn * NZR + C_V + c0 + 8);
        const int hd = lane >> 2;
        const float bon0 = BON[(size_t)row * 16 + hd], bon1 = BON[((size_t)M + row) * 16 + hd];
        const int gl = (lane < 40) ? lane * 4 : 0;
        const u32x2 gcr = *(const u32x2*)(ZR + (size_t)row * NZR + C_G1 + gl), gpr = *(const u32x2*)(ZR + (size_t)rp * NZR + C_G1 + gl), gnr = *(const u32x2*)(ZR + (size_t)rn * NZR + C_G1 + gl);
        __builtin_amdgcn_sched_barrier(0);
        const u32x4 vp0 = hp ? vp0r : z4, vp1 = hp ? vp1r : z4, vn0 = hn ? vn0r : z4, vn1 = hn ? vn1r : z4;
        const float bon = bon0 + bon1;
        float o[16], vz[16], vpz[16], vnz[16];
        { f32x4 p0, p1, q0, q1; unpack8(yf0, p0, p1); unpack8(yb0, q0, q1);
#pragma unroll
          for (int j = 0; j < 4; ++j) { o[j] = p0[j] + q0[j]; o[4 + j] = p1[j] + q1[j]; }
          unpack8(yf1, p0, p1); unpack8(yb1, q0, q1);
#pragma unroll
          for (int j = 0; j < 4; ++j) { o[8 + j] = p0[j] + q0[j]; o[12 + j] = p1[j] + q1[j]; }
          unpack8(vc0, p0, p1); unpack8(vc1, q0, q1);
#pragma unroll
          for (int j = 0; j < 4; ++j) { vz[j] = p0[j]; vz[4 + j] = p1[j]; vz[8 + j] = q0[j]; vz[12 + j] = q1[j]; }
          unpack8(vp0, p0, p1); unpack8(vp1, q0, q1);
#pragma unroll
          for (int j = 0; j < 4; ++j) { vpz[j] = p0[j]; vpz[4 + j] = p1[j]; vpz[8 + j] = q0[j]; vpz[12 + j] = q1[j]; }
          unpack8(vn0, p0, p1); unpack8(vn1, q0, q1);
#pragma unroll
          for (int j = 0; j < 4; ++j) { vnz[j] = p0[j]; vnz[4 + j] = p1[j]; vnz[8 + j] = q0[j]; vnz[12 + j] = q1[j]; } }
        float s = 0.f;
#pragma unroll
        for (int j = 0; j < 16; ++j) s += o[j];
        s += dpp_f<0xB1>(s); s += dpp_f<0x4E>(s);
        const float mean = s * (1.f / 64.f); float q = 0.f;
#pragma unroll
        for (int j = 0; j < 16; ++j) { const float dd = o[j] - mean; q += dd * dd; }
        q += dpp_f<0xB1>(q); q += dpp_f<0x4E>(q);
        const float rstd = rsqrtf(q * (1.f / 64.f) + 64e-5f);
        float r[16];
#pragma unroll
        for (int j = 0; j < 16; ++j) { const float vv = vz[j] + m0v[j] * (vpz[j] - vz[j]) + m1v[j] * (vnz[j] - vz[j]); r[j] = (o[j] - mean) * rstd * lg[j] + lb[j] + bon * vv; }
        u32x4 w0, w1; w0.x = pk_bf16(r[0], r[1]); w0.y = pk_bf16(r[2], r[3]); w0.z = pk_bf16(r[4], r[5]); w0.w = pk_bf16(r[6], r[7]);
        w1.x = pk_bf16(r[8], r[9]); w1.y = pk_bf16(r[10], r[11]); w1.z = pk_bf16(r[12], r[13]); w1.w = pk_bf16(r[14], r[15]);
        u32x4* op = (u32x4*)(YF + (size_t)row * 1024 + c0);
#if PROBE_HI == 6
        (void)op;
#else
        op[0] = w0; op[1] = w1;
#endif
#if PROBE_HI > 0
        if (row < 32768) { u32x4* o2 = (u32x4*)((bf16_t*)(a.ws() + WS_Z + 396 * MiB) + (size_t)row * 1024 + c0); o2[0] = w0; o2[1] = w1; }
#endif
        u32x2 sg = (u32x2){0u, 0u};
        if (lane < 40) { const u32x2 gc = gcr;
            const u32x2 gp = hp ? gpr : (u32x2){0u, 0u};
            const u32x2 gn = hn ? gnr : (u32x2){0u, 0u};
            const float zc[4] = {bf_lo(gc.x), bf_hi(gc.x), bf_lo(gc.y), bf_hi(gc.y)}, zp[4] = {bf_lo(gp.x), bf_hi(gp.x), bf_lo(gp.y), bf_hi(gp.y)}, zn[4] = {bf_lo(gn.x), bf_hi(gn.x), bf_lo(gn.y), bf_hi(gn.y)};
            float sv[4];
#pragma unroll
            for (int j = 0; j < 4; ++j) sv[j] = sigm(zc[j] + gm0[j] * (zp[j] - zc[j]) + gm1[j] * (zn[j] - zc[j]));
            sg.x = pk_bf16(sv[0], sv[1]); sg.y = pk_bf16(sv[2], sv[3]); }
        *(u32x2*)(SG + (size_t)row * 256 + lane * 4) = sg;
    }
}

__device__ __forceinline__ void conv_phase(const KA a_in, LAS unsigned char* lds, int l) {
    const KA a = opaque_ka(a_in); const int tid = opaque_tid(), bid = opaque_bid(); const int lane = tid & 63, wid = __builtin_amdgcn_readfirstlane(tid >> 6), c = lane & 15;
    const bf16_t* U = (const bf16_t*)(a.ws() + WS_Z); bf16_t* A2 = (bf16_t*)(a.ws() + WS_YB);
    LAS float* ST = (LAS float*)lds;
    const int ch = 128 * wid + 2 * lane;
    f32x2 w2[31];
    { const float* cw = a.in(I_CONVW) + (size_t)l * 31 * 1024 + ch;
#pragma unroll
      for (int k = 0; k < 31; ++k) w2[k] = *(const f32x2*)(cw + k * 1024); }
    const f32x2 cg = *(const f32x2*)(a.in(I_CNG) + l * 1024 + ch), cb = *(const f32x2*)(a.in(I_CNB) + l * 1024 + ch);
    bf16x4 SEL[4], ONES4;
#pragma unroll
    for (int k = 0; k < 4; ++k) { u32x2 w; w.x = (c == 4 * k ? 0x3F80u : 0u) | (c == 4 * k + 1 ? 0x3F800000u : 0u); w.y = (c == 4 * k + 2 ? 0x3F80u : 0u) | (c == 4 * k + 3 ? 0x3F800000u : 0u); SEL[k] = __builtin_bit_cast(bf16x4, w); }
    { u32x2 w; w.x = 0x3F803F80u; w.y = 0x3F803F80u; ONES4 = __builtin_bit_cast(bf16x4, w); }
    const f32x4 z4 = (f32x4){0.f, 0.f, 0.f, 0.f};
    __syncthreads();
    int par = 0;
    for (int tile = bid; tile < ((l == 1) ? 4096 : 4224); tile += gridDim.x, par ^= 1) {
        int base, stride, len, p0;
        if (tile < 4096) { const int b = tile >> 9, j = (tile >> 3) & 63, ib = tile & 7; base = b * SEQ + j; stride = 64; len = 128; p0 = ib * 16; }
        else { const int t2 = tile - 4096, b = t2 >> 4, tb = t2 & 15; base = M_LAT + b * CTXL; stride = 1; len = CTXL; p0 = tb * 16; }
        unsigned win[46];
#pragma unroll
        for (int r = 0; r < 46; ++r) { const int pp = p0 - 15 + r; win[r] = (pp >= 0 && pp < len) ? *(const unsigned*)(U + (size_t)(base + pp * stride) * 1024 + ch) : 0u; }
        f32x2 acc[16];
#pragma unroll
        for (int j = 0; j < 16; ++j) acc[j] = (f32x2){0.f, 0.f};
#pragma unroll
        for (int r = 0; r < 46; ++r) { const f32x2 x2 = (f32x2){bf_lo(win[r]), bf_hi(win[r])};
#pragma unroll
            for (int j = 0; j < 16; ++j) { const int k = r - j; if (k >= 0 && k < 31) acc[j] += x2 * w2[k]; } }
        float sv[16], qv[16];
#pragma unroll
        for (int j = 0; j < 16; ++j) { sv[j] = acc[j][0] + acc[j][1]; qv[j] = acc[j][0] * acc[j][0] + acc[j][1] * acc[j][1]; }
        f32x4 D1s = z4, D1q = z4;
#pragma unroll
        for (int k = 0; k < 4; ++k) { D1s = mfma16(pk4(sv[4 * k], sv[4 * k + 1], sv[4 * k + 2], sv[4 * k + 3]), SEL[k], D1s); D1q = mfma16(pk4(qv[4 * k], qv[4 * k + 1], qv[4 * k + 2], qv[4 * k + 3]), SEL[k], D1q); }
        const f32x4 D2s = mfma16(ONES4, pk4v(D1s), z4), D2q = mfma16(ONES4, pk4v(D1q), z4);
        LAS float* slot = ST + par * 256;
        if (lane < 16) { slot[wid * 32 + lane] = D2s[0]; slot[wid * 32 + 16 + lane] = D2q[0]; }
        __syncthreads();
        float S = 0.f, Q = 0.f;
#pragma unroll
        for (int w = 0; w < 8; ++w) { S += slot[w * 32 + c]; Q += slot[w * 32 + 16 + c]; }
        const float mean = S * (1.f / 1024.f); const float rstd = rsqrtf(fmaxf(Q * (1.f / 1024.f) - mean * mean, 0.f) + 1e-5f);
#pragma unroll
        for (int j = 0; j < 16; ++j) { const float m = rdl(mean, j), rs = rdl(rstd, j);
            const float y0 = (acc[j][0] - m) * rs * cg[0] + cb[0], y1 = (acc[j][1] - m) * rs * cg[1] + cb[1];
            *(unsigned*)(A2 + (size_t)(base + (p0 + j) * stride) * 1024 + ch) = pk_bf16(y0 * sigm(y0), y1 * sigm(y1)); }
    }
    __syncthreads();
}

__device__ __forceinline__ void ce(float& ka, unsigned& pa, float& kb, unsigned& pb) {
    const bool sw = kb > ka; const float k0 = sw ? kb : ka, k1 = sw ? ka : kb; const unsigned p0 = sw ? pb : pa, p1 = sw ? pa : pb; ka = k0; kb = k1; pa = p0; pb = p1;
}
template <int N> __device__ __forceinline__ void bitonic_sort_desc(float (&k)[N], unsigned (&p)[N]) {
#pragma unroll
    for (int size = 2; size <= N; size <<= 1)
#pragma unroll
        for (int stride = size >> 1; stride > 0; stride >>= 1)
#pragma unroll
            for (int i = 0; i < N; ++i) { const int j = i ^ stride; if (j > i) { if ((i & size) == 0) ce(k[i], p[i], k[j], p[j]); else ce(k[j], p[j], k[i], p[i]); } }
}
#define CE16(a, b) ce(k[a], p[a], k[b], p[b]);
__device__ __forceinline__ void sort16_desc_kp(float (&k)[16], unsigned (&p)[16]) { CE16(0,1) CE16(2,3) CE16(0,2) CE16(1,3) CE16(1,2) CE16(4,5) CE16(6,7) CE16(4,6) CE16(5,7) CE16(5,6) CE16(0,4) CE16(2,6) CE16(2,4) CE16(1,5) CE16(3,7) CE16(3,5) CE16(1,2) CE16(3,4) CE16(5,6) CE16(8,9) CE16(10,11) CE16(8,10) CE16(9,11) CE16(9,10) CE16(12,13) CE16(14,15) CE16(12,14) CE16(13,15) CE16(13,14) CE16(8,12) CE16(10,14) CE16(10,12) CE16(9,13) CE16(11,15) CE16(11,13) CE16(9,10) CE16(11,12) CE16(13,14) CE16(0,8) CE16(4,12) CE16(4,8) CE16(2,10) CE16(6,14) CE16(6,10) CE16(2,4) CE16(6,8) CE16(10,12) CE16(1,9) CE16(5,13) CE16(5,9) CE16(3,11) CE16(7,15) CE16(7,11) CE16(3,5) CE16(7,9) CE16(11,13) CE16(1,2) CE16(3,4) CE16(5,6) CE16(7,8) CE16(9,10) CE16(11,12) CE16(13,14) }
#undef CE16
__device__ __forceinline__ void bitonic_merge16_desc(float (&k)[16], unsigned (&p)[16]) {
#pragma unroll
    for (int stride = 8; stride > 0; stride >>= 1)
#pragma unroll
        for (int i = 0; i < 16; ++i) { const int j = i ^ stride; if (j > i) ce(k[i], p[i], k[j], p[j]); }
}
__device__ __forceinline__ void merge_partner16(float (&k)[16], unsigned (&p)[16], int mask, int lane) {
    float ok[16]; unsigned opp[16];
#pragma unroll
    for (int i = 0; i < 16; ++i) { ok[i] = shxf(k[i], mask, lane); opp[i] = (unsigned)shxi((int)p[i], mask, lane); }
#pragma unroll
    for (int i = 0; i < 16; ++i) { const float o = ok[15 - i]; const unsigned q = opp[15 - i]; const bool t = o > k[i]; k[i] = t ? o : k[i]; p[i] = t ? q : p[i]; }
    bitonic_merge16_desc(k, p);
}
__device__ __forceinline__ int f2sort(float f) { const int b = __builtin_bit_cast(int, f); return b ^ ((b >> 31) & 0x7fffffff); }
__device__ __forceinline__ float sort2f(int s) { return __builtin_bit_cast(float, s ^ ((s >> 31) & 0x7fffffff)); }
__device__ __forceinline__ void cei(int& a, int& b) { const int mx = a > b ? a : b, mn = a > b ? b : a; a = mx; b = mn; }
template <int N> __device__ __forceinline__ void bitonic_sort_desc_i(int (&k)[N]) {
#pragma unroll
    for (int size = 2; size <= N; size <<= 1)
#pragma unroll
        for (int stride = size >> 1; stride > 0; stride >>= 1)
#pragma unroll
            for (int i = 0; i < N; ++i) { const int j = i ^ stride; if (j > i) { if ((i & size) == 0) cei(k[i], k[j]); else cei(k[j], k[i]); } }
}
#define CE16(a, b) cei(k[B + (a)], k[B + (b)]);
template <int B> __device__ __forceinline__ void sort16_desc_i(int (&k)[32]) { CE16(0,1) CE16(2,3) CE16(0,2) CE16(1,3) CE16(1,2) CE16(4,5) CE16(6,7) CE16(4,6) CE16(5,7) CE16(5,6) CE16(0,4) CE16(2,6) CE16(2,4) CE16(1,5) CE16(3,7) CE16(3,5) CE16(1,2) CE16(3,4) CE16(5,6) CE16(8,9) CE16(10,11) CE16(8,10) CE16(9,11) CE16(9,10) CE16(12,13) CE16(14,15) CE16(12,14) CE16(13,15) CE16(13,14) CE16(8,12) CE16(10,14) CE16(10,12) CE16(9,13) CE16(11,15) CE16(11,13) CE16(9,10) CE16(11,12) CE16(13,14) CE16(0,8) CE16(4,12) CE16(4,8) CE16(2,10) CE16(6,14) CE16(6,10) CE16(2,4) CE16(6,8) CE16(10,12) CE16(1,9) CE16(5,13) CE16(5,9) CE16(3,11) CE16(7,15) CE16(7,11) CE16(3,5) CE16(7,9) CE16(11,13) CE16(1,2) CE16(3,4) CE16(5,6) CE16(7,8) CE16(9,10) CE16(11,12) CE16(13,14) }
#undef CE16
__device__ __forceinline__ void merge_partner16_i(int (&k)[16], int mask, int lane) {
    int ok[16];
#pragma unroll
    for (int i = 0; i < 16; ++i) ok[i] = shxi(k[i], mask, lane);
#pragma unroll
    for (int i = 0; i < 16; ++i) k[i] = k[i] > ok[15 - i] ? k[i] : ok[15 - i];
#pragma unroll
    for (int stride = 8; stride > 0; stride >>= 1)
#pragma unroll
        for (int i = 0; i < 16; ++i) { const int j = i ^ stride; if (j > i) cei(k[i], k[j]); }
}
constexpr int SKP = 136;
__device__ __forceinline__ void topk_half(const bf16_t* Q, const LAS bf16_t* SK, int tok0, int lane, int (&tk)[16]) {
    bf16x8 qf[4];
#pragma unroll
    for (int ks = 0; ks < 4; ++ks) qf[ks] = *(const bf16x8*)(Q + (size_t)(tok0 + (lane & 15)) * 2048 + ks * 32 + (lane >> 4) * 8);
    int k[32];
#pragma unroll
    for (int tile = 0; tile < 8; ++tile) { f32x4 acc = (f32x4){0.f, 0.f, 0.f, 0.f};
#pragma unroll
        for (int ks = 0; ks < 4; ++ks) { const bf16x8 kf = *(const LAS bf16x8*)(SK + (tile * 16 + (lane & 15)) * SKP + ks * 32 + (lane >> 4) * 8); acc = __builtin_amdgcn_mfma_f32_16x16x32_bf16(kf, qf[ks], acc, 0, 0, 0); }
#pragma unroll
        for (int rg = 0; rg < 4; ++rg) k[tile * 4 + rg] = (f2sort(acc[rg]) & ~127) | (tile * 16 + (lane >> 4) * 4 + rg); }
    sort16_desc_i<0>(k); sort16_desc_i<16>(k);
#pragma unroll
    for (int i = 0; i < 16; ++i) tk[i] = k[i] > k[31 - i] ? k[i] : k[31 - i];
#pragma unroll
    for (int stride = 8; stride > 0; stride >>= 1)
#pragma unroll
        for (int i = 0; i < 16; ++i) { const int j = i ^ stride; if (j > i) cei(tk[i], tk[j]); }
    merge_partner16_i(tk, 16, lane); merge_partner16_i(tk, 32, lane);
}
#define SELQ(x0, x1, x2, x3) (qd == 0 ? (x0) : (qd == 1 ? (x1) : (qd == 2 ? (x2) : (x3))))
#define CAND(m, i0, j0, i1, j1, i2, j2, i3, j3) do { ck[m] = SELQ(k1[i0] + k2[j0], k1[i1] + k2[j1], k1[i2] + k2[j2], k1[i3] + k2[j3]); \
    cp[m] = SELQ((p1[i0] << 7) | p2[j0], (p1[i1] << 7) | p2[j1], (p1[i2] << 7) | p2[j2], (p1[i3] << 7) | p2[j3]); } while (0)
__device__ __forceinline__ void topk_phase(const KA a_in, LAS unsigned char* lds, int l) {
    const KA a = opaque_ka(a_in); const int tid = opaque_tid(), bid = opaque_bid(); const int lane = tid & 63, wid = tid >> 6;
    const bf16_t* Q = (const bf16_t*)(a.ws() + WS_Z); const bf16_t* SKB = (const bf16_t*)(a.ws() + WS_WB + (size_t)l * WB_LAYER + WB_SK);
    int* EIDX = (int*)(a.ws() + WS_YF); float* GW = (float*)(a.ws() + WS_YB);
    const int qd = lane >> 4; const float NINF = -__builtin_inff();
    LAS bf16_t* SKL = (LAS bf16_t*)lds;
    const int NG = (l == 1) ? 512 : 528, NIT = 8 * NG, per = (NIT + (int)gridDim.x - 1) / (int)gridDim.x, it0 = bid * per, it1 = (it0 + per < NIT) ? it0 + per : NIT;
    int hcur = -1;
    for (int it = it0; it < it1; ++it) {
        const int h = it / NG, g = it - h * NG;
        if (h != hcur) { __syncthreads();
            for (int i = tid; i < 2 * 128 * 16; i += 512) { const int r = i >> 4, c8 = i & 15; *(LAS u32x4*)(SKL + r * SKP + c8 * 8) = *(const u32x4*)(SKB + (size_t)h * 32768 + (size_t)r * 128 + c8 * 8); }
            __syncthreads(); hcur = h; }
        const int tok0 = g * 128 + wid * 16;
        int t1[16], t2[16];
        topk_half(Q + h * 256, SKL, tok0, lane, t1);
        __builtin_amdgcn_sched_barrier(0);
        topk_half(Q + h * 256 + 128, SKL + 128 * SKP, tok0, lane, t2);
        __builtin_amdgcn_sched_barrier(0);
        float k1[16], k2[16]; unsigned p1[16], p2[16];
#pragma unroll
        for (int i = 0; i < 16; ++i) { k1[i] = sort2f(t1[i] & ~127); p1[i] = (unsigned)(t1[i] & 127); k2[i] = sort2f(t2[i] & ~127); p2[i] = (unsigned)(t2[i] & 127); }
        float ck[16]; unsigned cp[16];
        CAND(0, 0, 0, 0, 1, 0, 2, 0, 3); CAND(1, 0, 4, 0, 5, 0, 6, 0, 7); CAND(2, 0, 8, 0, 9, 0, 10, 0, 11); CAND(3, 0, 12, 0, 13, 0, 14, 0, 15);
        CAND(4, 1, 0, 1, 1, 1, 2, 1, 3); CAND(5, 1, 4, 1, 5, 1, 6, 1, 7); CAND(6, 2, 0, 2, 1, 2, 2, 2, 3); CAND(7, 2, 4, 3, 0, 3, 1, 3, 2);
        CAND(8, 3, 3, 4, 0, 4, 1, 4, 2); CAND(9, 5, 0, 5, 1, 6, 0, 6, 1); CAND(10, 7, 0, 7, 1, 8, 0, 9, 0); CAND(11, 10, 0, 11, 0, 12, 0, 13, 0);
        CAND(12, 14, 0, 15, 0, 15, 0, 15, 0); if (qd >= 2) ck[12] = NINF;
        ck[13] = NINF; ck[14] = NINF; ck[15] = NINF; cp[13] = 0u; cp[14] = 0u; cp[15] = 0u;
        sort16_desc_kp(ck, cp);
        merge_partner16(ck, cp, 16, lane); merge_partner16(ck, cp, 32, lane);
        float e[16], sum = 0.f;
#pragma unroll
        for (int i = 0; i < 16; ++i) { e[i] = __expf(ck[i] - ck[0]); sum += e[i]; }
        const float inv = 1.0f / sum;
        if (qd == 0) { const size_t o = (size_t)(tok0 + (lane & 15)) * 128 + h * 16;
            if (PEER_SLICED) { unsigned short* e16 = (unsigned short*)(a.ws() + WS_E16) + o;
                *(u32x4*)e16 = (u32x4){cp[0] | (cp[1] << 16), cp[2] | (cp[3] << 16), cp[4] | (cp[5] << 16), cp[6] | (cp[7] << 16)}; *(u32x4*)(e16 + 8) = (u32x4){cp[8] | (cp[9] << 16), cp[10] | (cp[11] << 16), cp[12] | (cp[13] << 16), cp[14] | (cp[15] << 16)}; }
#pragma unroll
            for (int i = 0; i < 4; ++i) { *(u32x4*)(EIDX + o + 4 * i) = (u32x4){cp[4 * i], cp[4 * i + 1], cp[4 * i + 2], cp[4 * i + 3]}; *(f32x4*)(GW + o + 4 * i) = (f32x4){e[4 * i] * inv, e[4 * i + 1] * inv, e[4 * i + 2] * inv, e[4 * i + 3] * inv}; } }
    }
}

__device__ __forceinline__ void peer_phase(const KA a_in, int l, float* xlat, float* xctx) {
    const KA a = opaque_ka(a_in); const int tid = opaque_tid(); const int lane = tid & 63, gw = opaque_bid() * 8 + (tid >> 6), NGW = gridDim.x * 8;
    const bf16_t* H = (const bf16_t*)(a.ws() + WS_H); const unsigned char* PU = a.ws() + WS_PT; const unsigned char* PV = a.ws() + WS_PT + 16 * MiB;
    const int* EIDX = (const int*)(a.ws() + WS_YF); const float* GW = (const float*)(a.ws() + WS_YB);
    const float* modl = (const float*)(a.ws() + WS_MOD) + (size_t)l * 9 * 6144;
    for (int row = gw; row < M; row += NGW) {
        const bool lat = row < M_LAT; const int bi = lat ? (row >> 13) : 8;
        float hf[16];
        { const u32x4* hp = (const u32x4*)(H + (size_t)row * 1024 + lane * 16); const u32x4 hA = hp[0], hB = hp[1]; f32x4 t0, t1, t2, t3; unpack8(hA, t0, t1); unpack8(hB, t2, t3);
#pragma unroll
          for (int j = 0; j < 4; ++j) { hf[j] = t0[j]; hf[4 + j] = t1[j]; hf[8 + j] = t2[j]; hf[12 + j] = t3[j]; } }
        const int ev[2] = {EIDX[(size_t)row * 128 + lane], EIDX[(size_t)row * 128 + 64 + lane]};
        const float gv[2] = {GW[(size_t)row * 128 + lane], GW[(size_t)row * 128 + 64 + lane]};
        float dv[2] = {0.f, 0.f};
#pragma unroll
        for (int half = 0; half < 2; ++half) {
#pragma unroll 1
            for (int kk0 = 0; kk0 < 64; kk0 += 16) { u32x4 ur[16];
#pragma unroll
                for (int j = 0; j < 16; ++j) { const int e = __builtin_amdgcn_readlane(ev[half], kk0 + j); ur[j] = *(const u32x4*)(PU + (size_t)e * 1024 + lane * 16); }
#pragma unroll
                for (int j = 0; j < 16; ++j) { const int w0 = (int)ur[j][0], w1 = (int)ur[j][1], w2 = (int)ur[j][2], w3 = (int)ur[j][3];
                    const f32x2v p0 = __builtin_amdgcn_cvt_pk_f32_fp8(w0, false), p1 = __builtin_amdgcn_cvt_pk_f32_fp8(w0, true), p2 = __builtin_amdgcn_cvt_pk_f32_fp8(w1, false), p3 = __builtin_amdgcn_cvt_pk_f32_fp8(w1, true);
                    const f32x2v p4 = __builtin_amdgcn_cvt_pk_f32_fp8(w2, false), p5 = __builtin_amdgcn_cvt_pk_f32_fp8(w2, true), p6 = __builtin_amdgcn_cvt_pk_f32_fp8(w3, false), p7 = __builtin_amdgcn_cvt_pk_f32_fp8(w3, true);
                    float s = (p0.x * hf[0] + p0.y * hf[1]) + (p1.x * hf[2] + p1.y * hf[3]); s += (p2.x * hf[4] + p2.y * hf[5]) + (p3.x * hf[6] + p3.y * hf[7]);
                    s += (p4.x * hf[8] + p4.y * hf[9]) + (p5.x * hf[10] + p5.y * hf[11]); s += (p6.x * hf[12] + p6.y * hf[13]) + (p7.x * hf[14] + p7.y * hf[15]);
                    s = wave_sum(s, lane); dv[half] = (lane == kk0 + j) ? s : dv[half]; } }
        }
        float act[2];
#pragma unroll
        for (int half = 0; half < 2; ++half) act[half] = gelu_erf(dv[half] * (1.0f / PU_SCALE)) * gv[half];
        float acc[16];
#pragma unroll
        for (int j = 0; j < 16; ++j) acc[j] = 0.f;
#pragma unroll
        for (int half = 0; half < 2; ++half) {
#pragma unroll 1
            for (int kk0 = 0; kk0 < 64; kk0 += 16) { u32x4 vr[16];
#pragma unroll
                for (int j = 0; j < 16; ++j) { const int e = __builtin_amdgcn_readlane(ev[half], kk0 + j); vr[j] = *(const u32x4*)(PV + (size_t)e * 1024 + lane * 16); }
#pragma unroll
                for (int j = 0; j < 16; ++j) { const float aw = __builtin_bit_cast(float, __builtin_amdgcn_readlane(__builtin_bit_cast(int, act[half]), kk0 + j));
                    const int w0 = (int)vr[j][0], w1 = (int)vr[j][1], w2 = (int)vr[j][2], w3 = (int)vr[j][3];
                    const f32x2v p0 = __builtin_amdgcn_cvt_pk_f32_fp8(w0, false), p1 = __builtin_amdgcn_cvt_pk_f32_fp8(w0, true), p2 = __builtin_amdgcn_cvt_pk_f32_fp8(w1, false), p3 = __builtin_amdgcn_cvt_pk_f32_fp8(w1, true);
                    const f32x2v p4 = __builtin_amdgcn_cvt_pk_f32_fp8(w2, false), p5 = __builtin_amdgcn_cvt_pk_f32_fp8(w2, true), p6 = __builtin_amdgcn_cvt_pk_f32_fp8(w3, false), p7 = __builtin_amdgcn_cvt_pk_f32_fp8(w3, true);
                    acc[0] += aw * p0.x; acc[1] += aw * p0.y; acc[2] += aw * p1.x; acc[3] += aw * p1.y; acc[4] += aw * p2.x; acc[5] += aw * p2.y; acc[6] += aw * p3.x; acc[7] += aw * p3.y;
                    acc[8] += aw * p4.x; acc[9] += aw * p4.y; acc[10] += aw * p5.x; acc[11] += aw * p5.y; acc[12] += aw * p6.x; acc[13] += aw * p6.y; acc[14] += aw * p7.x; acc[15] += aw * p7.y; } }
        }
        float* xr = (lat ? xlat + (size_t)row * 1024 : xctx + (size_t)(row - M_LAT) * 1024) + lane * 16;
        const float* gt = modl + bi * 6144 + 5 * 1024 + lane * 16;
        f32x4 xv[4]; float ss = 0.f;
#pragma unroll
        for (int q = 0; q < 4; ++q) { const f32x4 g4 = ((const f32x4*)gt)[q]; f32x4 x4 = ((f32x4*)xr)[q];
            x4 += g4 * ((f32x4){acc[4 * q], acc[4 * q + 1], acc[4 * q + 2], acc[4 * q + 3]} * (1.0f / PV_SCALE)); xv[q] = x4; ss += (x4[0] * x4[0] + x4[1] * x4[1]) + (x4[2] * x4[2] + x4[3] * x4[3]); }
        const float rs = rsqrtf(wave_sum(ss, lane) * (1.f / 1024.f) + 1e-6f);
        if (l == 0) {
#pragma unroll
            for (int q = 0; q < 4; ++q) ((f32x4*)xr)[q] = xv[q];
            const float* g1n = a.in(I_N1G) + 1024 + lane * 16; const float* m1 = (const float*)(a.ws() + WS_MOD) + (size_t)9 * 6144 + bi * 6144 + lane * 16;
            f32x4 y[4];
#pragma unroll
            for (int q = 0; q < 4; ++q) y[q] = xv[q] * rs * ((const f32x4*)g1n)[q] * (((const f32x4*)(m1 + 1024))[q] + 1.0f) + ((const f32x4*)m1)[q];
            u32x4* hb = (u32x4*)((bf16_t*)(a.ws() + WS_H) + (size_t)row * 1024 + lane * 16); hb[0] = pack8(y[0], y[1]); hb[1] = pack8(y[2], y[3]);
        } else if (lat) { const float* fg = a.in(I_FG) + lane * 16;
#pragma unroll
            for (int q = 0; q < 4; ++q) ((f32x4*)xr)[q] = xv[q] * rs * ((const f32x4*)fg)[q]; }
    }
}

__device__ __forceinline__ u32x6 load24(const unsigned char* p) { const u32x4 x = *(const u32x4_a8*)p; const u32x2 y = *(const u32x2*)(p + 16); return (u32x6){x.x, x.y, x.z, x.w, y.x, y.y}; }
__device__ __forceinline__ void peer_phase6(const KA a_in, int l, float* xlat, float* xctx) {
    const KA a = opaque_ka(a_in); const int tid = opaque_tid(); const int lane = tid & 63, gw = opaque_bid() * 8 + (tid >> 6), NGW = gridDim.x * 8;
    const int hb = lane >> 5, li = lane & 31, c = lane & 15;
    const bf16_t* H = (const bf16_t*)(a.ws() + WS_H); const unsigned char* PU = a.ws() + WS_PT; const unsigned char* PV = a.ws() + WS_PT + PT_V6; const f32x2v* SC = (const f32x2v*)(a.ws() + WS_PT + PT_SC);
    const int* EIDX = (const int*)(a.ws() + WS_YF); const float* GW = (const float*)(a.ws() + WS_YB);
    const float* modl = (const float*)(a.ws() + WS_MOD) + (size_t)l * 9 * 6144;
    bf16x4 SELA, SELB, ONES4;
    { u32x2 w; w.x = (c == hb ? 0x3F80u : 0u) | (c == 2 + hb ? 0x3F800000u : 0u); w.y = (c == 4 + hb ? 0x3F80u : 0u) | (c == 6 + hb ? 0x3F800000u : 0u); SELA = __builtin_bit_cast(bf16x4, w);
      w.x = (c == 8 + hb ? 0x3F80u : 0u) | (c == 10 + hb ? 0x3F800000u : 0u); w.y = (c == 12 + hb ? 0x3F80u : 0u) | (c == 14 + hb ? 0x3F800000u : 0u); SELB = __builtin_bit_cast(bf16x4, w);
      w.x = 0x3F803F80u; w.y = 0x3F803F80u; ONES4 = __builtin_bit_cast(bf16x4, w); }
    const f32x4 z4 = (f32x4){0.f, 0.f, 0.f, 0.f};
    for (int row = gw; row < ((l == 1) ? M_LAT : M); row += NGW) {
        const bool lat = row < M_LAT; const int bi = lat ? (row >> 13) : 8;
        unsigned hx[16];
        { const u32x4* hp = (const u32x4*)(H + (size_t)row * 1024 + li * 32);
#pragma unroll
          for (int q = 0; q < 4; ++q) { const u32x4 w = hp[q]; hx[4 * q] = w.x; hx[4 * q + 1] = w.y; hx[4 * q + 2] = w.z; hx[4 * q + 3] = w.w; } }
        f32x32 acc;
#pragma unroll
        for (int i = 0; i < 32; ++i) acc[i] = 0.f;
#pragma unroll 1
        for (int b = 0; b < 8; ++b) {
            const int ec = EIDX[(size_t)row * 128 + 16 * b + c]; const float gate = GW[(size_t)row * 128 + 16 * b + c];
            u32x6 ur[8], vr[8];
#pragma unroll
            for (int q = 0; q < 8; ++q) { const int em = __builtin_amdgcn_ds_bpermute((2 * q + hb) << 2, ec); const unsigned off = (unsigned)em * 768u + (unsigned)li * 24u; ur[q] = load24(PU + off); vr[q] = load24(PV + off); }
            const f32x2v sc = SC[ec];
            float part[8];
#pragma unroll
            for (int q = 0; q < 8; ++q) { const u32x16 u = __builtin_bit_cast(u32x16, __builtin_amdgcn_cvt_scalef32_pk32_bf16_fp6(ur[q], 1.0f)); float s0 = 0.f, s1 = 0.f, s2 = 0.f, s3 = 0.f;
#pragma unroll
                for (int j = 0; j < 16; j += 4) { s0 = dot2bf(u[j], hx[j], s0); s1 = dot2bf(u[j + 1], hx[j + 1], s1); s2 = dot2bf(u[j + 2], hx[j + 2], s2); s3 = dot2bf(u[j + 3], hx[j + 3], s3); }
                part[q] = (s0 + s1) + (s2 + s3); __builtin_amdgcn_sched_barrier(0); }
            f32x4 D1 = mfma16(pk4(part[0], part[1], part[2], part[3]), SELA, z4); D1 = mfma16(pk4(part[4], part[5], part[6], part[7]), SELB, D1);
            const f32x4 D2 = mfma16(ONES4, pk4v(D1), z4);
            const float act = gelu_erf(D2[0] * sc.x) * gate * sc.y;
#pragma unroll
            for (int q = 0; q < 8; ++q) { const float aw = __builtin_bit_cast(float, __builtin_amdgcn_ds_bpermute((2 * q + hb) << 2, __builtin_bit_cast(int, act)));
                u32x6 vq = vr[q]; asm volatile("" : "+v"(vq), "+v"(acc));
                const f32x32 v = __builtin_amdgcn_cvt_scalef32_pk32_f32_fp6(vq, 1.0f);
                acc += v * aw; }
        }
        float tot[16];
#pragma unroll
        for (int i = 0; i < 16; ++i) { float lo = acc[i], hi = acc[16 + i]; asm volatile("" : "+v"(lo), "+v"(hi));
            const float snd = hb ? lo : hi, mine = hb ? hi : lo; tot[i] = mine + shxf(snd, 32, lane); }
        const int cb = 32 * li + 16 * hb;
        float* xr = (lat ? xlat + (size_t)row * 1024 : xctx + (size_t)(row - M_LAT) * 1024) + cb;
        const float* gt = modl + bi * 6144 + 5 * 1024 + cb;
        f32x4 xv[4]; float ss = 0.f;
#pragma unroll
        for (int q = 0; q < 4; ++q) { const f32x4 g4 = ((const f32x4*)gt)[q]; f32x4 x4 = ((f32x4*)xr)[q];
            x4 += g4 * (f32x4){tot[4 * q], tot[4 * q + 1], tot[4 * q + 2], tot[4 * q + 3]}; xv[q] = x4; ss += (x4[0] * x4[0] + x4[1] * x4[1]) + (x4[2] * x4[2] + x4[3] * x4[3]); }
        const float rs = rsqrtf(wave_sum(ss, lane) * (1.f / 1024.f) + 1e-6f);
        if (l == 0) {
#pragma unroll
            for (int q = 0; q < 4; ++q) ((f32x4*)xr)[q] = xv[q];
            const float* g1n = a.in(I_N1G) + 1024 + cb; const float* m1 = (const float*)(a.ws() + WS_MOD) + (size_t)9 * 6144 + bi * 6144 + cb;
            f32x4 y[4];
#pragma unroll
            for (int q = 0; q < 4; ++q) y[q] = xv[q] * rs * ((const f32x4*)g1n)[q] * (((const f32x4*)(m1 + 1024))[q] + 1.0f) + ((const f32x4*)m1)[q];
            u32x4* hbp = (u32x4*)((bf16_t*)(a.ws() + WS_H) + (size_t)row * 1024 + cb); hbp[0] = pack8(y[0], y[1]); hbp[1] = pack8(y[2], y[3]);
        } else if (lat) { const float* fg = a.in(I_FG) + cb;
#pragma unroll
            for (int q = 0; q < 4; ++q) ((f32x4*)xr)[q] = xv[q] * rs * ((const f32x4*)fg)[q]; }
    }
}

__device__ __forceinline__ void peer_dots(const KA a_in, int l) {
    const KA a = opaque_ka(a_in); const int tid = opaque_tid(), bid = opaque_bid(); const int lane = tid & 63, wid = tid >> 6, grp = lane >> 2, seg = lane & 3;
    const int xs = bid & 7, nblk = ((int)gridDim.x - xs + 7) >> 3, NW = nblk * 8, w0 = (bid >> 3) * 8 + wid, MR = (l == 1) ? M_LAT : M;
    const unsigned char* PU = a.ws() + WS_PT + (size_t)xs * PT_SLICE + seg * 24; const bf16_t* H = (const bf16_t*)(a.ws() + WS_H) + 128 * xs + 32 * seg;
    const unsigned short* EIDX = (const unsigned short*)(a.ws() + WS_E16) + grp; bf16_t* P = (bf16_t*)(a.ws() + WS_PP) + (size_t)xs * M * 128 + 32 * seg + grp;
    auto meta = [&](int t, int (&ec)[8]) { const int tc = (t < MR) ? t : MR - 1;
#pragma unroll
        for (int gI = 0; gI < 8; ++gI) ec[gI] = EIDX[(size_t)tc * 128 + 16 * gI]; };
    auto issue = [&](int t, const int (&ec)[8], u32x6 (&ur)[8], u32x4 (&hq)[4]) { const int tc = (t < MR) ? t : MR - 1;
#pragma unroll
        for (int gI = 0; gI < 8; ++gI) ur[gI] = load24(PU + (unsigned)ec[gI] * 128u);
#pragma unroll
        for (int q = 0; q < 4; ++q) hq[q] = ((const u32x4*)(H + (size_t)tc * 1024))[q]; };
    auto compute = [&](int t, const u32x6 (&ur)[8], const u32x4 (&hq)[4]) {
        unsigned hx[16];
#pragma unroll
        for (int q = 0; q < 4; ++q) { hx[4 * q] = hq[q].x; hx[4 * q + 1] = hq[q].y; hx[4 * q + 2] = hq[q].z; hx[4 * q + 3] = hq[q].w; }
        float sm[8];
#pragma unroll
        for (int gI = 0; gI < 8; ++gI) { const u32x16 u = __builtin_bit_cast(u32x16, __builtin_amdgcn_cvt_scalef32_pk32_bf16_fp6(ur[gI], 1.0f)); float s0 = 0.f, s1 = 0.f, s2 = 0.f, s3 = 0.f;
#pragma unroll
            for (int j = 0; j < 16; j += 4) { s0 = dot2bf(u[j], hx[j], s0); s1 = dot2bf(u[j + 1], hx[j + 1], s1); s2 = dot2bf(u[j + 2], hx[j + 2], s2); s3 = dot2bf(u[j + 3], hx[j + 3], s3); }
            float pz = (s0 + s1) + (s2 + s3); pz += dpp_f<0xB1>(pz); pz += dpp_f<0x4E>(pz); sm[gI] = pz; __builtin_amdgcn_sched_barrier(0); }
        const float t01 = (seg & 1) ? sm[2] : sm[0], t23 = (seg & 1) ? sm[6] : sm[4], o0 = (seg & 2) ? t23 : t01;
        const float u01 = (seg & 1) ? sm[3] : sm[1], u23 = (seg & 1) ? sm[7] : sm[5], o1 = (seg & 2) ? u23 : u01;
        if (t < MR) { bf16_t* pr = P + (size_t)t * 128; pr[0] = f2b(o0); pr[16] = f2b(o1); } };
    int e0[8], e1[8]; u32x6 uA[8], uB[8]; u32x4 hA[4], hB[4];
    meta(w0, e0); meta(w0 + NW, e1); asm volatile("" ::: "memory");
    issue(w0, e0, uA, hA); asm volatile("" ::: "memory");
#pragma unroll 1
    for (int t = w0; t < MR; t += 2 * NW) {
        meta(t + 2 * NW, e0); asm volatile("" ::: "memory"); issue(t + NW, e1, uB, hB); asm volatile("" ::: "memory"); compute(t, uA, hA); asm volatile("" ::: "memory");
        meta(t + 3 * NW, e1); asm volatile("" ::: "memory"); issue(t + 2 * NW, e0, uA, hA); asm volatile("" ::: "memory"); compute(t + NW, uB, hB); asm volatile("" ::: "memory");
    }
}
__device__ __forceinline__ void peer_act(const KA a_in, int l) {
    const KA a = opaque_ka(a_in); const size_t gt = (size_t)opaque_bid() * 512 + opaque_tid(), NT = (size_t)gridDim.x * 512, tot = (size_t)((l == 1) ? M_LAT : M) * 128;
    const bf16_t* P = (const bf16_t*)(a.ws() + WS_PP); const int* EIDX = (const int*)(a.ws() + WS_YF); const float* GW = (const float*)(a.ws() + WS_YB); const f32x2v* SC = (const f32x2v*)(a.ws() + WS_PT + PT_SC);
    bf16_t* ACT = (bf16_t*)(a.ws() + WS_ACT);
    for (size_t i = gt; i < tot; i += NT) { float h = 0.f;
#pragma unroll
        for (int x = 0; x < 8; ++x) h += __builtin_bit_cast(float, (unsigned)P[(size_t)x * M * 128 + i] << 16);
        const int e = EIDX[i]; const f32x2v sc = SC[e]; ACT[i] = f2b(gelu_erf(h * sc.x) * GW[i] * sc.y); }
}
__device__ __forceinline__ void peer_mix(const KA a_in, int l, float* xlat, float* xctx) {
    const KA a = opaque_ka(a_in); const int tid = opaque_tid(), bid = opaque_bid(); const int lane = tid & 63, wid = tid >> 6, grp = lane >> 2, seg = lane & 3;
    const int xs = bid & 7, nblk = ((int)gridDim.x - xs + 7) >> 3, NW = nblk * 8, w0 = (bid >> 3) * 8 + wid, MR = (l == 1) ? M_LAT : M;
    const unsigned char* PV = a.ws() + WS_PT + PT_V6 + (size_t)xs * PT_SLICE;
    const unsigned char* EB = a.ws() + WS_E16; const unsigned char* AB = a.ws() + WS_ACT;
    const int col = 128 * xs + 2 * lane;
    bf16x4 TSEL;
    { const int sg = lane & 3; u32x2 w; w.x = (sg == 0 ? 0x3F80u : 0u) | (sg == 1 ? 0x3F800000u : 0u); w.y = (sg == 2 ? 0x3F80u : 0u) | (sg == 3 ? 0x3F800000u : 0u); TSEL = __builtin_bit_cast(bf16x4, w); }
    const float* modc = (const float*)(a.ws() + WS_MOD) + (size_t)l * 9 * 6144 + 5 * 1024;
    auto meta = [&](int t, int (&ec)[8]) { const int tc = (t < MR) ? t : MR - 1;
#pragma unroll
        for (int gI = 0; gI < 8; ++gI) ec[gI] = *(const unsigned short*)(EB + ((unsigned)tc * 128u + 16u * gI + (unsigned)grp) * 2u); };
    auto xrow = [&](int t) -> float* { const bool lat = t < M_LAT; return (lat ? xlat + (size_t)t * 1024 : xctx + (size_t)(t - M_LAT) * 1024) + col; };
    const bf16_t* xb_in = (const bf16_t*)xlat; bf16_t* xb_out = (l == 1) ? (bf16_t*)(a.ws() + WS_X4) : (bf16_t*)xlat;
    auto issue = [&](int t, const int (&ec)[8], u32x6 (&vr)[8], float (&aw)[8], f32x2& xv, f32x2& g2) { const int tc = (t < MR) ? t : MR - 1;
#pragma unroll
        for (int gI = 0; gI < 8; ++gI) vr[gI] = load24(PV + ((unsigned)ec[gI] * 128u + (unsigned)seg * 24u));
#pragma unroll
        for (int gI = 0; gI < 8; ++gI) aw[gI] = __builtin_bit_cast(float, (unsigned)*(const unsigned short*)(AB + ((unsigned)tc * 128u + 16u * gI + (unsigned)grp) * 2u) << 16);
        const int bi = (tc < M_LAT) ? (tc >> 13) : 8;
        if (XBF16) { const int tl = (tc < M_LAT) ? tc : M_LAT - 1, tx = (tc >= M_LAT) ? tc - M_LAT : 0; const unsigned w = *(const unsigned*)((const unsigned char*)xb_in + ((unsigned)tl * 2048u + (unsigned)col * 2u)); const f32x2 xc = *(const f32x2*)((const unsigned char*)xctx + ((unsigned)tx * 4096u + (unsigned)col * 4u));
            xv = (tc < M_LAT) ? (f32x2){bf_lo(w), bf_hi(w)} : xc; } else xv = *(const f32x2*)xrow(tc);
        g2 = *(const f32x2*)((const unsigned char*)modc + ((unsigned)bi * 24576u + (unsigned)col * 4u)); };
    auto compute = [&](int t, const u32x6 (&vr)[8], const float (&aw)[8], f32x2 xv, const f32x2 g2) {
        f32x32 acc;
#pragma unroll
        for (int i = 0; i < 32; ++i) acc[i] = 0.f;
#pragma unroll
        for (int gI = 0; gI < 8; ++gI) { u32x6 vq = vr[gI]; asm volatile("" : "+v"(vq), "+v"(acc));
            const f32x32 v = __builtin_amdgcn_cvt_scalef32_pk32_f32_fp6(vq, 1.0f); acc += v * aw[gI]; }
        const f32x4 z4 = (f32x4){0.f, 0.f, 0.f, 0.f}; f32x4 D1a = z4, D1b = z4;
#pragma unroll
        for (int q = 0; q < 4; ++q) { const u32x2 tw = __builtin_bit_cast(u32x2, TSEL); const bool on = ((lane >> 2) & 3) == q; u32x2 sw; sw.x = on ? tw.x : 0u; sw.y = on ? tw.y : 0u; const bf16x4 selq = __builtin_bit_cast(bf16x4, sw);
            D1a = mfma16(pk4(acc[8 * q], acc[8 * q + 2], acc[8 * q + 4], acc[8 * q + 6]), selq, D1a); D1b = mfma16(pk4(acc[8 * q + 1], acc[8 * q + 3], acc[8 * q + 5], acc[8 * q + 7]), selq, D1b); }
        const f32x4 D2a = mfma16(TSEL, pk4v(D1a), z4), D2b = mfma16(TSEL, pk4v(D1b), z4);
        float r2[2];
        { const int g = lane >> 4; const float a01 = (g & 1) ? D2a[1] : D2a[0], a23 = (g & 1) ? D2a[3] : D2a[2], b01 = (g & 1) ? D2b[1] : D2b[0], b23 = (g & 1) ? D2b[3] : D2b[2]; r2[0] = (g & 2) ? a23 : a01; r2[1] = (g & 2) ? b23 : b01; }
        xv[0] += g2[0] * r2[0]; xv[1] += g2[1] * r2[1];
        if (t < MR) { if (XBF16 && t < M_LAT) *(unsigned*)((unsigned char*)xb_out + ((unsigned)t * 2048u + (unsigned)col * 2u)) = pk_bf16(xv[0], xv[1]); else *(f32x2*)xrow(t) = xv; } };
    int e0[8], e1[8]; u32x6 vA[8], vB[8]; float aA[8], aB[8]; f32x2 xA, xB, gA, gB;
    meta(w0, e0); meta(w0 + NW, e1); asm volatile("" ::: "memory");
    issue(w0, e0, vA, aA, xA, gA); asm volatile("" ::: "memory");
#pragma unroll 1
    for (int t = w0; t < MR; t += 2 * NW) {
        meta(t + 2 * NW, e0); asm volatile("" ::: "memory"); issue(t + NW, e1, vB, aB, xB, gB); asm volatile("" ::: "memory"); compute(t, vA, aA, xA, gA); asm volatile("" ::: "memory");
        meta(t + 3 * NW, e1); asm volatile("" ::: "memory"); issue(t + 2 * NW, e0, vA, aA, xA, gA); asm volatile("" ::: "memory"); compute(t + NW, vB, aB, xB, gB); asm volatile("" ::: "memory");
    }
}

#if PROBE_HI > 0
#ifndef CHECK_SUB
#define CHECK_SUB 0
#endif
#ifndef CHECK_ROUND
#define CHECK_ROUND 2
#endif
__device__ __forceinline__ float bfbits2f(bf16_t b) { return __uint_as_float(((unsigned)b) << 16); }
__device__ __forceinline__ bool bad_rel(float got, float ref, float rel, float abs_) { const float d = fabsf(got - ref); return !(d <= rel * fabsf(ref) + abs_); }
__device__ __forceinline__ void check_phase(const KA a) {
    if (blockIdx.x != 0) return;
    __shared__ unsigned fm[4];
    const int t = threadIdx.x;
    if (t < 4) fm[t] = 0u;
    __syncthreads();
    unsigned char* ws = a.ws();
#if CHECK_ROUND == 1
    {
        const int b = t % 9, j = (t * 37) % 6144; const float* cv = (b < 8) ? a.in(I_C) + b * 1024 : a.in(I_CCTX);
        float s = a.in(I_ADAB)[j];
        for (int k = 0; k < 1024; ++k) { const float c = cv[k]; s += (c / (1.f + expf(-c))) * a.in(I_ADAW)[(size_t)k * 6144 + j]; }
        const float got = ((const float*)(ws + WS_MOD))[b * 6144 + j];
        if (bad_rel(got, s, 2e-3f, 2e-3f)) atomicOr(&fm[0], 1u);
    }
    {
        const int row = (int)(((long)t * 131071) % M), col = (t * 17) % 1024;
        const bool lat = row < M_LAT; const int bi = lat ? (row >> 13) : 8;
        const float* xr = lat ? a.in(I_X) + (size_t)row * 1024 : a.in(I_CTX) + (size_t)(row - M_LAT) * 1024;
        float ms = 0.f; for (int k = 0; k < 1024; ++k) ms += xr[k] * xr[k];
        const float rs = 1.0f / sqrtf(ms / 1024.f + 1e-6f);
        const float* modl = (const float*)(ws + WS_MOD);
        const float y = xr[col] * rs * a.in(I_N1G)[col] * (1.f + modl[bi * 6144 + 1024 + col]) + modl[bi * 6144 + col];
        const bf16_t* HB = (const bf16_t*)(ws + WS_H);
        if (bad_rel(bfbits2f(HB[(size_t)row * 1024 + col]), y, 1e-2f, 1e-2f)) atomicOr(&fm[1], 1u);
        const int zc = (t * 29) % 3488; float z = 0.f;
        for (int k = 0; k < 1024; ++k) z += bfbits2f(HB[(size_t)row * 1024 + k]) * a.in(I_WIN)[(size_t)k * P_IN + zc];
        const bf16_t* ZR = (const bf16_t*)(ws + WS_Z);
        if (bad_rel(bfbits2f(ZR[(size_t)row * NZR + zc]), z, 2e-2f, 4e-2f)) atomicOr(&fm[2], 1u);
        const int n = (t * 7) % 3488, k = (t * 13) % 1024; const bf16_t* WrT = (const bf16_t*)(ws + WS_WB + WB_WR);
        const unsigned want = pk_bf16(a.in(I_WIN)[(size_t)k * P_IN + n], 0.f) & 0xffffu;
        if ((unsigned)WrT[(size_t)n * 1024 + k] != want) atomicOr(&fm[3], 1u);
    }
#endif

#if CHECK_ROUND == 2
    {
        const int wv = t >> 6, lane = t & 63;
        if (wv < 2) {
            const int b = 1, h = 3, d = wv, l = 0;
            __shared__ float sh[2][8][64];
            __shared__ float Sst[2][64][65];
            float* S = &Sst[wv][lane][0];
            float (*L)[64] = sh[wv];
            const bf16_t* ZR = (const bf16_t*)(ws + WS_Z); const float* smu = a.in(I_SMU) + (size_t)l * 2 * P_RWKV;
            const bf16_t* Yd = (const bf16_t*)(ws + (d ? WS_YB : WS_YF)); const float* BON = (const float*)(ws + WS_BON);
            const int hc = h * 64 + lane;
            const int cols[5] = {hc, 1024 + hc, 2048 + hc, C_W1 + d * 64 + lane, C_A1 + d * 64 + lane};
#pragma nounroll
            for (int k = 0; k < 64; ++k) S[k] = 0.f;
            bool bad = false, badb = false; float l2n = 0.f, l2d = 0.f;
            for (int step = 0; step < 296; ++step) {
                const int seg = step >= 256, p = seg ? step - 256 : step, len = seg ? SEQ : CTXL; const int base = seg ? b * SEQ : M_LAT + b * CTXL;
                const int tt = d ? len - 1 - p : p;
                float z[5];
#pragma unroll
                for (int g = 0; g < 5; ++g) { const int c = cols[g];
                    const float zc = bfbits2f(ZR[(size_t)(base + tt) * NZR + c]);
                    const float zp = tt > 0 ? bfbits2f(ZR[(size_t)(base + tt - 1) * NZR + c]) : 0.f;
                    const float zn = tt < len - 1 ? bfbits2f(ZR[(size_t)(base + tt + 1) * NZR + c]) : 0.f;
                    z[g] = zc + smu[c] * (zp - zc) + smu[P_RWKV + c] * (zn - zc); }
                L[0][lane] = tanhf(z[3]); L[1][lane] = z[4];
                __builtin_amdgcn_wave_barrier(); asm volatile("s_waitcnt lgkmcnt(0)" ::: "memory");
                float wl = a.in(I_W0)[(l * 2 + d) * 1024 + hc], al = a.in(I_A0)[(l * 2 + d) * 1024 + hc];
#pragma nounroll
                for (int j = 0; j < 64; ++j) { wl += L[0][j] * a.in(I_W2)[((size_t)(l * 2 + d) * 64 + j) * 1024 + hc]; al += L[1][j] * a.in(I_A2)[((size_t)(l * 2 + d) * 64 + j) * 1024 + hc]; }
                const float wlog = -log1pf(expf(-wl)) - 0.5f; const float dec = expf(-expf(wlog));
                const float av = 1.f / (1.f + expf(-al));
                const float kkr = z[1] * a.in(I_KK)[l * 1024 + hc];
                L[7][lane] = kkr * kkr;
                __builtin_amdgcn_wave_barrier(); asm volatile("s_waitcnt lgkmcnt(0)" ::: "memory");
                float n2 = 0.f; for (int j = 0; j < 64; ++j) n2 += L[7][j];
                const float kk = kkr / fmaxf(sqrtf(n2), 1e-12f);
                const float kd = z[1] * (1.f + (av - 1.f) * a.in(I_KA)[l * 1024 + hc]);
                L[2][lane] = kk; L[3][lane] = kk * av; L[4][lane] = kd; L[5][lane] = z[0]; L[6][lane] = dec;
                __builtin_amdgcn_wave_barrier(); asm volatile("s_waitcnt lgkmcnt(0)" ::: "memory");
                float sa = 0.f;
#pragma nounroll
                for (int k = 0; k < 64; ++k) sa += S[k] * L[2][k];
                float y = 0.f, bon = 0.f;
#pragma nounroll
                for (int k = 0; k < 64; ++k) { S[k] = S[k] * L[6][k] - sa * L[3][k] + z[2] * L[4][k]; y += S[k] * L[5][k]; }
                for (int k = 0; k < 64; ++k) bon += L[5][k] * L[4][k] * a.in(I_RK)[l * 1024 + h * 64 + k];
                if (step >= 200) {
                    const float got = bfbits2f(Yd[(size_t)(base + tt) * 1024 + hc]);
                    if (bad_rel(got, y, 1.2e-2f, 0.06f)) bad = true; l2n += (got - y) * (got - y); l2d += y * y;
                    const float gb = BON[((size_t)d * M + base + tt) * 16 + h];
                    if (bad_rel(gb, bon, 2e-2f, 2e-2f)) badb = true;
                }
                __builtin_amdgcn_wave_barrier(); asm volatile("s_waitcnt lgkmcnt(0)" ::: "memory");
            }
            if (bad) atomicOr(&fm[d], 1u);
            if (badb) atomicOr(&fm[2 + d], 1u);
            { __shared__ float l2s[2][2]; if (lane == 0) { l2s[wv][0] = 0.f; l2s[wv][1] = 0.f; } __builtin_amdgcn_wave_barrier(); atomicAdd(&l2s[wv][0], l2n); atomicAdd(&l2s[wv][1], l2d); __builtin_amdgcn_wave_barrier();
              if (lane == 0) { const float re = sqrtf(l2s[wv][0] / fmaxf(l2s[wv][1], 1e-30f)); const unsigned bk = re < 0.005f ? 0u : (re < 0.01f ? 1u : (re < 0.02f ? 2u : (re < 0.05f ? 3u : 4u))); ((unsigned*)(ws + WS_CTL))[10 + wv] = bk; } }
        }
    }
#endif
#if CHECK_ROUND == 3
    {
        const int row = (int)(((long)t * 131071) % M), ch = (t * 17) % 1024, gc = (t * 23) % 2048;
        const bf16_t* HB = (const bf16_t*)(ws + WS_H); const bf16_t* WgT = (const bf16_t*)(ws + WS_WB + WB_WG);
        { const int n = (t * 7) % 2048, k = (t * 13) % 1024; const unsigned want = pk_bf16(a.in(I_WIN)[(size_t)k * P_IN + P_RWKV + 2048 + n], 0.f) & 0xffffu;
          if ((unsigned)WgT[(size_t)n * 1024 + k] != want) atomicOr(&fm[0], 1u); }
        float z1 = 0.f, z2 = 0.f, zg = 0.f, zg2 = 0.f;
        for (int k = 0; k < 1024; ++k) { const float hv = bfbits2f(HB[(size_t)row * 1024 + k]); const float* wr = a.in(I_WIN) + (size_t)k * P_IN;
            z1 += hv * wr[P_RWKV + ch]; z2 += hv * wr[P_RWKV + 1024 + ch]; zg += hv * wr[P_RWKV + 2048 + gc]; zg2 += hv * bfbits2f(WgT[(size_t)gc * 1024 + k]); }
        const float u = z1 / (1.f + expf(-z2)), g = 1.f / (1.f + expf(-(zg + a.in(I_GATEB)[gc]))), g2 = 1.f / (1.f + expf(-(zg2 + a.in(I_GATEB)[gc])));
        const bf16_t* U = (const bf16_t*)(ws + WS_Z); const bf16_t* G = (const bf16_t*)(ws + WS_Z + 132 * MiB);
        if (bad_rel(bfbits2f(G[(size_t)row * 2048 + gc]), g2, 2e-2f, 1e-2f)) atomicOr(&fm[1], 1u);
        if (bad_rel(bfbits2f(U[(size_t)row * 1024 + ch]), u, 3e-2f, 3e-2f)) atomicOr(&fm[2], 1u);
        if (bad_rel(bfbits2f(G[(size_t)row * 2048 + gc]), g, 2e-2f, 1e-2f)) atomicOr(&fm[3], 1u);
    }
#endif

#if CHECK_ROUND == 4
    {
        __shared__ unsigned cnt; __shared__ unsigned mx;
        if (t == 0) { cnt = 0u; mx = 0u; }
        __syncthreads();
        const bf16_t* HB = (const bf16_t*)(ws + WS_H); const bf16_t* WgT = (const bf16_t*)(ws + WS_WB + WB_WG); const bf16_t* G = (const bf16_t*)(ws + WS_Z + 132 * MiB);
        for (int rep = 0; rep < 4; ++rep) {
            const int sidx = t + 512 * rep; const int row = (int)(((long)sidx * 131071) % M), gc = (sidx * 23) % 2048;
            float zg2 = 0.f;
            for (int k = 0; k < 1024; ++k) zg2 += bfbits2f(HB[(size_t)row * 1024 + k]) * bfbits2f(WgT[(size_t)gc * 1024 + k]);
            const float g2 = 1.f / (1.f + expf(-(zg2 + a.in(I_GATEB)[gc])));
            const float d = fabsf(bfbits2f(G[(size_t)row * 2048 + gc]) - g2);
            if (!(d <= 0.01f)) { atomicAdd(&cnt, 1u); atomicMax(&mx, __float_as_uint(d != d ? 1e9f : d)); }
        }
        __syncthreads();
        if (t == 0) { const unsigned c = cnt; const float m = __uint_as_float(mx);
            const unsigned cb = c == 0 ? 0u : (c <= 2 ? 1u : (c <= 8 ? 2u : (c <= 64 ? 3u : (c <= 512 ? 4u : 5u))));
            const unsigned mb = m < 0.02f ? 0u : (m < 0.05f ? 1u : (m < 0.15f ? 2u : (m < 0.5f ? 3u : 4u)));
            fm[0] = 0; fm[1] = 0; fm[2] = 0; fm[3] = 0; ((unsigned*)(ws + WS_CTL))[9] = 5u * cb + mb; }
        __syncthreads();
    }
#endif

#if CHECK_ROUND == 6
    {
        __shared__ unsigned cnt; __shared__ unsigned mx;
        if (t == 0) { cnt = 0u; mx = 0u; }
        __syncthreads();
        const bf16_t* HB = (const bf16_t*)(ws + WS_H); const bf16_t* WgT = (const bf16_t*)(ws + WS_WB + WB_WG); const bf16_t* G = (const bf16_t*)(ws + WS_Z + 132 * MiB);
        for (int rep = 0; rep < 4; ++rep) {
            const int sidx = t + 512 * rep; const int row = (int)(((long)sidx * 131071) % M), gc = (sidx * 23) % 2048;
            float zg2 = 0.f;
            for (int k = 0; k < 1024; ++k) zg2 += bfbits2f(HB[(size_t)row * 1024 + k]) * bfbits2f(WgT[(size_t)gc * 1024 + k]);
            const float d = fabsf(bfbits2f(G[(size_t)row * 2048 + gc]) - zg2);
            if (!(d <= 0.02f + 0.01f * fabsf(zg2))) { atomicAdd(&cnt, 1u); atomicMax(&mx, __float_as_uint(d != d ? 1e9f : d)); }
        }
        __syncthreads();
        if (t == 0) { const unsigned c = cnt; const float m = __uint_as_float(mx);
            const unsigned cb = c == 0 ? 0u : (c <= 2 ? 1u : (c <= 8 ? 2u : (c <= 64 ? 3u : (c <= 512 ? 4u : 5u))));
            const unsigned mb = m < 0.05f ? 0u : (m < 0.2f ? 1u : (m < 1.0f ? 2u : (m < 5.f ? 3u : 4u)));
            ((unsigned*)(ws + WS_CTL))[9] = 5u * cb + mb; }
        __syncthreads();
    }
#endif
#if CHECK_ROUND == 7
    {
        const bf16_t* HB = (const bf16_t*)(ws + WS_H); const bf16_t* Q = (const bf16_t*)(ws + WS_Z); const bf16_t* SKB = (const bf16_t*)(ws + WS_WB + WB_SK);
        const int* EIDX = (const int*)(ws + WS_YF); const float* GWp = (const float*)(ws + WS_YB);
        { const int row = (int)(((long)t * 131071) % M), qc = (t * 29) % 2048; float z = 0.f;
          for (int k = 0; k < 1024; ++k) z += bfbits2f(HB[(size_t)row * 1024 + k]) * a.in(I_WQ)[(size_t)k * 2048 + qc];
          if (bad_rel(bfbits2f(Q[(size_t)row * 2048 + qc]), z, 2e-2f, 4e-2f)) atomicOr(&fm[0], 1u); }
        __shared__ float sc[32][2][128];
        if (t < 32) {
            const int tok = (int)(((long)t * 104729) % M), h = t & 7;
            for (int c = 0; c < 2; ++c) for (int n = 0; n < 128; ++n) { float s = 0.f;
                for (int dd = 0; dd < 128; ++dd) s += bfbits2f(Q[(size_t)tok * 2048 + h * 256 + c * 128 + dd]) * bfbits2f(SKB[((size_t)(h * 2 + c) * 128 + n) * 128 + dd]);
                sc[t][c][n] = s; }
            float tv[2][16]; int ti[2][16];
            for (int c = 0; c < 2; ++c) for (int r = 0; r < 16; ++r) { float best = -1e30f; int bi_ = 0;
                for (int n = 0; n < 128; ++n) { const float v = sc[t][c][n]; if (v > best) { best = v; bi_ = n; } }
                sc[t][c][bi_] = -1e30f; float* tvp = &sc[t][c][0]; (void)tvp;
                if (c == 0) { tv[0][r] = best; ti[0][r] = bi_; } else { tv[1][r] = best; ti[1][r] = bi_; } }
            unsigned used[8] = {0u, 0u, 0u, 0u, 0u, 0u, 0u, 0u};
            int miss = 0; float wsum = 0.f, w0 = 0.f; float cv[16]; int ce_[16];
            for (int r = 0; r < 16; ++r) { float best = -1e30f; int bp = 0;
                for (int p = 0; p < 256; ++p) { if (used[p >> 5] & (1u << (p & 31))) continue; const float v = tv[0][p >> 4] + tv[1][p & 15]; if (v > best) { best = v; bp = p; } }
                used[bp >> 5] |= 1u << (bp & 31); cv[r] = best; ce_[r] = ti[0][bp >> 4] * 128 + ti[1][bp & 15]; }
            w0 = cv[0]; for (int r = 0; r < 16; ++r) wsum += expf(cv[r] - w0);
            for (int r = 0; r < 16; ++r) { bool found = false; float gw_k = 0.f;
                for (int q = 0; q < 16; ++q) if (EIDX[(size_t)tok * 128 + h * 16 + q] == ce_[r]) { found = true; gw_k = GWp[(size_t)tok * 128 + h * 16 + q]; }
                if (!found) ++miss; else if (bad_rel(gw_k, expf(cv[r] - w0) / wsum, 5e-2f, 5e-3f)) ++miss; }
            if (miss > 2) atomicOr(&fm[1], 1u);
        }
        {
            const bf16_t* PU = (const bf16_t*)(ws + WS_PT); const bf16_t* PV = (const bf16_t*)(ws + WS_PT + 32 * MiB); const bf16_t* DMP = (const bf16_t*)(ws + WS_Z + 264 * MiB);
            const int tok = (int)(((long)(t >> 3) * 104729 + 17) % M), dcol = ((t & 7) * 131 + (t >> 3) * 7) % 1024; float o = 0.f;
            for (int e = 0; e < 128; ++e) { const int ex = EIDX[(size_t)tok * 128 + e]; if (ex < 0 || ex >= 16384) { o = __builtin_nanf(""); break; } float dt = 0.f;
                for (int k = 0; k < 1024; ++k) dt += bfbits2f(PU[(size_t)ex * 1024 + k]) * bfbits2f(HB[(size_t)tok * 1024 + k]);
                const float ge = 0.5f * dt * (1.f + erff(dt * 0.70710678f));
                o += ge * GWp[(size_t)tok * 128 + e] * bfbits2f(PV[(size_t)ex * 1024 + dcol]); }
            if (bad_rel(bfbits2f(DMP[(size_t)tok * 1024 + dcol]), o, 3e-2f, 2e-2f)) atomicOr(&fm[2], 1u);
        }
    }
#endif
#if CHECK_ROUND == 8
    {
        const bf16_t* A1 = (const bf16_t*)(ws + WS_YF); const bf16_t* A2 = (const bf16_t*)(ws + WS_YB); const bf16_t* O2 = (const bf16_t*)(ws + WS_Z + 396 * MiB);
        const bf16_t* SG = (const bf16_t*)(ws + WS_PT); const bf16_t* U = (const bf16_t*)(ws + WS_Z); const bf16_t* G = (const bf16_t*)(ws + WS_Z + 132 * MiB); const bf16_t* MB = (const bf16_t*)(ws + WS_H);
        { const int row = (int)(((long)t * 131071) % 32768), c = (t * 17) % 1024; float g = 0.f;
          for (int k = 0; k < 160; ++k) g += bfbits2f(SG[(size_t)row * 256 + k]) * a.in(I_G2)[(size_t)k * 1024 + c];
          const float want = bfbits2f(O2[(size_t)row * 1024 + c]) * g;
          if (bad_rel(bfbits2f(A1[(size_t)row * 1024 + c]), want, 3e-2f, 2e-2f)) atomicOr(&fm[0], 1u); }
        { const int row = (int)(((long)t * 131071) % M), c = (t * 17) % 1024; const bool lat = row < M_LAT; const int stride = lat ? 64 : 1; const int pos = lat ? ((row & (SEQ - 1)) >> 6) : ((row - M_LAT) & (CTXL - 1)); const int len = lat ? 128 : CTXL;
          float mean = 0.f, var = 0.f, mine = 0.f;
          for (int pass = 0; pass < 2; ++pass) { float s = 0.f;
              for (int ch = 0; ch < 1024; ++ch) { float acc = 0.f;
                  for (int k = 0; k < 31; ++k) { const int pp = pos + k - 15; if (pp >= 0 && pp < len) acc += bfbits2f(U[(size_t)(row + (k - 15) * stride) * 1024 + ch]) * a.in(I_CONVW)[k * 1024 + ch]; }
                  if (pass == 0) s += acc; else { s += (acc - mean) * (acc - mean); if (ch == c) mine = acc; } }
              if (pass == 0) mean = s / 1024.f; else var = s / 1024.f; }
          const float y = (mine - mean) / sqrtf(var + 1e-5f) * a.in(I_CNG)[c] + a.in(I_CNB)[c]; const float want = y / (1.f + expf(-y));
          if (bad_rel(bfbits2f(A2[(size_t)row * 1024 + c]), want, 3e-2f, 2e-2f)) atomicOr(&fm[1], 1u); }
        { const int row = (int)(((long)t * 131071) % M), c = (t * 19) % 1024; float ya = 0.f, yb = 0.f;
          for (int k = 0; k < 1024; ++k) { ya += bfbits2f(A1[(size_t)row * 1024 + k]) * a.in(I_WOA)[(size_t)k * 1024 + c]; yb += bfbits2f(A2[(size_t)row * 1024 + k]) * a.in(I_WOB)[(size_t)k * 1024 + c]; }
          const float want = bfbits2f(G[(size_t)row * 2048 + c]) * ya + bfbits2f(G[(size_t)row * 2048 + 1024 + c]) * yb;
          if (bad_rel(bfbits2f(MB[(size_t)row * 1024 + c]), want, 3e-2f, 3e-2f)) atomicOr(&fm[2], 1u); }
        { const int row = (int)(((long)t * 131071) % M), c = (t * 23) % 1024; const bool lat = row < M_LAT; const int bi = lat ? (row >> 13) : 8; float y = 0.f;
          for (int k = 0; k < 1024; ++k) y += bfbits2f(MB[(size_t)row * 1024 + k]) * a.in(I_WOUT)[(size_t)k * 1024 + c];
          const float xin = lat ? a.in(I_X)[(size_t)row * 1024 + c] : a.in(I_CTX)[(size_t)(row - M_LAT) * 1024 + c];
          const float want = xin + ((const float*)(ws + WS_MOD))[bi * 6144 + 2048 + c] * y;
          const float got = lat ? a.out()[(size_t)row * 1024 + c] : ((const float*)(ws + WS_XCTX))[(size_t)(row - M_LAT) * 1024 + c];
          if (bad_rel(got, want, 1e-2f, 2e-2f)) atomicOr(&fm[3], 1u); }
    }
#endif
#if CHECK_ROUND == 9
    {
        const bf16_t* YF = (const bf16_t*)(ws + WS_YF); const bf16_t* YB = (const bf16_t*)(ws + WS_YB); const bf16_t* ZR = (const bf16_t*)(ws + WS_Z); const bf16_t* O2 = (const bf16_t*)(ws + WS_Z + 396 * MiB);
        const float* BON = (const float*)(ws + WS_BON); const bf16_t* SG = (const bf16_t*)(ws + WS_PT); const float* smu = a.in(I_SMU);
        { const int row = (int)(((long)t * 131071) % 32768), c = (t * 17) % 1024, hd = c >> 6; const int tt = row & (SEQ - 1);
          float mean = 0.f, var = 0.f;
          for (int j = 0; j < 64; ++j) mean += bfbits2f(YF[(size_t)row * 1024 + hd * 64 + j]) + bfbits2f(YB[(size_t)row * 1024 + hd * 64 + j]);
          mean /= 64.f;
          for (int j = 0; j < 64; ++j) { const float o = bfbits2f(YF[(size_t)row * 1024 + hd * 64 + j]) + bfbits2f(YB[(size_t)row * 1024 + hd * 64 + j]) - mean; var += o * o; }
          var /= 64.f;
          const float o = bfbits2f(YF[(size_t)row * 1024 + c]) + bfbits2f(YB[(size_t)row * 1024 + c]);
          const float zc = bfbits2f(ZR[(size_t)row * NZR + C_V + c]), zp = tt > 0 ? bfbits2f(ZR[(size_t)(row - 1) * NZR + C_V + c]) : 0.f, zn = tt < SEQ - 1 ? bfbits2f(ZR[(size_t)(row + 1) * NZR + C_V + c]) : 0.f;
          const float vv = zc + smu[C_V + c] * (zp - zc) + smu[P_RWKV + C_V + c] * (zn - zc);
          const float want = (o - mean) / sqrtf(var + 64e-5f) * a.in(I_LNXG)[c] + a.in(I_LNXB)[c] + (BON[(size_t)row * 16 + hd] + BON[((size_t)M + row) * 16 + hd]) * vv;
          if (bad_rel(bfbits2f(O2[(size_t)row * 1024 + c]), want, 3e-2f, 3e-2f)) atomicOr(&fm[0], 1u); }
        { const int row = (int)(((long)t * 131071) % M), k = (t * 7) % 256; const bool lat = row < M_LAT; const int tt = lat ? (row & (SEQ - 1)) : ((row - M_LAT) & (CTXL - 1)); const int len = lat ? SEQ : CTXL;
          float want = 0.f;
          if (k < 160) { const float zc = bfbits2f(ZR[(size_t)row * NZR + C_G1 + k]), zp = tt > 0 ? bfbits2f(ZR[(size_t)(row - 1) * NZR + C_G1 + k]) : 0.f, zn = tt < len - 1 ? bfbits2f(ZR[(size_t)(row + 1) * NZR + C_G1 + k]) : 0.f;
              const float z = zc + smu[C_G1 + k] * (zp - zc) + smu[P_RWKV + C_G1 + k] * (zn - zc); want = 1.f / (1.f + expf(-z)); }
          if (bad_rel(bfbits2f(SG[(size_t)row * 256 + k]), want, 2e-2f, 1e-2f)) atomicOr(&fm[1], 1u); }
    }
#endif
#if CHECK_ROUND == 10
    {
        const float* XB = (const float*)(ws + WS_Z + 396 * MiB); const bf16_t* DMP = (const bf16_t*)(ws + WS_Z + 264 * MiB); const bf16_t* HB = (const bf16_t*)(ws + WS_H);
        const float* mod0 = (const float*)(ws + WS_MOD);
        { const int row = (int)(((long)t * 131071) % 16384), c = (t * 17) % 1024, bi = row >> 13;
          const float want = XB[(size_t)row * 1024 + c] + mod0[bi * 6144 + 5120 + c] * bfbits2f(DMP[(size_t)row * 1024 + c]);
          if (bad_rel(a.out()[(size_t)row * 1024 + c], want, 1e-2f, 1e-2f)) atomicOr(&fm[0], 1u);
          float ms = 0.f; for (int k = 0; k < 1024; ++k) { const float xv = XB[(size_t)row * 1024 + k]; ms += xv * xv; }
          const float rs = 1.0f / sqrtf(ms / 1024.f + 1e-6f);
          const float y = XB[(size_t)row * 1024 + c] * rs * a.in(I_N2G)[c] * (1.f + mod0[bi * 6144 + 4096 + c]) + mod0[bi * 6144 + 3072 + c];
          if (bad_rel(bfbits2f(HB[(size_t)row * 1024 + c]), y, 1e-2f, 1e-2f)) atomicOr(&fm[1], 1u); }
        { const int b = t % 9, j = (t * 37) % 6144; const float* cv = (b < 8) ? a.in(I_C) + b * 1024 : a.in(I_CCTX);
          float s = a.in(I_ADAB)[6144 + j];
          for (int k = 0; k < 1024; ++k) { const float c = cv[k]; s += (c / (1.f + expf(-c))) * a.in(I_ADAW)[(size_t)(1024 + k) * 6144 + j]; }
          if (bad_rel(mod0[9 * 6144 + b * 6144 + j], s, 2e-3f, 2e-3f)) atomicOr(&fm[2], 1u); }
        { const unsigned char* wb1 = ws + WS_WB + WB_LAYER; const float* win1 = a.in(I_WIN) + (size_t)1024 * P_IN;
          const int n = (t * 7) % 3488, k = (t * 13) % 1024;
          if ((unsigned)((const bf16_t*)(wb1 + WB_WR))[(size_t)n * 1024 + k] != (pk_bf16(win1[(size_t)k * P_IN + n], 0.f) & 0xffffu)) atomicOr(&fm[3], 1u);
          const int n2 = (t * 11) % 2048;
          if ((unsigned)((const bf16_t*)(wb1 + WB_Q))[(size_t)n2 * 1024 + k] != (pk_bf16(a.in(I_WQ)[(size_t)2097152 + (size_t)k * 2048 + n2], 0.f) & 0xffffu)) atomicOr(&fm[3], 1u);
          const int n3 = (t * 5) % 1024;
          if ((unsigned)((const bf16_t*)(wb1 + WB_OUT))[(size_t)n3 * 1024 + k] != (pk_bf16(a.in(I_WOUT)[(size_t)1048576 + (size_t)k * 1024 + n3], 0.f) & 0xffffu)) atomicOr(&fm[3], 1u);
          if ((unsigned)((const bf16_t*)(wb1 + WB_OA))[(size_t)n3 * 1024 + k] != (pk_bf16(a.in(I_WOA)[(size_t)1048576 + (size_t)k * 1024 + n3], 0.f) & 0xffffu)) atomicOr(&fm[3], 1u);
          if ((unsigned)((const bf16_t*)(wb1 + WB_OB))[(size_t)n3 * 1024 + k] != (pk_bf16(a.in(I_WOB)[(size_t)1048576 + (size_t)k * 1024 + n3], 0.f) & 0xffffu)) atomicOr(&fm[3], 1u); }
    }
#endif
#if CHECK_ROUND == 13
    {
        __shared__ float xs[1024], hs[1024], qs[2048], ss[16][128], actv[128], red[512]; __shared__ int eix[128]; __shared__ float acc_num, acc_den, b_num, b_den, ab_num; __shared__ unsigned nmatch; __shared__ float actb[128];
        const float* XB = (const float*)(ws + WS_Z + 396 * MiB); const bf16_t* DMP = (const bf16_t*)(ws + WS_Z + 264 * MiB); const float* mod0 = (const float*)(ws + WS_MOD); const int* EIDX = (const int*)(ws + WS_YF);
        if (t == 0) { acc_num = 0.f; acc_den = 0.f; nmatch = 0u; b_num = 0.f; b_den = 0.f; ab_num = 0.f; }
        __syncthreads();
        for (int smp = 0; smp < 4; ++smp) {
            const int row = 1000 + smp * 4099, bi = row >> 13;
            xs[t] = XB[(size_t)row * 1024 + t]; xs[t + 512] = XB[(size_t)row * 1024 + t + 512];
            red[t] = xs[t] * xs[t] + xs[t + 512] * xs[t + 512];
            __syncthreads();
            for (int o = 256; o > 0; o >>= 1) { if (t < o) red[t] += red[t + o]; __syncthreads(); }
            const float rs = 1.0f / sqrtf(red[0] / 1024.f + 1e-6f);
            for (int c = t; c < 1024; c += 512) hs[c] = xs[c] * rs * a.in(I_N2G)[c] * (1.f + mod0[bi * 6144 + 4096 + c]) + mod0[bi * 6144 + 3072 + c];
            __syncthreads();
            for (int j = t; j < 2048; j += 512) { float q = 0.f; for (int k = 0; k < 1024; ++k) q += hs[k] * a.in(I_WQ)[(size_t)k * 2048 + j]; qs[j] = q; }
            __syncthreads();
            for (int j = t; j < 2048; j += 512) { const int hc2 = j >> 7, n = j & 127; float s = 0.f; for (int dd = 0; dd < 128; ++dd) s += qs[hc2 * 128 + dd] * a.in(I_SUBK)[((size_t)hc2 * 128 + n) * 128 + dd]; ss[hc2][n] = s; }
            __syncthreads();
            if (t < 8) { const int h = t; float tv[2][16]; int ti[2][16];
                for (int c = 0; c < 2; ++c) for (int r = 0; r < 16; ++r) { float best = -1e30f; int bn = 0; for (int n = 0; n < 128; ++n) { const float v = ss[h * 2 + c][n]; if (v > best) { best = v; bn = n; } } ss[h * 2 + c][bn] = -1e30f; tv[c][r] = best; ti[c][r] = bn; }
                unsigned used[8] = {0u, 0u, 0u, 0u, 0u, 0u, 0u, 0u}; float cv[16]; float wsum = 0.f;
                for (int r = 0; r < 16; ++r) { float best = -1e30f; int bp = 0; for (int p = 0; p < 256; ++p) { if (used[p >> 5] & (1u << (p & 31))) continue; const float v = tv[0][p >> 4] + tv[1][p & 15]; if (v > best) { best = v; bp = p; } }
                    used[bp >> 5] |= 1u << (bp & 31); cv[r] = best; eix[h * 16 + r] = ti[0][bp >> 4] * 128 + ti[1][bp & 15]; }
                for (int r = 0; r < 16; ++r) wsum += expf(cv[r] - cv[0]);
                for (int r = 0; r < 16; ++r) actv[h * 16 + r] = expf(cv[r] - cv[0]) / wsum; }
            __syncthreads();
            if (t < 128) { const int ex = eix[t]; float dt = 0.f; for (int k = 0; k < 1024; ++k) dt += hs[k] * a.in(I_PU)[(size_t)ex * 1024 + k];
                actv[t] = 0.5f * dt * (1.f + erff(dt * 0.70710678f)) * actv[t];
                bool fnd = false; for (int q = 0; q < 16; ++q) fnd |= (EIDX[(size_t)row * 128 + (t >> 4) * 16 + q] == ex); if (fnd) atomicAdd(&nmatch, 1u); }
            if (t < 128) { const bf16_t* HBk = (const bf16_t*)(ws + WS_H); const bf16_t* PUk = (const bf16_t*)(ws + WS_PT); const float* GWk = (const float*)(ws + WS_YB);
                const int ex = EIDX[(size_t)row * 128 + t]; float dt = 0.f; for (int k = 0; k < 1024; ++k) dt += bfbits2f(HBk[(size_t)row * 1024 + k]) * bfbits2f(PUk[(size_t)ex * 1024 + k]);
                actb[t] = 0.5f * dt * (1.f + erff(dt * 0.70710678f)) * GWk[(size_t)row * 128 + t]; }
            __syncthreads();
            float num = 0.f, den = 0.f, bn = 0.f, bd = 0.f, abn = 0.f;
            for (int c = t; c < 1024; c += 512) { float o = 0.f; for (int e = 0; e < 128; ++e) o += actv[e] * a.in(I_PV)[(size_t)eix[e] * 1024 + c]; const float dm = bfbits2f(DMP[(size_t)row * 1024 + c]); num += (o - dm) * (o - dm); den += o * o;
                float ob = 0.f; { const bf16_t* PVk = (const bf16_t*)(ws + WS_PT + 32 * MiB); for (int e2 = 0; e2 < 128; ++e2) ob += actb[e2] * bfbits2f(PVk[(size_t)EIDX[(size_t)row * 128 + e2] * 1024 + c]); }
                bn += (ob - dm) * (ob - dm); bd += ob * ob; abn += (o - ob) * (o - ob); }
            atomicAdd(&acc_num, num); atomicAdd(&acc_den, den); atomicAdd(&b_num, bn); atomicAdd(&b_den, bd); atomicAdd(&ab_num, abn);
            __syncthreads();
        }
        if (t == 0) { const float re = sqrtf(acc_num / fmaxf(acc_den, 1e-30f)); const unsigned eb = re < 0.03f ? 0u : (re < 0.1f ? 1u : (re < 0.3f ? 2u : (re < 1.0f ? 3u : 4u)));
            const float rb = sqrtf(b_num / fmaxf(b_den, 1e-30f)), rab = sqrtf(ab_num / fmaxf(acc_den, 1e-30f));
            const unsigned bb = rb < 0.03f ? 0u : (rb < 0.1f ? 1u : (rb < 0.3f ? 2u : (rb < 1.0f ? 3u : 4u))); const unsigned abb = rab < 0.03f ? 0u : (rab < 0.1f ? 1u : (rab < 0.3f ? 2u : (rab < 1.0f ? 3u : 4u)));
            (void)eb; ((unsigned*)(ws + WS_CTL))[9] = 5u * bb + abb; }
        __syncthreads();
    }
#endif
#if CHECK_ROUND == 11
    {
        __shared__ float xs[1024], hs[1024], qs[2048], ss[16][128], actv[128], red[512]; __shared__ int eix[128]; __shared__ float acc_num, acc_den; __shared__ unsigned nmatch;
        const float* XB = (const float*)(ws + WS_Z + 396 * MiB); const bf16_t* DMP = (const bf16_t*)(ws + WS_Z + 264 * MiB); const float* mod0 = (const float*)(ws + WS_MOD); const int* EIDX = (const int*)(ws + WS_YF);
        if (t == 0) { acc_num = 0.f; acc_den = 0.f; nmatch = 0u; }
        __syncthreads();
        for (int smp = 0; smp < 4; ++smp) {
            const int row = 1000 + smp * 4099, bi = row >> 13;
            xs[t] = XB[(size_t)row * 1024 + t]; xs[t + 512] = XB[(size_t)row * 1024 + t + 512];
            red[t] = xs[t] * xs[t] + xs[t + 512] * xs[t + 512];
            __syncthreads();
            for (int o = 256; o > 0; o >>= 1) { if (t < o) red[t] += red[t + o]; __syncthreads(); }
            const float rs = 1.0f / sqrtf(red[0] / 1024.f + 1e-6f);
            for (int c = t; c < 1024; c += 512) hs[c] = xs[c] * rs * a.in(I_N2G)[c] * (1.f + mod0[bi * 6144 + 4096 + c]) + mod0[bi * 6144 + 3072 + c];
            __syncthreads();
            for (int j = t; j < 2048; j += 512) { float q = 0.f; for (int k = 0; k < 1024; ++k) q += hs[k] * a.in(I_WQ)[(size_t)k * 2048 + j]; qs[j] = q; }
            __syncthreads();
            for (int j = t; j < 2048; j += 512) { const int hc2 = j >> 7, n = j & 127; float s = 0.f; for (int dd = 0; dd < 128; ++dd) s += qs[hc2 * 128 + dd] * a.in(I_SUBK)[((size_t)hc2 * 128 + n) * 128 + dd]; ss[hc2][n] = s; }
            __syncthreads();
            if (t < 8) { const int h = t; float tv[2][16]; int ti[2][16];
                for (int c = 0; c < 2; ++c) for (int r = 0; r < 16; ++r) { float best = -1e30f; int bn = 0; for (int n = 0; n < 128; ++n) { const float v = ss[h * 2 + c][n]; if (v > best) { best = v; bn = n; } } ss[h * 2 + c][bn] = -1e30f; tv[c][r] = best; ti[c][r] = bn; }
                unsigned used[8] = {0u, 0u, 0u, 0u, 0u, 0u, 0u, 0u}; float cv[16]; float wsum = 0.f;
                for (int r = 0; r < 16; ++r) { float best = -1e30f; int bp = 0; for (int p = 0; p < 256; ++p) { if (used[p >> 5] & (1u << (p & 31))) continue; const float v = tv[0][p >> 4] + tv[1][p & 15]; if (v > best) { best = v; bp = p; } }
                    used[bp >> 5] |= 1u << (bp & 31); cv[r] = best; eix[h * 16 + r] = ti[0][bp >> 4] * 128 + ti[1][bp & 15]; }
                for (int r = 0; r < 16; ++r) wsum += expf(cv[r] - cv[0]);
                for (int r = 0; r < 16; ++r) actv[h * 16 + r] = expf(cv[r] - cv[0]) / wsum; }
            __syncthreads();
            if (t < 128) { const int ex = eix[t]; float dt = 0.f; for (int k = 0; k < 1024; ++k) dt += hs[k] * a.in(I_PU)[(size_t)ex * 1024 + k];
                actv[t] = 0.5f * dt * (1.f + erff(dt * 0.70710678f)) * actv[t];
                bool fnd = false; for (int q = 0; q < 16; ++q) fnd |= (EIDX[(size_t)row * 128 + (t >> 4) * 16 + q] == ex); if (fnd) atomicAdd(&nmatch, 1u); }
            __syncthreads();
            float num = 0.f, den = 0.f;
            for (int c = t; c < 1024; c += 512) { float o = 0.f; for (int e = 0; e < 128; ++e) o += actv[e] * a.in(I_PV)[(size_t)eix[e] * 1024 + c]; const float dm = bfbits2f(DMP[(size_t)row * 1024 + c]); num += (o - dm) * (o - dm); den += o * o; }
            atomicAdd(&acc_num, num); atomicAdd(&acc_den, den);
            __syncthreads();
        }
        if (t == 0) { const float re = sqrtf(acc_num / fmaxf(acc_den, 1e-30f)); const unsigned eb = re < 0.03f ? 0u : (re < 0.1f ? 1u : (re < 0.3f ? 2u : (re < 1.0f ? 3u : 4u)));
            const unsigned nm = nmatch; const unsigned mb = nm >= 500 ? 0u : (nm >= 460 ? 1u : (nm >= 384 ? 2u : (nm >= 128 ? 3u : 4u)));
            ((unsigned*)(ws + WS_CTL))[9] = 5u * eb + mb; }
        __syncthreads();
    }
#endif
#if CHECK_ROUND == 12
    {
        const bf16_t* PU = (const bf16_t*)(ws + WS_PT); const bf16_t* PV = (const bf16_t*)(ws + WS_PT + 32 * MiB);
        for (int rep = 0; rep < 8; ++rep) { const int sidx = t + 512 * rep; const int e = (int)(((long)sidx * 7919) % 16384), k = (sidx * 13) % 1024;
            if ((unsigned)PU[(size_t)e * 1024 + k] != (pk_bf16(a.in(I_PU)[(size_t)e * 1024 + k], 0.f) & 0xffffu)) { atomicOr(&fm[0], 1u); if (e < 8192) atomicOr(&fm[2], 1u); }
            if ((unsigned)PV[(size_t)e * 1024 + k] != (pk_bf16(a.in(I_PV)[(size_t)e * 1024 + k], 0.f) & 0xffffu)) { atomicOr(&fm[1], 1u); if (e < 8192) atomicOr(&fm[3], 1u); } }
    }
#endif
#if CHECK_ROUND == 15
    {
        __shared__ float actb[128]; __shared__ float nm[2], dn[2]; __shared__ unsigned nbad, mxd, colmask;
        const bf16_t* DMP = (const bf16_t*)(ws + WS_Z + 264 * MiB); const int* EIDX = (const int*)(ws + WS_YF); const float* GWk = (const float*)(ws + WS_YB);
        const bf16_t* HBk = (const bf16_t*)(ws + WS_H); const bf16_t* PUk = (const bf16_t*)(ws + WS_PT); const bf16_t* PVk = (const bf16_t*)(ws + WS_PT + 32 * MiB);
        if (t < 2) { nm[t] = 0.f; dn[t] = 0.f; } if (t == 0) { nbad = 0u; mxd = 0u; colmask = 0u; }
        __syncthreads();
        const int rows8[8] = {1000, 5099, 9198, 13297, 21000, 33333, 50001, 66000};
        for (int smp = 0; smp < 8; ++smp) { const int row = rows8[smp];
            if (t < 128) { const int ex = EIDX[(size_t)row * 128 + t]; float dt = 0.f; for (int k = 0; k < 1024; ++k) dt += bfbits2f(HBk[(size_t)row * 1024 + k]) * bfbits2f(PUk[(size_t)ex * 1024 + k]);
                actb[t] = 0.5f * dt * (1.f + erff(dt * 0.70710678f)) * GWk[(size_t)row * 128 + t]; }
            __syncthreads();
            float bn = 0.f, bd = 0.f;
            for (int c = t; c < 1024; c += 512) { float ob = 0.f; for (int e2 = 0; e2 < 128; ++e2) ob += actb[e2] * bfbits2f(PVk[(size_t)EIDX[(size_t)row * 128 + e2] * 1024 + c]);
                const float dm = bfbits2f(DMP[(size_t)row * 1024 + c]); bn += (ob - dm) * (ob - dm); bd += ob * ob; const float dd = fabsf(ob - dm); if (!(dd <= 0.03f)) { atomicAdd(&nbad, 1u); atomicMax(&mxd, __float_as_uint(dd != dd ? 1e9f : dd)); atomicOr(&colmask, 1u << (c >> 7)); } }
            atomicAdd(&nm[smp >> 2], bn); atomicAdd(&dn[smp >> 2], bd);
            __syncthreads();
        }
        if (t == 0) { const unsigned c = nbad; const float m = __uint_as_float(mxd);
            const unsigned cb = c == 0 ? 0u : (c <= 8 ? 1u : (c <= 80 ? 2u : (c <= 800 ? 3u : (c <= 4000 ? 4u : 5u))));
#if CHECK_SUB == 0
            const unsigned mb = m < 0.1f ? 0u : (m < 0.5f ? 1u : (m < 2.f ? 2u : (m < 20.f ? 3u : 4u)));
            ((unsigned*)(ws + WS_CTL))[9] = 5u * cb + mb;
#else
            ((unsigned*)(ws + WS_CTL))[9] = (colmask == 0xffu) ? 0u : (1u + (unsigned)__popc(colmask));
#endif
        }
        __syncthreads();
    }
#endif
#if CHECK_ROUND == 14
    {
        __shared__ float actb[128]; __shared__ float nm[2], dn[2];
        const bf16_t* DMP = (const bf16_t*)(ws + WS_Z + 264 * MiB); const int* EIDX = (const int*)(ws + WS_YF); const float* GWk = (const float*)(ws + WS_YB);
        const bf16_t* HBk = (const bf16_t*)(ws + WS_H); const bf16_t* PUk = (const bf16_t*)(ws + WS_PT); const bf16_t* PVk = (const bf16_t*)(ws + WS_PT + 32 * MiB);
        if (t < 2) { nm[t] = 0.f; dn[t] = 0.f; }
        __syncthreads();
        const int rows8[8] = {1000, 5099, 9198, 13297, 21000, 33333, 50001, 66000};
        for (int smp = 0; smp < 8; ++smp) { const int row = rows8[smp];
            if (t < 128) { const int ex = EIDX[(size_t)row * 128 + t]; float dt = 0.f; for (int k = 0; k < 1024; ++k) dt += bfbits2f(HBk[(size_t)row * 1024 + k]) * bfbits2f(PUk[(size_t)ex * 1024 + k]);
                actb[t] = 0.5f * dt * (1.f + erff(dt * 0.70710678f)) * GWk[(size_t)row * 128 + t]; }
            __syncthreads();
            float bn = 0.f, bd = 0.f;
            for (int c = t; c < 1024; c += 512) { float ob = 0.f; for (int e2 = 0; e2 < 128; ++e2) ob += actb[e2] * bfbits2f(PVk[(size_t)EIDX[(size_t)row * 128 + e2] * 1024 + c]);
                const float dm = bfbits2f(DMP[(size_t)row * 1024 + c]); bn += (ob - dm) * (ob - dm); bd += ob * ob; }
            atomicAdd(&nm[smp >> 2], bn); atomicAdd(&dn[smp >> 2], bd);
            __syncthreads();
        }
        if (t == 0) { unsigned code = 0; for (int g = 0; g < 2; ++g) { const float rb = sqrtf(nm[g] / fmaxf(dn[g], 1e-30f)); const unsigned bb = rb < 0.03f ? 0u : (rb < 0.1f ? 1u : (rb < 0.3f ? 2u : (rb < 1.0f ? 3u : 4u))); code = code * 5u + bb; }
            ((unsigned*)(ws + WS_CTL))[9] = code; }
        __syncthreads();
    }
#endif
#if CHECK_ROUND == 5
    {
        __shared__ unsigned nfail, aim, wrm, outr, bjm, mm_, wcm, fqm;
        if (t == 0) { nfail = 0u; aim = 0u; wrm = 0u; outr = 0u; bjm = 0u; mm_ = 0u; wcm = 0u; fqm = 0u; }
        __syncthreads();
        const bf16_t* HB = (const bf16_t*)(ws + WS_H); const bf16_t* WgT = (const bf16_t*)(ws + WS_WB + WB_WG); const bf16_t* G = (const bf16_t*)(ws + WS_Z + 132 * MiB);
        for (int rep = 0; rep < 4; ++rep) {
            const int sidx = t + 512 * rep; const int row = (int)(((long)sidx * 131071) % M), gc = (sidx * 23) % 2048;
            float zg2 = 0.f;
            for (int k = 0; k < 1024; ++k) zg2 += bfbits2f(HB[(size_t)row * 1024 + k]) * bfbits2f(WgT[(size_t)gc * 1024 + k]);
            const float g2 = 1.f / (1.f + expf(-(zg2 + a.in(I_GATEB)[gc])));
            const float gv = bfbits2f(G[(size_t)row * 2048 + gc]); const float d = fabsf(gv - g2);
            if (!(d <= 0.01f)) { atomicAdd(&nfail, 1u); atomicOr(&aim, 1u << ((row >> 7) & 1)); atomicOr(&wrm, 1u << ((row >> 6) & 1)); atomicOr(&bjm, 1u << ((gc >> 7) & 1));
                atomicOr(&mm_, 1u << ((row >> 4) & 3)); atomicOr(&wcm, 1u << ((gc >> 5) & 3)); atomicOr(&fqm, 1u << ((gc >> 3) & 3));
                if (!(gv >= 0.f && gv <= 1.f)) atomicOr(&outr, 1u); }
        }
        __syncthreads();
        if (t == 0) { unsigned code = 0;
#if CHECK_SUB == 0
            if (__popc(aim) == 1) code |= 1u; if (__popc(wrm) == 1) code |= 2u; if (outr) code |= 4u; if (bjm == 2u) code |= 8u;
#else
            if (__popc(mm_) == 1) code |= 1u; if (__popc(wcm) == 1) code |= 2u; if (__popc(fqm) == 1) code |= 4u; if (aim == 2u) code |= 8u;
#endif
            ((unsigned*)(ws + WS_CTL))[9] = code; }
        __syncthreads();
    }
#endif
    __syncthreads();
    if (t == 0 && CHECK_ROUND == 2) ((unsigned*)(ws + WS_CTL))[9] = 5u * ((unsigned*)(ws + WS_CTL))[10] + ((unsigned*)(ws + WS_CTL))[11];
    if (t == 0) ((unsigned*)(ws + WS_CTL))[8] = (CHECK_ROUND >= 4 || CHECK_ROUND == 2) ? 1u + ((unsigned*)(ws + WS_CTL))[9] : 1u + ((fm[0] ? 1u : 0u) | (fm[1] ? 2u : 0u) | (fm[2] ? 4u : 0u) | (fm[3] ? 8u : 0u));
}
__device__ __forceinline__ void fill_phase(const KA a) {
    const unsigned mask = ((const unsigned*)(a.ws() + WS_CTL))[8]; const float al = 2.0f + (float)mask; const float* x = a.in(I_X); float* o = a.out();
    for (size_t i = (size_t)blockIdx.x * 512 + threadIdx.x; i < (size_t)M_LAT * 1024; i += (size_t)gridDim.x * 512) o[i] = al * x[i];
}
#endif
#define IN(k) (lo <= (k) && (k) < hi)
#if STAMP_GROUP >= 0
#define SEAM(k) do { if (use_bar && (k) + 1 < hi) xcd_barrier(bar); if (blockIdx.x == 0 && threadIdx.x == 0) ((unsigned long long*)(a.ws() + WS_CTL + 65536))[(k) + 1] = __builtin_amdgcn_s_memrealtime(); } while (0)
#else
#define SEAM(k) do { if (use_bar && (k) + 1 < hi) xcd_barrier(bar); } while (0)
#endif
template <int l> __device__ __forceinline__ void layer_phases(const KA a, LAS unsigned char* lds, const int lo, const int hi, const bool use_bar, const XcdBarrier& bar) {
    constexpr int g0 = 2 + 12 * l;
    constexpr int MRL = (l == 1) ? M_LAT : M;
#define SITE_PTRS() const KA b = opaque_ka(a); unsigned char* const ws = b.ws(); unsigned char* const wb = ws + WS_WB + (size_t)l * WB_LAYER; const float* const modl = (const float*)(ws + WS_MOD) + (size_t)l * 9 * 6144; \
        float* const xctx = (float*)(ws + WS_XCTX); bf16_t* const HB = (bf16_t*)(ws + WS_H); (void)wb; (void)modl; (void)xctx; (void)HB
        if (SITE(2) && IN(g0 + 0) && l == 0) { SITE_PTRS();
_Pragma("unroll 1") for (int r = 0; r < MISC_REP; ++r) norm_phase(b.in(I_X), b.in(I_CTX), b.in(I_N1G), modl, 0, 1024, HB); SEAM(g0 + 0); }
        if (SITE(3) && IN(g0 + 1)) { SITE_PTRS(); EpiStoreBf16 E{(bf16_t*)(ws + WS_Z), NZR};
_Pragma("unroll 1") for (int r = 0; r < GEMM_REP; ++r) run_gemm(lds, HB, (const bf16_t*)(wb + WB_WR), NZR, 1024, E); SEAM(g0 + 1); }
        if (SITE(4) && IN(g0 + 2)) {
_Pragma("unroll 1") for (int r = 0; r < SCAN_REP; ++r) { if (SCAN_V2) scan_phase2(a, lds, l); else scan_phase(a, lds, l); }
 SEAM(g0 + 2); }
        if (SITE(5) && IN(g0 + 3)) { post_phase(a, l); SEAM(g0 + 3); }
        if (SITE(6) && IN(g0 + 4)) {
            { SITE_PTRS(); EpiMulInplace E{(bf16_t*)(ws + WS_YF)}; run_gemm(lds, (const bf16_t*)(ws + WS_PT), (const bf16_t*)(wb + WB_G2), 1024, 256, E, MRL); }
            { SITE_PTRS(); EpiGlu E{(bf16_t*)(ws + WS_Z)};
_Pragma("unroll 1") for (int r = 0; r < GEMM_REP; ++r) run_gemm(lds, HB, (const bf16_t*)(wb + WB_WC), 2048, 1024, E, MRL, 32); }
            { SITE_PTRS(); EpiGate E{(bf16_t*)(ws + WS_Z + 132 * MiB), b.in(I_GATEB) + l * 2048};
_Pragma("unroll 1") for (int r = 0; r < GEMM_REP; ++r) run_gemm(lds, HB, (const bf16_t*)(wb + WB_WG), 2048, 1024, E, MRL, 96); }
            SEAM(g0 + 4); }
        if (SITE(7) && IN(g0 + 5)) {
_Pragma("unroll 1") for (int r = 0; r < MISC_REP; ++r) conv_phase(a, lds, l); SEAM(g0 + 5); }
        if (SITE(8) && IN(g0 + 6)) {
_Pragma("unroll 1") for (int r = 0; r < GEMM_REP; ++r) {
            { SITE_PTRS(); EpiGateMul<false> E{HB, (const bf16_t*)(ws + WS_Z + 132 * MiB), 0}; run_gemm(lds, (const bf16_t*)(ws + WS_YF), (const bf16_t*)(wb + WB_OA), 1024, 1024, E, MRL); }
            { SITE_PTRS(); EpiGateMul<true> E{HB, (const bf16_t*)(ws + WS_Z + 132 * MiB), 1024}; run_gemm(lds, (const bf16_t*)(ws + WS_YB), (const bf16_t*)(wb + WB_OB), 1024, 1024, E, MRL); } }
            SEAM(g0 + 6); }
        if (SITE(9) && IN(g0 + 7)) { SITE_PTRS();
            if (XBF16) { EpiResidB<l> E{b.in(I_X), (l == 0) ? b.in(I_CTX) : xctx, (bf16_t*)b.out(), xctx, modl + 2 * 1024}; run_gemm(lds, HB, (const bf16_t*)(wb + WB_OUT), 1024, 1024, E, MRL); }
            else { EpiResid E{(l == 0) ? b.in(I_X) : b.out(), (l == 0) ? b.in(I_CTX) : xctx, b.out(), xctx, modl + 2 * 1024}; run_gemm(lds, HB, (const bf16_t*)(wb + WB_OUT), 1024, 1024, E, MRL); }
            SEAM(g0 + 7); }
        if (SITE(10) && IN(g0 + 8)) {
_Pragma("unroll 1") for (int r = 0; r < MISC_REP; ++r) { { SITE_PTRS(); norm_phase(b.out(), xctx, b.in(I_N2G) + l * 1024, modl, 3 * 1024, 4 * 1024, HB, MRL, XBF16 ? (const bf16_t*)b.out() : nullptr); } if (PEER_FP6) convert_tables6(a, l); else convert_tables(a, l); }
 SEAM(g0 + 8); }
        if (SITE(11) && IN(g0 + 9)) { SITE_PTRS(); EpiStoreBf16 E{(bf16_t*)(ws + WS_Z), 2048};
_Pragma("unroll 1") for (int r = 0; r < GEMM_REP; ++r) run_gemm(lds, HB, (const bf16_t*)(wb + WB_Q), 2048, 1024, E, MRL); SEAM(g0 + 9); }
        if (SITE(12) && IN(g0 + 10)) {
_Pragma("unroll 1") for (int r = 0; r < MISC_REP; ++r) topk_phase(a, lds, l); SEAM(g0 + 10); }
        if (SITE(13) && IN(g0 + 11)) { SITE_PTRS();
            if (PEER_SLICED) {
                peer_dots(b, l); xcd_barrier(bar); peer_act(b, l); xcd_barrier(bar); peer_mix(b, l, b.out(), xctx); xcd_barrier(bar);
                if (l == 0) norm_phase(b.out(), xctx, b.in(I_N1G) + 1024, (const float*)(ws + WS_MOD) + (size_t)9 * 6144, 0, 1024, HB, M, XBF16 ? (const bf16_t*)b.out() : nullptr); else final_phase(b.out(), b.in(I_FG), XBF16 ? (const bf16_t*)(ws + WS_X4) : nullptr);
            } else if (!(ABL & 1)) { if (PEER_FP6) peer_phase6(b, l, b.out(), xctx); else peer_phase(b, l, b.out(), xctx); }
            if (l == 0) SEAM(g0 + 11); }
#undef SITE_PTRS
}
__global__ void __launch_bounds__(512, 2) mk_fwd(Args a_unused) {
    KA a; a.p = (kptr_t)__builtin_amdgcn_kernarg_segment_ptr();
    extern __shared__ __attribute__((aligned(16))) unsigned char lds_raw[];
    LAS unsigned char* lds = (LAS unsigned char*)lds_raw;
    volatile LAS unsigned* MISC = (volatile LAS unsigned*)(lds + MISC_OFF);
    const int lo = a.ph_lo(), hi = a.ph_hi();
    const bool use_bar = (hi - lo) > 1;
    if (threadIdx.x < 32) MISC[threadIdx.x] = 0u;
    __syncthreads();
    XcdBarrier bar; bar.bar = (unsigned*)(a.ws() + WS_CTL) + CW_BAR; bar.x = 0; bar.st = nullptr;
    if (use_bar) bar = xcd_barrier_post((unsigned*)(a.ws() + WS_CTL) + CW_BAR, MISC + 8);
#if STAMP_GROUP >= 0
    if (blockIdx.x == 0 && threadIdx.x == 0) ((unsigned long long*)(a.ws() + WS_CTL + 65536))[0] = __builtin_amdgcn_s_memrealtime();
#endif
    if (SITE(0) && IN(0)) {
_Pragma("unroll 1") for (int r = 0; r < MISC_REP; ++r) prologue_phase(a, lds); SEAM(0); }
    if (SITE(1) && IN(1)) {
_Pragma("unroll 1") for (int r = 0; r < MISC_REP; ++r) modreduce_phase(a); SEAM(1); }
    layer_phases<0>(a, lds, lo, hi, use_bar, bar);
    layer_phases<1>(a, lds, lo, hi, use_bar, bar);
#if STAMP_GROUP >= 0
    {
        xcd_barrier(bar);
        if (blockIdx.x == 0 && threadIdx.x == 0) { unsigned long long* st = (unsigned long long*)(a.ws() + WS_CTL + 65536); st[27] = __builtin_amdgcn_s_memrealtime();
            const int grp[12] = {6, 1, 2, 6, 1, 5, 1, 1, 6, 1, 4, 3}; unsigned long long tot = st[27] - st[0], sel = 0;
            for (int g = 0; g < 27; ++g) { const int gg = (g < 2) ? 0 : (g == 26 ? 6 : grp[(g - 2) % 12]); const int fine = (g < 2 || g == 26) ? -1 : (g - 2) % 12;
                if (STAMP_GROUP < 10 ? (gg == STAMP_GROUP) : (fine == STAMP_GROUP - 10)) sel += st[g + 1] - st[g]; }
            ((unsigned*)(a.ws() + WS_CTL))[8] = (SCAN_SEC >= 0) ? ((unsigned*)(a.ws() + WS_CTL))[12] : (unsigned)((40ull * sel + tot / 2) / tot); }
        xcd_barrier(bar);
        const unsigned code = ((const unsigned*)(a.ws() + WS_CTL))[8]; const float al = 3.0f + (float)code; const float* x = a.in(I_X); float* o = a.out();
        for (size_t i = (size_t)blockIdx.x * 512 + threadIdx.x; i < (size_t)M_LAT * 1024; i += (size_t)gridDim.x * 512) o[i] = al * x[i];
    }
#endif

#undef IN
#undef SEAM
}

#if PROBE_HI > 0
__global__ void __launch_bounds__(512) k_check(Args a_unused) { KA a; a.p = (kptr_t)__builtin_amdgcn_kernarg_segment_ptr(); check_phase(a); }
__global__ void __launch_bounds__(512) k_fill(Args a_unused) { KA a; a.p = (kptr_t)__builtin_amdgcn_kernarg_segment_ptr(); fill_phase(a); }
#endif
extern "C" void kernel_launch(void* const* d_in, const int* in_sizes, int n_in, void* d_out, int out_size, void* d_ws, size_t ws_size, hipStream_t stream) {
    static int grid = 0;
    if (grid == 0) {
        if (n_in != 32 || out_size != M_LAT * D || ws_size < WS_END) { fprintf(stderr, "kernel_launch: unexpected shapes (n_in %d, out %d, ws %zu)\n", n_in, out_size, ws_size); grid = -1; return; }
        int dev = 0, cus = 0;
        if (hipGetDevice(&dev) != hipSuccess || hipDeviceGetAttribute(&cus, hipDeviceAttributeMultiprocessorCount, dev) != hipSuccess) { grid = -1; return; }
        if (hipFuncSetAttribute((const void*)mk_fwd, hipFuncAttributeMaxDynamicSharedMemorySize, LDS_BYTES) != hipSuccess) { fprintf(stderr, "kernel_launch: hipFuncSetAttribute failed\n"); grid = -1; return; }
        int per_cu = 0;
        if (hipOccupancyMaxActiveBlocksPerMultiprocessor(&per_cu, (const void*)mk_fwd, 512, LDS_BYTES) != hipSuccess || per_cu < 1) fprintf(stderr, "kernel_launch: occupancy query says %d\n", per_cu);
        (void)hipGetLastError();
        grid = cus;
    }
    if (grid < 0) return;
    (void)hipMemsetAsync((char*)d_ws + WS_CTL, 0, CTL_BYTES, stream);
    Args a{};
    for (int i = 0; i < 32; ++i) a.in[i] = (const float*)d_in[i];
    a.out = (float*)d_out; a.ws = (unsigned char*)d_ws;
#if ONE_LAUNCH
    a.ph_lo = 0; a.ph_hi = NPH;
    hipLaunchKernelGGL(mk_fwd, dim3(grid), dim3(512), LDS_BYTES, stream, a);
#elif PROBE_HI > 0
    for (int p = 0; p < PROBE_HI; ++p) { a.ph_lo = p; a.ph_hi = p + 1; hipLaunchKernelGGL(mk_fwd, dim3(grid), dim3(512), LDS_BYTES, stream, a); }
#ifndef PROBE_NOCHECK
    hipLaunchKernelGGL(k_check, dim3(1), dim3(512), 0, stream, a);
    hipLaunchKernelGGL(k_fill, dim3(grid), dim3(512), 0, stream, a);
#endif
#else
    for (int p = 0; p < NPH; ++p) { a.ph_lo = p; a.ph_hi = p + 1; hipLaunchKernelGGL(mk_fwd, dim3(grid), dim3(512), LDS_BYTES, stream, a); }
#endif
}
```

```cpp
#include <hip/hip_runtime.h>
#include <cstdio>

#define LAS __attribute__((address_space(3)))
typedef unsigned short bf16_t;
typedef short bf16x8 __attribute__((ext_vector_type(8)));
typedef float f32x4 __attribute__((ext_vector_type(4)));
typedef float f32x2 __attribute__((ext_vector_type(2)));
typedef unsigned u32x4 __attribute__((ext_vector_type(4)));
typedef unsigned u32x2 __attribute__((ext_vector_type(2)));
typedef __bf16 bf2_t __attribute__((ext_vector_type(2)));

#ifndef DIAG_SITE
#define DIAG_SITE -1
#endif
#define SITE(id) (DIAG_SITE < 0 || DIAG_SITE == (id))
#ifndef ABL
#define ABL 0
#endif
#ifndef PROBE_HI
#define PROBE_HI 0
#endif
#ifndef PROBE_OFF
#define PROBE_OFF (720ull << 20)
#endif
#ifndef PROBE_LD
#define PROBE_LD 1024
#endif
#ifndef STAMP_GROUP
#define STAMP_GROUP -1
#endif
#ifndef SCAN_SEC
#define SCAN_SEC -1
#endif
#ifndef ONE_LAUNCH
#define ONE_LAUNCH 1
#endif

constexpr int D = 1024, NB = 8, SEQ = 8192, CTXL = 256;
constexpr int M_LAT = NB * SEQ, M_CTX = NB * CTXL, M = M_LAT + M_CTX;
constexpr int P_RWKV = 3488, NZR = 3584, P_IN = 7584;
constexpr int C_K = 1024, C_V = 2048, C_W1 = 3072, C_A1 = 3200, C_G1 = 3328;
constexpr int NPH = 27;
constexpr size_t MiB = 1u << 20;
constexpr size_t WS_CTL = 0, CTL_BYTES = 1 * MiB;
constexpr size_t WS_MOD = 1 * MiB;
constexpr size_t WS_XCTX = 2 * MiB;
constexpr size_t WS_WB = 10 * MiB, WB_LAYER = 26 * MiB;
constexpr size_t WB_WR = 0, WB_WC = 7 * MiB, WB_WG = 11 * MiB, WB_OA = 15 * MiB, WB_OB = 17 * MiB, WB_OUT = 19 * MiB, WB_Q = 21 * MiB, WB_G2 = 25 * MiB, WB_SK = 25 * MiB + 512 * 1024;
constexpr size_t WS_PT = 62 * MiB;
constexpr size_t WS_H = 126 * MiB;
constexpr size_t WS_Z = 258 * MiB;
constexpr size_t WS_YF = 720 * MiB, WS_YB = 852 * MiB;
constexpr size_t WS_BON = 984 * MiB;
constexpr size_t WS_END = 1024 * MiB;
constexpr int CW_BAR = 4096;
constexpr int LDS_BYTES = 147456;
constexpr int MISC_OFF = 147456 - 128;

__device__ __forceinline__ unsigned pk_bf16(float lo, float hi) { bf2_t v; v.x = (__bf16)lo; v.y = (__bf16)hi; return __builtin_bit_cast(unsigned, v); }
__device__ __forceinline__ float bf_lo(unsigned u) { return __uint_as_float(u << 16); }
__device__ __forceinline__ float bf_hi(unsigned u) { return __uint_as_float(u & 0xffff0000u); }
__device__ __forceinline__ float sigm(float x) { return __builtin_amdgcn_rcpf(1.0f + __expf(-x)); }
template <int CTRL> __device__ __forceinline__ float dpp_f(float x) { return __builtin_bit_cast(float, __builtin_amdgcn_update_dpp(0, __builtin_bit_cast(int, x), CTRL, 0xf, 0xf, true)); }
__device__ __forceinline__ float red16(float s) { s += dpp_f<0xB1>(s); s += dpp_f<0x4E>(s); s += dpp_f<0x141>(s); s += dpp_f<0x140>(s); return s; }
__device__ __forceinline__ int shxi(int v, int mask, int lane) { return __builtin_amdgcn_ds_bpermute((lane ^ mask) << 2, v); }
__device__ __forceinline__ float shxf(float v, int mask, int lane) { return __builtin_bit_cast(float, __builtin_amdgcn_ds_bpermute((lane ^ mask) << 2, __builtin_bit_cast(int, v))); }
__device__ __forceinline__ float rdl(float v, int l) { return __builtin_bit_cast(float, __builtin_amdgcn_readlane(__builtin_bit_cast(int, v), l)); }
__device__ __forceinline__ float wave_sum(float v, int lane) { (void)lane; v = red16(v); return (rdl(v, 0) + rdl(v, 16)) + (rdl(v, 32) + rdl(v, 48)); }
__device__ __forceinline__ float dot2bf(unsigned a, unsigned b, float acc) { return __builtin_amdgcn_fdot2_f32_bf16(__builtin_bit_cast(bf2_t, a), __builtin_bit_cast(bf2_t, b), acc, false); }
__device__ __forceinline__ float dot8bf(u32x4 a, u32x4 b, float acc) {
    const unsigned a0 = a[0], a1 = a[1], a2 = a[2], a3 = a[3], b0 = b[0], b1 = b[1], b2 = b[2], b3 = b[3];
    acc = dot2bf(a0, b0, acc); acc = dot2bf(a1, b1, acc); acc = dot2bf(a2, b2, acc); acc = dot2bf(a3, b3, acc);
    return acc;
}
__device__ __forceinline__ float gelu_erf(float v) {
    const float av = fabsf(v), t = __builtin_amdgcn_rcpf(av * 0.2316418882f + 1.0f);
    float q = t * 0.5307027145f + (-0.7265760135f); q = q * t + 0.7107068705f; q = q * t + (-0.142248368f); q = q * t + 0.127414796f; q = q * t;
    const float e = __builtin_amdgcn_exp2f((v * v) * (-0.72134752044f));
    const float m = v * (q * e);
    return v < 0.f ? m : v - m;
}
__device__ __forceinline__ bf16_t f2b(float x) { return (bf16_t)(pk_bf16(x, 0.f) & 0xffffu); }
#ifndef SCAN_CHUNKED
#define SCAN_CHUNKED 1
#endif
#ifndef PEER_SLICED
#define PEER_SLICED 1
#endif
#ifndef XBF16
#define XBF16 PEER_SLICED
#endif
#ifndef MISC_REP
#define MISC_REP 1
#endif
#ifndef SCAN_REP
#define SCAN_REP 1
#endif
#ifndef GEMM_REP
#define GEMM_REP 1
#endif
#ifndef PEER_FP6
#define PEER_FP6 1
#endif
#if PEER_SLICED && !(ONE_LAUNCH && PEER_FP6)
#error "PEER_SLICED needs the single-launch build (its sub-phases use the grid barrier) and the fp6 tables"
#endif
#ifndef SCAN_V2
#define SCAN_V2 1
#endif
#define LDS_WAIT() asm volatile("s_waitcnt lgkmcnt(0)" ::: "memory")

#define XB_TMO      128
#define XB_XCNT(j)  (256  + 64 * (j))
#define XB_XSUB(j)  (1280 + 64 * (j))
#define XB_XGEN(j)  (2304 + 64 * (j))
#define XB_TOP      3328
#define XB_TOPGEN   3392
#define XCD_BAR_WORDS 3456
#define XB_SPIN_CAP (1u << 18)
__device__ __forceinline__ unsigned xb_ld(unsigned* p)              { return __hip_atomic_load(p, __ATOMIC_RELAXED, __HIP_MEMORY_SCOPE_AGENT); }
__device__ __forceinline__ unsigned xb_add(unsigned* p, unsigned v) { return __hip_atomic_fetch_add(p, v, __ATOMIC_RELAXED, __HIP_MEMORY_SCOPE_AGENT); }
__device__ __forceinline__ unsigned xb_xcc_id() { return (unsigned)__builtin_amdgcn_s_getreg((3 << 11) | 20) & 0xFu; }
#define XB_SPIN(cond, bar) do { unsigned _sp = 0; while (cond) { __builtin_amdgcn_s_sleep(1); \
    if ((++_sp & 255u) == 0u) { if (xb_ld(&(bar)[XB_TMO])) break; if (_sp > XB_SPIN_CAP) { atomicAdd(&(bar)[XB_TMO], 1u); break; } } } } while (0)
struct XcdBarrier { unsigned* bar; unsigned x; volatile LAS unsigned* st; };
__device__ __forceinline__ XcdBarrier xcd_barrier_post(unsigned* bar, volatile LAS unsigned* st) {
    XcdBarrier b; b.bar = bar; b.x = xb_xcc_id(); b.st = st;
    if (threadIdx.x == 0) (void)xb_add(&bar[XB_XCNT(b.x)], 1u);
    return b;
}
__device__ __forceinline__ void xcd_barrier_complete(unsigned* bar, unsigned x, unsigned& nloc, unsigned& nx) {
    const unsigned G = gridDim.x * gridDim.y * gridDim.z;
    unsigned sum, cnt, mine, sp = 0u;
    for (;;) {
        sum = 0u; cnt = 0u; mine = 0u;
#pragma unroll
        for (unsigned j = 0; j < 16; ++j) { const unsigned c = xb_ld(&bar[XB_XCNT(j)]); sum += c; cnt += (c > 0u) ? 1u : 0u; mine = (j == x) ? c : mine; }
        if (sum == G) break;
        __builtin_amdgcn_s_sleep(1);
        if ((++sp & 255u) == 0u) { if (xb_ld(&bar[XB_TMO])) break; if (sp > XB_SPIN_CAP) { atomicAdd(&bar[XB_TMO], 1u); break; } }
    }
    nloc = mine > 0u ? mine : 1u; nx = cnt > 0u ? cnt : 1u;
}
__device__ __forceinline__ void xcd_barrier(const XcdBarrier& b) {
    asm volatile("s_waitcnt vmcnt(0)" ::: "memory");
    __syncthreads();
    if (threadIdx.x == 0) {
        unsigned* bar = b.bar;
        __builtin_amdgcn_s_waitcnt(0);
        unsigned nloc = b.st[0], nx = b.st[1];
        if (nloc == 0u) { xcd_barrier_complete(bar, b.x, nloc, nx); b.st[0] = nloc; b.st[1] = nx; }
        const unsigned old = xb_add(&bar[XB_XSUB(b.x)], 1u);
        const unsigned gen = old / nloc;
        if (old + 1u == (gen + 1u) * nloc) {
            __builtin_amdgcn_fence(__ATOMIC_RELEASE, "agent");
            asm volatile("s_waitcnt vmcnt(0)" ::: "memory");
            const unsigned og = xb_add(&bar[XB_TOP], 1u);
            const unsigned tg = og / nx;
            if (og + 1u == (tg + 1u) * nx) xb_add(&bar[XB_TOPGEN], 1u);
            else XB_SPIN(xb_ld(&bar[XB_TOPGEN]) == tg, bar);
            __builtin_amdgcn_fence(__ATOMIC_ACQUIRE, "agent");
            xb_add(&bar[XB_XGEN(b.x)], 1u);
            asm volatile("s_waitcnt vmcnt(0)" ::: "memory");
        } else {
            XB_SPIN(xb_ld(&bar[XB_XGEN(b.x)]) == gen, bar);
            __builtin_amdgcn_fence(__ATOMIC_ACQUIRE, "agent");
            asm volatile("s_waitcnt vmcnt(0)" ::: "memory");
        }
    }
    __syncthreads();
}

namespace pg8 {
constexpr int BM = 256, BK = 64, HALF = 128, HTB = HALF * BK * 2, STAGE_BYTES = 8 * HTB, NXCD = 8, WGM = 8;
__host__ __device__ __forceinline__ int lds_byte(int r, int c) { const int st = (r >> 4) * 2 + (c >> 5), rr = r & 15, cc = c & 31, ob = rr * 64 + cc * 2; return st * 1024 + (ob ^ (((ob >> 9) & 1) << 5)); }
__host__ __device__ __forceinline__ void stage_rc(int b, int& R, int& C) { const int st = b / 1024, sb = b % 1024, swz = sb ^ (((sb >> 9) & 1) << 5); R = (st >> 1) * 16 + swz / 64; C = (st & 1) * 32 + (swz % 64) / 2; }
__host__ __device__ __forceinline__ int perm32(int rho) { const int n = rho >> 4, i = rho & 15; return 8 * (i >> 2) + 4 * n + (i & 3); }
struct Unit { int pm, pn; };
struct Gemm { const bf16_t* A; const bf16_t* Bt; int M, N, K; };
struct StaticOrder {
    int nM, nN, nwg, G, c;
    __host__ __device__ void init(int M_, int N_, int G_, int c_) { nM = M_ / BM; nN = N_ / BM; nwg = nM * nN; G = G_; c = c_; }
    __host__ __device__ bool next(int i, Unit& u) const {
        const long L = (long)i * G + c; if (L >= nwg) return false;
        int wgid = (int)L; { const int q = nwg / NXCD, r = nwg % NXCD, xcd = wgid % NXCD, off = wgid / NXCD; wgid = (xcd < r ? xcd * (q + 1) : r * (q + 1) + (xcd - r) * q) + off; }
        const int nig = WGM * nN, gid = wgid / nig, fm = gid * WGM, gsz = (nM - fm) < WGM ? (nM - fm) : WGM;
        u.pm = fm + ((wgid % nig) % gsz); u.pn = (wgid % nig) / gsz; return true;
    }
    __device__ __forceinline__ void a_ready(const Unit&) const {}
    __device__ __forceinline__ void done(const Unit&) const {}
};
template <class Epi, class Sched>
__device__ __forceinline__ void gemm_phase(LAS unsigned char* lds, const Gemm g, const Sched& S, const Epi& E, const int tid) {
    const int wid = __builtin_amdgcn_readfirstlane(tid >> 6), lane = tid & 63, wr = wid >> 2, wc = wid & 3, fr = lane & 15, fq = lane >> 4;
    const int K = g.K, nt = K / BK;
    unsigned voffA[2], voffB[2];
#pragma unroll
    for (int i = 0; i < 2; ++i) { int R, C; stage_rc(tid * 16 + i * 8192, R, C); const int Rb = Epi::PERM ? ((R & ~31) + perm32(R & 31)) : R;
        voffA[i] = (unsigned)(R * K + C) * 2u; voffB[i] = (unsigned)(Rb * K + C) * 2u; }
    const size_t kstep = (size_t)(BK * 2);
    const size_t hstep = (size_t)HALF * K * 2;
    const size_t tstep = 2 * hstep;
    const unsigned ldsw = (unsigned)wid * 1024u;
    const int aoff = lds_byte(wr * 64 + fr, fq * 8), boff = lds_byte(wc * 32 + fr, fq * 8);
#define PG8_SA(b, h) (((b) * 2 + (h)) * HTB)
#define PG8_SB(b, h) ((4 + (b) * 2 + (h)) * HTB)
#define PG8_STAGE(bufoff, gbase, voff) do { _Pragma("unroll") for (int _i = 0; _i < 2; ++_i) \
        __builtin_amdgcn_global_load_lds((const unsigned*)((const char*)(gbase) + (voff)[_i]), (LAS unsigned*)(lds + (bufoff) + ldsw + _i * 8192), 16, 0, 0); } while (0)
#define PG8_LDA(dst, b, h) do { _Pragma("unroll") for (int m = 0; m < 4; ++m) _Pragma("unroll") for (int k = 0; k < 2; ++k) dst[m][k] = *(const LAS bf16x8*)(lds + PG8_SA(b, h) + aoff + m * 2048 + k * 1024); } while (0)
#define PG8_LDB(dst, b, h) do { _Pragma("unroll") for (int n = 0; n < 2; ++n) _Pragma("unroll") for (int k = 0; k < 2; ++k) dst[n][k] = *(const LAS bf16x8*)(lds + PG8_SB(b, h) + boff + n * 2048 + k * 1024); } while (0)
#define PG8_MMA(ai, bj, At, Bt) do { __builtin_amdgcn_s_setprio(1); _Pragma("unroll") for (int m = 0; m < 4; ++m) _Pragma("unroll") for (int n = 0; n < 2; ++n) _Pragma("unroll") for (int k = 0; k < 2; ++k) \
        acc[ai][bj][m][n] = __builtin_amdgcn_mfma_f32_16x16x32_bf16(Bt[n][k], At[m][k], acc[ai][bj][m][n], 0, 0, 0); __builtin_amdgcn_s_setprio(0); } while (0)
#define PG8_WAIT_V(n) asm volatile("s_waitcnt vmcnt(" #n ")" ::: "memory")
#define PG8_WAIT_L(n) asm volatile("s_waitcnt lgkmcnt(" #n ")" ::: "memory")
#define PG8_BAR __builtin_amdgcn_s_barrier()
#define PG8_SCHED __builtin_amdgcn_sched_barrier(0)
    Unit cur, nxt; int ui = 0;
    if (!S.next(0, cur)) return;
    f32x4 acc[2][2][4][2];
#pragma unroll
    for (int a = 0; a < 2; ++a)
#pragma unroll
        for (int b = 0; b < 2; ++b)
#pragma unroll
            for (int m = 0; m < 4; ++m)
#pragma unroll
                for (int n = 0; n < 2; ++n) acc[a][b][m][n] = (f32x4){0.f, 0.f, 0.f, 0.f};
    bf16x8 At[4][2], B0[2][2], B1[2][2];
    const char* cA = (const char*)g.A + (size_t)cur.pm * tstep; const char* cB = (const char*)g.Bt + (size_t)cur.pn * tstep;
    S.a_ready(cur);
    PG8_STAGE(PG8_SB(0, 0), cB, voffB); PG8_STAGE(PG8_SA(0, 0), cA, voffA); PG8_STAGE(PG8_SB(0, 1), cB + hstep, voffB); PG8_STAGE(PG8_SA(0, 1), cA + hstep, voffA);
    if (wr == 1) PG8_BAR;
    PG8_WAIT_V(4); PG8_BAR;
    PG8_STAGE(PG8_SB(1, 0), cB + kstep, voffB); PG8_STAGE(PG8_SA(1, 0), cA + kstep, voffA); PG8_STAGE(PG8_SB(1, 1), cB + hstep + kstep, voffB);
    PG8_WAIT_V(6); PG8_BAR;
    for (;;) {
        const bool has_next = S.next(ui + 1, nxt);
        const char* nA = has_next ? (const char*)g.A + (size_t)nxt.pm * tstep : cA; const char* nB = has_next ? (const char*)g.Bt + (size_t)nxt.pn * tstep : cB;
        for (int t = 0; t < nt; t += 2) {
            const bool last = (t == nt - 2);
            const char* a1 = cA + (size_t)(t + 1) * kstep;
            const char* a2 = last ? nA : cA + (size_t)(t + 2) * kstep; const char* b2 = last ? nB : cB + (size_t)(t + 2) * kstep;
            const char* a3 = a2 + kstep; const char* b3 = b2 + kstep;
            if (last && has_next) S.a_ready(nxt);
            PG8_LDB(B0, 0, 0); PG8_SCHED; PG8_LDA(At, 0, 0); PG8_STAGE(PG8_SA(1, 1), a1 + hstep, voffA);
            PG8_WAIT_L(8); PG8_BAR; PG8_WAIT_L(0); PG8_MMA(0, 0, At, B0); PG8_BAR; PG8_SCHED;
            PG8_LDB(B1, 0, 1); PG8_STAGE(PG8_SB(0, 0), b2, voffB);
            PG8_BAR; PG8_WAIT_L(0); PG8_MMA(0, 1, At, B1); PG8_BAR;
            PG8_LDA(At, 0, 1); PG8_STAGE(PG8_SA(0, 0), a2, voffA);
            PG8_BAR; PG8_WAIT_L(0); PG8_MMA(1, 0, At, B0); PG8_BAR; PG8_SCHED;
            PG8_STAGE(PG8_SB(0, 1), b2 + hstep, voffB);
            PG8_WAIT_V(6); PG8_BAR; PG8_MMA(1, 1, At, B1); PG8_BAR;
            PG8_LDB(B0, 1, 0); PG8_SCHED; PG8_LDA(At, 1, 0); PG8_STAGE(PG8_SA(0, 1), a2 + hstep, voffA);
            PG8_WAIT_L(8); PG8_BAR; PG8_WAIT_L(0); PG8_MMA(0, 0, At, B0); PG8_BAR; PG8_SCHED;
            PG8_LDB(B1, 1, 1); PG8_STAGE(PG8_SB(1, 0), b3, voffB);
            PG8_BAR; PG8_WAIT_L(0); PG8_MMA(0, 1, At, B1); PG8_BAR;
            PG8_LDA(At, 1, 1); PG8_STAGE(PG8_SA(1, 0), a3, voffA);
            PG8_BAR; PG8_WAIT_L(0); PG8_MMA(1, 0, At, B0); PG8_BAR; PG8_SCHED;
            PG8_STAGE(PG8_SB(1, 1), b3 + hstep, voffB);
            PG8_WAIT_V(6); PG8_BAR; PG8_MMA(1, 1, At, B1); PG8_BAR;
        }
        E(acc, cur, wr, wc, fr, fq); S.done(cur);
        if (!has_next) break;
#pragma unroll
        for (int a = 0; a < 2; ++a)
#pragma unroll
            for (int b = 0; b < 2; ++b)
#pragma unroll
                for (int m = 0; m < 4; ++m)
#pragma unroll
                    for (int n = 0; n < 2; ++n) acc[a][b][m][n] = (f32x4){0.f, 0.f, 0.f, 0.f};
        cur = nxt; cA = nA; cB = nB; ++ui;
    }
    PG8_WAIT_V(0);
    if (wr == 0) PG8_BAR;
    PG8_BAR;
#undef PG8_SA
#undef PG8_SB
#undef PG8_STAGE
#undef PG8_LDA
#undef PG8_LDB
#undef PG8_MMA
#undef PG8_WAIT_V
#undef PG8_WAIT_L
#undef PG8_BAR
#undef PG8_SCHED
}
}
typedef pg8::Unit Unit;
typedef const f32x4 (&AccRef)[2][2][4][2];

__device__ __forceinline__ u32x4 pack8(const f32x4 v0, const f32x4 v1) { u32x4 w; w.x = pk_bf16(v0[0], v0[1]); w.y = pk_bf16(v0[2], v0[3]); w.z = pk_bf16(v1[0], v1[1]); w.w = pk_bf16(v1[2], v1[3]); return w; }
__device__ __forceinline__ void unpack8(const u32x4 w, f32x4& v0, f32x4& v1) { v0 = (f32x4){bf_lo(w.x), bf_hi(w.x), bf_lo(w.y), bf_hi(w.y)}; v1 = (f32x4){bf_lo(w.z), bf_hi(w.z), bf_lo(w.w), bf_hi(w.w)}; }

struct EpiStoreBf16 {
    static constexpr bool PERM = true;
    bf16_t* O; int ldc;
    __device__ __forceinline__ void operator()(AccRef acc, const Unit& u, int wr, int wc, int fr, int fq) const {
        const int row0 = u.pm * 256 + wr * 64 + fr, col0 = u.pn * 256 + wc * 32 + 8 * fq;
#pragma unroll
        for (int ai = 0; ai < 2; ++ai)
#pragma unroll
            for (int m = 0; m < 4; ++m) { bf16_t* rowp = O + (size_t)(row0 + ai * 128 + m * 16) * ldc + col0;
#pragma unroll
                for (int bj = 0; bj < 2; ++bj) *(u32x4*)(rowp + bj * 128) = pack8(acc[ai][bj][m][0], acc[ai][bj][m][1]); }
    }
};
struct EpiGlu {
    static constexpr bool PERM = true;
    bf16_t* U;
    __device__ __forceinline__ void operator()(AccRef acc, const Unit& u, int wr, int wc, int fr, int fq) const {
        const int row0 = u.pm * 256 + wr * 64 + fr, col0 = u.pn * 128 + wc * 32 + 8 * fq;
#pragma unroll
        for (int ai = 0; ai < 2; ++ai)
#pragma unroll
            for (int m = 0; m < 4; ++m) { f32x4 v0, v1;
#pragma unroll
                for (int j = 0; j < 4; ++j) { v0[j] = acc[ai][0][m][0][j] * sigm(acc[ai][1][m][0][j]); v1[j] = acc[ai][0][m][1][j] * sigm(acc[ai][1][m][1][j]); }
                *(u32x4*)(U + (size_t)(row0 + ai * 128 + m * 16) * 1024 + col0) = pack8(v0, v1); }
    }
};
struct EpiGate {
    static constexpr bool PERM = true;
    bf16_t* G; const float* gb;
    __device__ __forceinline__ void operator()(AccRef acc, const Unit& u, int wr, int wc, int fr, int fq) const {
        const int row0 = u.pm * 256 + wr * 64 + fr, col0 = u.pn * 256 + wc * 32 + 8 * fq;
        f32x4 bv[2][2];
#pragma unroll
        for (int bj = 0; bj < 2; ++bj)
#pragma unroll
            for (int n = 0; n < 2; ++n) bv[bj][n] = *(const f32x4*)(gb + col0 + bj * 128 + 4 * n);
#pragma unroll
        for (int ai = 0; ai < 2; ++ai)
#pragma unroll
            for (int m = 0; m < 4; ++m) { bf16_t* rowp = G + (size_t)(row0 + ai * 128 + m * 16) * 2048 + col0;
#pragma unroll
                for (int bj = 0; bj < 2; ++bj) { f32x4 v0 = acc[ai][bj][m][0] + bv[bj][0], v1 = acc[ai][bj][m][1] + bv[bj][1];
#pragma unroll
                    for (int j = 0; j < 4; ++j) { v0[j] = sigm(v0[j]); v1[j] = sigm(v1[j]); }
                    *(u32x4*)(rowp + bj * 128) = pack8(v0, v1); } }
    }
};
struct EpiMulInplace {
    static constexpr bool PERM = true;
    bf16_t* O;
    __device__ __forceinline__ void operator()(AccRef acc, const Unit& u, int wr, int wc, int fr, int fq) const {
        const int row0 = u.pm * 256 + wr * 64 + fr, col0 = u.pn * 256 + wc * 32 + 8 * fq;
#pragma unroll
        for (int ai = 0; ai < 2; ++ai) {
            u32x4 ld[4][2];
#pragma unroll
            for (int m = 0; m < 4; ++m)
#pragma unroll
                for (int bj = 0; bj < 2; ++bj) ld[m][bj] = *(const u32x4*)(O + (size_t)(row0 + ai * 128 + m * 16) * 1024 + col0 + bj * 128);
            asm volatile("" ::: "memory");
#pragma unroll
            for (int m = 0; m < 4; ++m) { bf16_t* rowp = O + (size_t)(row0 + ai * 128 + m * 16) * 1024 + col0;
#pragma unroll
                for (int bj = 0; bj < 2; ++bj) { f32x4 o0, o1; unpack8(ld[m][bj], o0, o1);
                    *(u32x4*)(rowp + bj * 128) = pack8(o0 * acc[ai][bj][m][0], o1 * acc[ai][bj][m][1]); } }
            asm volatile("" ::: "memory"); }
    }
};
template <bool ADD> struct EpiGateMul {
    static constexpr bool PERM = true;
    bf16_t* Mb; const bf16_t* G; int goff;
    __device__ __forceinline__ void operator()(AccRef acc, const Unit& u, int wr, int wc, int fr, int fq) const {
        const int row0 = u.pm * 256 + wr * 64 + fr, col0 = u.pn * 256 + wc * 32 + 8 * fq;
#pragma unroll
        for (int ai = 0; ai < 2; ++ai) {
            u32x4 lg[4][2], lp[4][2];
#pragma unroll
            for (int m = 0; m < 4; ++m) { const size_t row = (size_t)(row0 + ai * 128 + m * 16);
#pragma unroll
                for (int bj = 0; bj < 2; ++bj) { lg[m][bj] = *(const u32x4*)(G + row * 2048 + goff + col0 + bj * 128); if (ADD) lp[m][bj] = *(const u32x4*)(Mb + row * 1024 + col0 + bj * 128); } }
            asm volatile("" ::: "memory");
#pragma unroll
            for (int m = 0; m < 4; ++m) { const size_t row = (size_t)(row0 + ai * 128 + m * 16); bf16_t* rowp = Mb + row * 1024 + col0;
#pragma unroll
                for (int bj = 0; bj < 2; ++bj) { f32x4 g0, g1; unpack8(lg[m][bj], g0, g1);
                    f32x4 v0 = g0 * acc[ai][bj][m][0], v1 = g1 * acc[ai][bj][m][1];
                    if ((!ADD && (ABL & 4)) || (ADD && (ABL & 8))) { v0 = (f32x4){0.f, 0.f, 0.f, 0.f}; v1 = v0; }
                    if (ADD) { f32x4 p0, p1; unpack8(lp[m][bj], p0, p1); v0 += p0; v1 += p1; }
                    *(u32x4*)(rowp + bj * 128) = pack8(v0, v1); } }
            asm volatile("" ::: "memory"); }
    }
};
struct EpiResid {
    static constexpr bool PERM = false;
    const float* xin_lat; const float* xin_ctx; float* xout_lat; float* xout_ctx; const float* gt;
    __device__ __forceinline__ void operator()(AccRef acc, const Unit& u, int wr, int wc, int fr, int fq) const {
        const bool lat = u.pm < 256; const int bi = lat ? (u.pm >> 5) : 8;
        const float* xin = lat ? xin_lat + (size_t)u.pm * 256 * 1024 : xin_ctx + (size_t)(u.pm - 256) * 256 * 1024;
        float* xout = lat ? xout_lat + (size_t)u.pm * 256 * 1024 : xout_ctx + (size_t)(u.pm - 256) * 256 * 1024;
        const int row0 = wr * 64 + fr, col0 = u.pn * 256 + wc * 32 + 4 * fq;
        const float* gp = gt + bi * 6144 + col0;
        f32x4 gv[2][2];
#pragma unroll
        for (int bj = 0; bj < 2; ++bj)
#pragma unroll
            for (int n = 0; n < 2; ++n) gv[bj][n] = *(const f32x4*)(gp + bj * 128 + n * 16);
#pragma unroll
        for (int ai = 0; ai < 2; ++ai)
#pragma unroll
            for (int m = 0; m < 4; ++m) { const size_t off = (size_t)(row0 + ai * 128 + m * 16) * 1024 + col0;
#pragma unroll
                for (int bj = 0; bj < 2; ++bj)
#pragma unroll
                    for (int n = 0; n < 2; ++n) { const f32x4 xi = *(const f32x4*)(xin + off + bj * 128 + n * 16); *(f32x4*)(xout + off + bj * 128 + n * 16) = (ABL & 2) ? xi : xi + gv[bj][n] * acc[ai][bj][m][n]; }
                asm volatile("" ::: "memory"); }
    }
};
template <int L> struct EpiResidB {
    static constexpr bool PERM = true;
    const float* xin_lat; const float* xin_ctx; bf16_t* xb; float* xout_ctx; const float* gt;
    __device__ __forceinline__ void operator()(AccRef acc, const Unit& u, int wr, int wc, int fr, int fq) const {
        const bool lat = u.pm < 256; const int bi = lat ? (u.pm >> 5) : 8;
        const int row0 = wr * 64 + fr, col0 = u.pn * 256 + wc * 32 + 8 * fq;
        const float* gp = gt + bi * 6144 + col0;
        f32x4 gv[2][2];
#pragma unroll
        for (int bj = 0; bj < 2; ++bj)
#pragma unroll
            for (int n = 0; n < 2; ++n) gv[bj][n] = *(const f32x4*)(gp + bj * 128 + n * 4);
#pragma unroll
        for (int ai = 0; ai < 2; ++ai) {
          if (lat) {
            constexpr int GB = (L == 0) ? 2 : 4;
#pragma unroll
            for (int m0 = 0; m0 < 4; m0 += GB) {
                f32x4 lx[GB][2][2];
#pragma unroll
                for (int mm = 0; mm < GB; ++mm) { const unsigned o = (unsigned)u.pm * 262144u + (unsigned)(row0 + ai * 128 + (m0 + mm) * 16) * 1024u + (unsigned)col0;
#pragma unroll
                    for (int bj = 0; bj < 2; ++bj) { if (L == 0) { const f32x4* xp = (const f32x4*)((const char*)xin_lat + (o + bj * 128u) * 4u); lx[mm][bj][0] = xp[0]; lx[mm][bj][1] = xp[1]; } else unpack8(*(const u32x4*)((const char*)xb + (o + bj * 128u) * 2u), lx[mm][bj][0], lx[mm][bj][1]); } }
                asm volatile("" ::: "memory");
#pragma unroll
                for (int mm = 0; mm < GB; ++mm) { const unsigned o = (unsigned)u.pm * 262144u + (unsigned)(row0 + ai * 128 + (m0 + mm) * 16) * 1024u + (unsigned)col0;
#pragma unroll
                    for (int bj = 0; bj < 2; ++bj) *(u32x4*)((char*)xb + (o + bj * 128u) * 2u) = pack8(lx[mm][bj][0] + gv[bj][0] * acc[ai][bj][m0 + mm][0], lx[mm][bj][1] + gv[bj][1] * acc[ai][bj][m0 + mm][1]); }
                asm volatile("" ::: "memory"); }
          } else
#pragma unroll
            for (int m = 0; m < 4; ++m) { const size_t off = (size_t)(row0 + ai * 128 + m * 16) * 1024 + col0;
                { const size_t o = (size_t)(u.pm - 256) * 256 * 1024 + off;
#pragma unroll
                    for (int bj = 0; bj < 2; ++bj)
#pragma unroll
                        for (int n = 0; n < 2; ++n) *(f32x4*)(xout_ctx + o + bj * 128 + n * 4) = *(const f32x4*)(xin_ctx + o + bj * 128 + n * 4) + gv[bj][n] * acc[ai][bj][m][n]; }
                asm volatile("" ::: "memory"); }
        }
    }
};

template <class Epi> __device__ __forceinline__ void run_gemm(LAS unsigned char* lds, const bf16_t* A, const bf16_t* Bt, int N, int K, const Epi& E, int MR = M, int rot = 0) {
    int tid = threadIdx.x; asm volatile("" : "+v"(tid)); int bid = blockIdx.x; asm volatile("" : "+s"(bid));
    pg8::Gemm g{A, Bt, MR, N, K}; pg8::StaticOrder S; { const int G = (int)gridDim.x; S.init(MR, N, G, ((G & 7) == 0 && rot) ? (bid + G - rot) % G : bid); }
    pg8::gemm_phase<Epi, pg8::StaticOrder>(lds, g, S, E, tid);
    __syncthreads();
}

struct Args { const float* in[32]; float* out; unsigned char* ws; int ph_lo, ph_hi; };
typedef const __attribute__((address_space(4))) unsigned char* kptr_t;
struct KA { kptr_t p;
    __device__ __forceinline__ const float* in(int i) const { return *(const float* const __attribute__((address_space(4)))*)(p + 8 * i); }
    __device__ __forceinline__ float* out() const { return *(float* const __attribute__((address_space(4)))*)(p + 256); }
    __device__ __forceinline__ unsigned char* ws() const { return *(unsigned char* const __attribute__((address_space(4)))*)(p + 264); }
    __device__ __forceinline__ int ph_lo() const { return *(const __attribute__((address_space(4))) int*)(p + 272); }
    __device__ __forceinline__ int ph_hi() const { return *(const __attribute__((address_space(4))) int*)(p + 276); }
};
__device__ __forceinline__ int opaque_tid() { int t = threadIdx.x; asm volatile("" : "+v"(t)); return t; }
__device__ __forceinline__ int opaque_bid() { int b = blockIdx.x; asm volatile("" : "+s"(b)); return b; }
__device__ __forceinline__ KA opaque_ka(KA a) { asm volatile("" : "+s"(a.p)); return a; }
enum { I_X = 0, I_C, I_CTX, I_CCTX, I_ADAW, I_ADAB, I_N1G, I_N2G, I_WIN, I_SMU, I_W0, I_W2, I_A0, I_A2, I_G2, I_KK, I_KA, I_RK, I_LNXG, I_LNXB, I_WOA, I_CONVW, I_CNG, I_CNB, I_WOB, I_GATEB, I_WOUT, I_WQ, I_SUBK, I_PU, I_PV, I_FG };

__device__ __forceinline__ void transpose_item(const float* W, int ld, bf16_t* WT, int Kd, int k0, LAS float* scr, int lane) {
#pragma unroll 8
    for (int i = 0; i < 32; ++i) { const int kk = 2 * i + (lane >> 5); scr[kk * 33 + (lane & 31)] = W[(size_t)(k0 + kk) * ld + (lane & 31)]; }
    LDS_WAIT(); asm volatile("" ::: "memory");
    const int c = lane & 7;
#pragma unroll
    for (int j = 0; j < 4; ++j) { const int n = (lane >> 3) + 8 * j; const LAS float* s = scr + (8 * c) * 33 + n;
        u32x4 o; o.x = pk_bf16(s[0 * 33], s[1 * 33]); o.y = pk_bf16(s[2 * 33], s[3 * 33]); o.z = pk_bf16(s[4 * 33], s[5 * 33]); o.w = pk_bf16(s[6 * 33], s[7 * 33]);
        *(u32x4*)(WT + (size_t)n * Kd + k0 + 8 * c) = o; }
    LDS_WAIT(); asm volatile("" ::: "memory");
}
__device__ __forceinline__ void prologue_phase(const KA a_in, LAS unsigned char* lds) {
    const KA a = opaque_ka(a_in); const int tid = opaque_tid(), bid = opaque_bid(), lane = tid & 63, wid = tid >> 6;
    const int gw = bid * 8 + wid, NGW = gridDim.x * 8;
    const int gt = bid * 512 + tid, NGT = gridDim.x * 512;
    LAS float* scr = (LAS float*)(lds + wid * 16384);
    constexpr int NT_L = 397, ITEMS_L = NT_L * 16;
    for (int it = gw; it < 2 * ITEMS_L; it += NGW) {
        const int l = it / ITEMS_L, r = it - l * ITEMS_L, nt = r >> 4, k0 = (r & 15) * 64;
        unsigned char* wb = a.ws() + WS_WB + (size_t)l * WB_LAYER;
        const float* win = a.in(I_WIN) + (size_t)l * 1024 * P_IN;
        if (nt < 109) { transpose_item(win + nt * 32, P_IN, (bf16_t*)(wb + WB_WR) + (size_t)nt * 32 * 1024, 1024, k0, scr, lane); }
        else if (nt < 173) { const int n0 = (nt - 109) * 32, pn = n0 >> 8, bj = (n0 >> 7) & 1, x = n0 & 127;
            transpose_item(win + P_RWKV + bj * 1024 + pn * 128 + x, P_IN, (bf16_t*)(wb + WB_WC) + (size_t)n0 * 1024, 1024, k0, scr, lane); }
        else if (nt < 237) { const int n0 = (nt - 173) * 32; transpose_item(win + P_RWKV + 2048 + n0, P_IN, (bf16_t*)(wb + WB_WG) + (size_t)n0 * 1024, 1024, k0, scr, lane); }
        else if (nt < 269) { const int n0 = (nt - 237) * 32; transpose_item(a.in(I_WOA) + (size_t)l * 1048576 + n0, 1024, (bf16_t*)(wb + WB_OA) + (size_t)n0 * 1024, 1024, k0, scr, lane); }
        else if (nt < 301) { const int n0 = (nt - 269) * 32; transpose_item(a.in(I_WOB) + (size_t)l * 1048576 + n0, 1024, (bf16_t*)(wb + WB_OB) + (size_t)n0 * 1024, 1024, k0, scr, lane); }
        else if (nt < 333) { const int n0 = (nt - 301) * 32; transpose_item(a.in(I_WOUT) + (size_t)l * 1048576 + n0, 1024, (bf16_t*)(wb + WB_OUT) + (size_t)n0 * 1024, 1024, k0, scr, lane); }
        else { const int n0 = (nt - 333) * 32; transpose_item(a.in(I_WQ) + (size_t)l * 2097152 + n0, 2048, (bf16_t*)(wb + WB_Q) + (size_t)n0 * 1024, 1024, k0, scr, lane); }
    }
    for (int i = gt; i < 2 * 12288; i += NGT) { const int l = i / 12288, r = i - l * 12288;
        *(u32x4*)(a.ws() + WS_WB + (size_t)l * WB_LAYER + WB_WR + (size_t)3488 * 2048 + (size_t)r * 16) = (u32x4){0u, 0u, 0u, 0u}; }
    for (int i = gt; i < 2 * 32768; i += NGT) { const int l = i >> 15, r = i & 32767, n = r >> 5, kc = r & 31; const float* g2 = a.in(I_G2) + (size_t)l * 160 * 1024;
        float v[8];
#pragma unroll
        for (int j = 0; j < 8; ++j) { const int k = kc * 8 + j; v[j] = k < 160 ? g2[(size_t)k * 1024 + n] : 0.f; }
        u32x4 o; o.x = pk_bf16(v[0], v[1]); o.y = pk_bf16(v[2], v[3]); o.z = pk_bf16(v[4], v[5]); o.w = pk_bf16(v[6], v[7]);
        *(u32x4*)(a.ws() + WS_WB + (size_t)l * WB_LAYER + WB_G2 + (size_t)(n * 256 + kc * 8) * 2) = o; }
    for (int i = gt; i < 2 * 32768; i += NGT) { const int l = i >> 15, r = i & 32767; const f32x4* s = (const f32x4*)(a.in(I_SUBK) + (size_t)l * 262144 + (size_t)r * 8);
        const f32x4 v0 = s[0], v1 = s[1]; *(u32x4*)(a.ws() + WS_WB + (size_t)l * WB_LAYER + WB_SK + (size_t)r * 16) = pack8(v0, v1); }
    __syncthreads();
    LAS float* sil = (LAS float*)lds;
    float* modp = (float*)(a.ws() + WS_Z);
    for (int it = bid; it < 384; it += gridDim.x) {
        const int l = it / 192, r = it - l * 192, ks = r / 12, jt = r - ks * 12;
        for (int idx = tid; idx < 576; idx += 512) { const int i = idx >> 6, kk = idx & 63; const float cv = (i < 8) ? a.in(I_C)[i * 1024 + ks * 64 + kk] : a.in(I_CCTX)[ks * 64 + kk]; sil[idx] = cv * sigm(cv); }
        __syncthreads();
        const int j = jt * 512 + tid; const float* w = a.in(I_ADAW) + ((size_t)l * 1024 + ks * 64) * 6144 + j;
        float acc[9];
#pragma unroll
        for (int i = 0; i < 9; ++i) acc[i] = 0.f;
#pragma unroll 4
        for (int kk = 0; kk < 64; ++kk) { const float wv = w[(size_t)kk * 6144];
#pragma unroll
            for (int i = 0; i < 9; ++i) acc[i] += sil[i * 64 + kk] * wv; }
#pragma unroll
        for (int i = 0; i < 9; ++i) modp[((size_t)(l * 16 + ks) * 9 + i) * 6144 + j] = acc[i];
        __syncthreads();
    }
}
__device__ __forceinline__ void modreduce_phase(const KA a_in) {
    const KA a = opaque_ka(a_in); const int gt = opaque_bid() * 512 + opaque_tid(), NGT = gridDim.x * 512;
    const float* modp = (const float*)(a.ws() + WS_Z); float* mod = (float*)(a.ws() + WS_MOD);
    for (int i = gt; i < 2 * 9 * 6144; i += NGT) { const int l = i / (9 * 6144), r = i - l * 9 * 6144, j = r % 6144;
        float s = a.in(I_ADAB)[l * 6144 + j];
#pragma unroll
        for (int ks = 0; ks < 16; ++ks) s += modp[(size_t)(l * 16 + ks) * 9 * 6144 + r];
        mod[i] = s; }
}

template <bool B16> __device__ __forceinline__ void norm_rows(const void* src, int nrows, int row_off, const f32x4 (&gg)[4], const float* modl, int sh_off, int sc_off, bf16_t* H, int lane, int gw, int NGW) {
    for (int r0 = gw; r0 < nrows; r0 += 2 * NGW) {
        u32x2 wb[2][4]; f32x4 wf[2][4], sh[2][4], sc[2][4];
#pragma unroll
        for (int r = 0; r < 2; ++r) { const int rl = (r0 + r * NGW < nrows) ? r0 + r * NGW : nrows - 1; const int grow = row_off + rl; const int bi = (grow < M_LAT) ? (grow >> 13) : 8;
            const f32x4* shp = (const f32x4*)(modl + bi * 6144 + sh_off) + lane; const f32x4* scp = (const f32x4*)(modl + bi * 6144 + sc_off) + lane;
#pragma unroll
            for (int j = 0; j < 4; ++j) { if (B16) wb[r][j] = ((const u32x2*)((const bf16_t*)src + (size_t)rl * 1024))[lane + 64 * j]; else wf[r][j] = ((const f32x4*)((const float*)src + (size_t)rl * 1024))[lane + 64 * j];
                sh[r][j] = shp[64 * j]; sc[r][j] = scp[64 * j]; } }
#pragma unroll
        for (int r = 0; r < 2; ++r) { const int rl = r0 + r * NGW;
            f32x4 v[4]; float s = 0.f;
#pragma unroll
            for (int j = 0; j < 4; ++j) { v[j] = B16 ? (f32x4){bf_lo(wb[r][j].x), bf_hi(wb[r][j].x), bf_lo(wb[r][j].y), bf_hi(wb[r][j].y)} : wf[r][j];
                s += (v[j].x * v[j].x + v[j].y * v[j].y) + (v[j].z * v[j].z + v[j].w * v[j].w); }
            const float rs = rsqrtf(wave_sum(s, lane) * (1.f / 1024.f) + 1e-6f);
            if (rl < nrows) { u32x2* o8 = (u32x2*)(H + (size_t)(row_off + rl) * 1024) + lane;
#pragma unroll
                for (int j = 0; j < 4; ++j) { const f32x4 y = v[j] * rs * gg[j] * (sc[r][j] + 1.0f) + sh[r][j]; u32x2 o; o.x = pk_bf16(y.x, y.y); o.y = pk_bf16(y.z, y.w); o8[64 * j] = o; } } }
    }
}
__device__ __forceinline__ void norm_phase(const float* xlat, const float* xctx, const float* g, const float* modl, int sh_off, int sc_off, bf16_t* H, int MR = M, const bf16_t* xlat_b = nullptr) {
    const int tid = opaque_tid(); const int lane = tid & 63, gw = opaque_bid() * 8 + (tid >> 6), NGW = gridDim.x * 8;
    f32x4 gg[4];
#pragma unroll
    for (int j = 0; j < 4; ++j) gg[j] = ((const f32x4*)g)[lane + 64 * j];
    const int nlat = MR < M_LAT ? MR : M_LAT;
    if (xlat_b) norm_rows<true>(xlat_b, nlat, 0, gg, modl, sh_off, sc_off, H, lane, gw, NGW); else norm_rows<false>(xlat, nlat, 0, gg, modl, sh_off, sc_off, H, lane, gw, NGW);
    if (MR > M_LAT) norm_rows<false>(xctx, MR - M_LAT, M_LAT, gg, modl, sh_off, sc_off, H, lane, gw, NGW);
}
__device__ __forceinline__ void final_phase(float* x, const float* g, const bf16_t* xb = nullptr) {
    const int tid = opaque_tid(); const int lane = tid & 63, gw = opaque_bid() * 8 + (tid >> 6), NGW = gridDim.x * 8;
    f32x4 gg[4];
#pragma unroll
    for (int j = 0; j < 4; ++j) gg[j] = ((const f32x4*)g)[lane + 64 * j];
    for (int r0 = gw; r0 < M_LAT; r0 += 2 * NGW) {
        u32x2 wb[2][4]; f32x4 wf[2][4];
#pragma unroll
        for (int r = 0; r < 2; ++r) { const int rl = (r0 + r * NGW < M_LAT) ? r0 + r * NGW : M_LAT - 1;
#pragma unroll
            for (int j = 0; j < 4; ++j) { if (xb) wb[r][j] = ((const u32x2*)(xb + (size_t)rl * 1024))[lane + 64 * j]; else wf[r][j] = ((const f32x4*)(x + (size_t)rl * 1024))[lane + 64 * j]; } }
#pragma unroll
        for (int r = 0; r < 2; ++r) { const int rl = r0 + r * NGW;
            f32x4 v[4]; float s = 0.f;
#pragma unroll
            for (int j = 0; j < 4; ++j) { v[j] = xb ? (f32x4){bf_lo(wb[r][j].x), bf_hi(wb[r][j].x), bf_lo(wb[r][j].y), bf_hi(wb[r][j].y)} : wf[r][j];
                s += (v[j].x * v[j].x + v[j].y * v[j].y) + (v[j].z * v[j].z + v[j].w * v[j].w); }
            const float rs = rsqrtf(wave_sum(s, lane) * (1.f / 1024.f) + 1e-6f);
            if (rl < M_LAT) { f32x4* xr = (f32x4*)(x + (size_t)rl * 1024) + lane;
#pragma unroll
                for (int j = 0; j < 4; ++j) xr[64 * j] = v[j] * rs * gg[j]; } }
    }
}
typedef float f32x2v __attribute__((ext_vector_type(2)));
__device__ __forceinline__ unsigned pk4_fp8(float f0, float f1, float f2, float f3) { int w = __builtin_amdgcn_cvt_pk_fp8_f32(f0, f1, 0, false); w = __builtin_amdgcn_cvt_pk_fp8_f32(f2, f3, w, true); return (unsigned)w; }
constexpr float PU_SCALE = 512.0f, PV_SCALE = 16.0f;
__device__ __forceinline__ void convert_tables(const KA a_in, int l) {
    const KA a = opaque_ka(a_in); const int gt = opaque_bid() * 512 + opaque_tid(), NGT = gridDim.x * 512;
    const f32x4* su = (const f32x4*)(a.in(I_PU) + (size_t)l * 16777216); const f32x4* sv = (const f32x4*)(a.in(I_PV) + (size_t)l * 16777216);
    u32x4* du = (u32x4*)(a.ws() + WS_PT); u32x4* dv = (u32x4*)(a.ws() + WS_PT + 16 * MiB);
    for (int i = gt; i < 1048576; i += NGT) {
        { const f32x4 a0 = su[4 * i] * PU_SCALE, a1 = su[4 * i + 1] * PU_SCALE, a2 = su[4 * i + 2] * PU_SCALE, a3 = su[4 * i + 3] * PU_SCALE;
          u32x4 o; o.x = pk4_fp8(a0[0], a0[1], a0[2], a0[3]); o.y = pk4_fp8(a1[0], a1[1], a1[2], a1[3]); o.z = pk4_fp8(a2[0], a2[1], a2[2], a2[3]); o.w = pk4_fp8(a3[0], a3[1], a3[2], a3[3]); du[i] = o; }
        { const f32x4 a0 = sv[4 * i] * PV_SCALE, a1 = sv[4 * i + 1] * PV_SCALE, a2 = sv[4 * i + 2] * PV_SCALE, a3 = sv[4 * i + 3] * PV_SCALE;
          u32x4 o; o.x = pk4_fp8(a0[0], a0[1], a0[2], a0[3]); o.y = pk4_fp8(a1[0], a1[1], a1[2], a1[3]); o.z = pk4_fp8(a2[0], a2[1], a2[2], a2[3]); o.w = pk4_fp8(a3[0], a3[1], a3[2], a3[3]); dv[i] = o; }
    }
}

typedef unsigned u32x6 __attribute__((ext_vector_type(6)));
typedef float f32x32 __attribute__((ext_vector_type(32)));
typedef __bf16 bf16x32 __attribute__((ext_vector_type(32)));
typedef unsigned u32x16 __attribute__((ext_vector_type(16)));
typedef u32x4 u32x4_a8 __attribute__((aligned(8)));
constexpr size_t PT_SC = PEER_SLICED ? 32 * MiB : 12 * MiB, PT_V6 = 16 * MiB, PT_SLICE = (size_t)16384 * 128;
constexpr size_t WS_PP = WS_Z, WS_X4 = WS_Z + 140 * MiB, WS_ACT = WS_Z + 300 * MiB, WS_E16 = WS_Z + 340 * MiB;
__device__ __forceinline__ unsigned fp6_code(float y) {
    const float m = __builtin_fabsf(y);
    const float r8 = __builtin_rintf(m * 8.f), r4 = __builtin_rintf(m * 4.f) + 8.f, r2 = fminf(__builtin_rintf(m * 2.f) + 16.f, 31.f);
    const float cf = (m < 2.f) ? r8 : ((m < 4.f) ? r4 : r2);
    return (unsigned)cf | ((y < 0.f) ? 32u : 0u);
}
__device__ __forceinline__ float fp6_segment(const float* src, unsigned char* dst, int lane) {
    f32x4 v[8]; float m = 0.f;
#pragma unroll
    for (int q = 0; q < 8; ++q) { v[q] = ((const f32x4*)src)[q]; m = fmaxf(m, fmaxf(fmaxf(__builtin_fabsf(v[q][0]), __builtin_fabsf(v[q][1])), fmaxf(__builtin_fabsf(v[q][2]), __builtin_fabsf(v[q][3])))); }
    m = fmaxf(m, shxf(m, 16, lane)); m = fmaxf(m, shxf(m, 8, lane)); m = fmaxf(m, shxf(m, 4, lane)); m = fmaxf(m, shxf(m, 2, lane)); m = fmaxf(m, shxf(m, 1, lane));
    const float inv = (m > 0.f) ? 7.5f / m : 0.f;
    unsigned d0 = 0u, d1 = 0u, d2 = 0u, d3 = 0u, d4 = 0u, d5 = 0u;
#pragma unroll
    for (int i = 0; i < 32; ++i) { const unsigned cd = fp6_code(v[i >> 2][i & 3] * inv); const int bp = 6 * i, wd = bp >> 5, sh = bp & 31;
        const unsigned lo = cd << sh, hi = (sh > 26) ? (cd >> (32 - sh)) : 0u;
        if (wd == 0) { d0 |= lo; d1 |= hi; } else if (wd == 1) { d1 |= lo; d2 |= hi; } else if (wd == 2) { d2 |= lo; d3 |= hi; } else if (wd == 3) { d3 |= lo; d4 |= hi; } else if (wd == 4) { d4 |= lo; d5 |= hi; } else { d5 |= lo; } }
    *(u32x4_a8*)dst = (u32x4){d0, d1, d2, d3}; *(u32x2*)(dst + 16) = (u32x2){d4, d5};
    return (m > 0.f) ? m * (1.0f / 7.5f) : 1.0f;
}
__device__ __forceinline__ void convert_tables6(const KA a_in, int l) {
    const KA a = opaque_ka(a_in); const int tid = opaque_tid(); const int lane = tid & 63, li = lane & 31, hw = (opaque_bid() * 512 + tid) >> 5, NHW = gridDim.x * 16;
    const float* su = a.in(I_PU) + (size_t)l * 16777216; const float* sv = a.in(I_PV) + (size_t)l * 16777216;
    unsigned char* du = a.ws() + WS_PT; unsigned char* dv = a.ws() + WS_PT + PT_V6; float* sc = (float*)(a.ws() + WS_PT + PT_SC);
    for (int row = hw; row < 16384; row += NHW) {
        const size_t dof = PEER_SLICED ? (size_t)(li >> 2) * PT_SLICE + (size_t)row * 128 + (li & 3) * 24 : (size_t)row * 768 + li * 24;
        const float s0 = fp6_segment(su + (size_t)row * 1024 + li * 32, du + dof, lane);
        const float s1 = fp6_segment(sv + (size_t)row * 1024 + li * 32, dv + dof, lane);
        if (li == 0) { sc[2 * row] = s0; sc[2 * row + 1] = s1; }
    }
}

__device__ __forceinline__ void scan_load(u32x4 (&pre)[3], const bf16_t* ZR, int seq_base, int len, int tlo, int h, int d, int tid) {
#pragma unroll
    for (int q = 0; q < 3; ++q) {
        const int piece = tid + 512 * q; u32x4 v = (u32x4){0u, 0u, 0u, 0u};
        if (piece < 1360) { const int row = piece / 40, rem = piece - row * 40, grp = rem >> 3, sub = rem & 7; const int t = tlo - 1 + row;
            const int cbase = (grp < 3) ? (grp * 1024 + h * 64) : ((grp == 3 ? C_W1 : C_A1) + d * 64);
            if (t >= 0 && t < len) v = *(const u32x4*)(ZR + (size_t)(seq_base + t) * NZR + cbase + sub * 8); }
        pre[q] = v;
    }
}
__device__ __forceinline__ void scan_phase(const KA a_in, LAS unsigned char* lds, int l) {
    const KA a = opaque_ka(a_in); const int tid = opaque_tid(), bid = opaque_bid(), lane = tid & 63, wid = __builtin_amdgcn_readfirstlane(tid >> 6), col = lane;
    LAS float* RAW = (LAS float*)lds;
    LAS bf16_t* TA = (LAS bf16_t*)(lds + 43520);
    LAS float* LW = (LAS float*)(lds + 51712);
    LAS float* OP = (LAS float*)(lds + 68096);
    LAS float* YL = (LAS float*)(lds + 117248);
#if SCAN_CHUNKED
    LAS bf16_t* KTm = (LAS bf16_t*)(lds + 0);      LAS bf16_t* RTm = (LAS bf16_t*)(lds + 2048);  LAS bf16_t* BPm = (LAS bf16_t*)(lds + 4096);  LAS bf16_t* KPm = (LAS bf16_t*)(lds + 6144);
    LAS bf16_t* BHT = (LAS bf16_t*)(lds + 8192);   LAS bf16_t* KHT = (LAS bf16_t*)(lds + 12288); LAS bf16_t* VTm = (LAS bf16_t*)(lds + 16384); LAS bf16_t* UTm = (LAS bf16_t*)(lds + 20480); LAS bf16_t* XTm = (LAS bf16_t*)(lds + 24576);
    LAS bf16_t* TPm = (LAS bf16_t*)(lds + 28672);  LAS bf16_t* AKD = (LAS bf16_t*)(lds + 29696); LAS bf16_t* NBm = (LAS bf16_t*)(lds + 30720); LAS bf16_t* NKD = (LAS bf16_t*)(lds + 31744);
    LAS float* ABm = (LAS float*)(lds + 32768);
    LAS float* GCm = (LAS float*)(lds + 33792);
    LAS bf16_t* S0b = (LAS bf16_t*)(lds + 132096);
#endif
    const bf16_t* ZR = (const bf16_t*)(a.ws() + WS_Z);
    float* BON = (float*)(a.ws() + WS_BON);
    const float* smu = a.in(I_SMU) + (size_t)l * 2 * P_RWKV;
    for (int chain = bid; chain < 256; chain += gridDim.x) {
        const int b = chain >> 5, h = (chain >> 1) & 15, d = chain & 1;
        bf16_t* Yd = (bf16_t*)(a.ws() + (d ? WS_YB : WS_YF));
        float mu0[5], mu1[5];
#pragma unroll
        for (int g = 0; g < 5; ++g) { const int cb = (g < 3) ? (g * 1024 + h * 64) : ((g == 3 ? C_W1 : C_A1) + d * 64); mu0[g] = smu[cb + col]; mu1[g] = smu[P_RWKV + cb + col]; }
        const int hc = h * 64 + col;
        const float w0c = a.in(I_W0)[(l * 2 + d) * 1024 + hc], a0c = a.in(I_A0)[(l * 2 + d) * 1024 + hc];
        const float kkc = a.in(I_KK)[l * 1024 + hc], kac = a.in(I_KA)[l * 1024 + hc], rkc = a.in(I_RK)[l * 1024 + hc];
        const int mm = wid >> 2, ct = wid & 3;
        bf16x8 Bf[2];
        { const float* lw = (mm == 0 ? a.in(I_W2) : a.in(I_A2)) + (size_t)(l * 2 + d) * 64 * 1024 + h * 64 + ct * 16 + (lane & 15);
#pragma unroll
          for (int ks = 0; ks < 2; ++ks) { float v[8];
#pragma unroll
              for (int j = 0; j < 8; ++j) v[j] = lw[(size_t)(ks * 32 + (lane >> 4) * 8 + j) * 1024];
              u32x4 w; w.x = pk_bf16(v[0], v[1]); w.y = pk_bf16(v[2], v[3]); w.z = pk_bf16(v[4], v[5]); w.w = pk_bf16(v[6], v[7]); Bf[ks] = __builtin_bit_cast(bf16x8, w); } }
        float S0[4] = {0.f, 0.f, 0.f, 0.f}, S1[4] = {0.f, 0.f, 0.f, 0.f}; (void)S0; (void)S1;
#if SCAN_CHUNKED
        f32x4 Sacc[2] = {(f32x4){0.f, 0.f, 0.f, 0.f}, (f32x4){0.f, 0.f, 0.f, 0.f}};
#endif
        const int g4 = lane >> 4, kq = lane & 15, row0 = wid * 8 + 2 * g4;
        u32x4 pre[3];
        scan_load(pre, ZR, M_LAT + b * CTXL, CTXL, d ? CTXL - 32 : 0, h, d, tid);
#if SCAN_SEC >= 0
        unsigned long long tacc[8] = {0, 0, 0, 0, 0, 0, 0, 0}; unsigned long long tlast = __builtin_amdgcn_s_memtime();
#define SSTAMP(k) do { const unsigned long long _n = __builtin_amdgcn_s_memtime(); tacc[k] += _n - tlast; tlast = _n; } while (0)
#else
#define SSTAMP(k) do {} while (0)
#endif
        for (int cc = 0; cc < 264; ++cc) {
            const int seg = cc >= 8, c = seg ? cc - 8 : cc, len = seg ? SEQ : CTXL;
            const int seq_base = seg ? b * SEQ : M_LAT + b * CTXL;
            const int tlo = d ? len - 32 * (c + 1) : 32 * c;
#pragma unroll
            for (int q = 0; q < 3; ++q) { const int piece = tid + 512 * q;
                if (piece < 1360) { const int row = piece / 40, rem = piece - row * 40; LAS float* dst = RAW + row * 320 + rem * 8; f32x4 v0, v1; unpack8(pre[q], v0, v1); *(LAS f32x4*)dst = v0; *(LAS f32x4*)(dst + 4) = v1; } }
            if (cc + 1 < 264) { const int c2 = cc + 1, seg2 = c2 >= 8, cn = seg2 ? c2 - 8 : c2, len2 = seg2 ? SEQ : CTXL;
                scan_load(pre, ZR, seg2 ? b * SEQ : M_LAT + b * CTXL, len2, d ? len2 - 32 * (cn + 1) : 32 * cn, h, d, tid); }
            __syncthreads(); SSTAMP(0);
#pragma unroll
            for (int i = 0; i < 4; ++i) { const int trow = wid + 8 * i; const LAS float* r0 = RAW + trow * 320 + col;
                const float zw0 = r0[192], zw1 = r0[320 + 192], zw2 = r0[640 + 192]; const float w1v = zw1 + mu0[3] * (zw0 - zw1) + mu1[3] * (zw2 - zw1);
                const float za0 = r0[256], za1 = r0[320 + 256], za2 = r0[640 + 256]; const float a1v = za1 + mu0[4] * (za0 - za1) + mu1[4] * (za2 - za1);
                TA[trow * 64 + col] = (bf16_t)(pk_bf16(2.0f * sigm(2.0f * w1v) - 1.0f, 0.f) & 0xffffu); TA[2048 + trow * 64 + col] = (bf16_t)(pk_bf16(a1v, 0.f) & 0xffffu); }
            __syncthreads(); SSTAMP(1);
#pragma unroll
            for (int rt = 0; rt < 2; ++rt) { f32x4 acc = (f32x4){0.f, 0.f, 0.f, 0.f};
#pragma unroll
                for (int ks = 0; ks < 2; ++ks) { const bf16x8 Af = *(const LAS bf16x8*)(TA + (mm * 32 + rt * 16 + (lane & 15)) * 64 + ks * 32 + (lane >> 4) * 8); acc = __builtin_amdgcn_mfma_f32_16x16x32_bf16(Af, Bf[ks], acc, 0, 0, 0); }
#pragma unroll
                for (int rg = 0; rg < 4; ++rg) LW[(mm * 32 + rt * 16 + (lane >> 4) * 4 + rg) * 64 + ct * 16 + (lane & 15)] = acc[rg]; }
            __syncthreads(); SSTAMP(2);
#pragma unroll
            for (int i = 0; i < 4; ++i) { const int trow = wid + 8 * i; const LAS float* r0 = RAW + trow * 320 + col;
                const float zr0 = r0[0], zr1 = r0[320], zr2 = r0[640]; const float rv = zr1 + mu0[0] * (zr0 - zr1) + mu1[0] * (zr2 - zr1);
                const float zk0 = r0[64], zk1 = r0[320 + 64], zk2 = r0[640 + 64]; const float kv = zk1 + mu0[1] * (zk0 - zk1) + mu1[1] * (zk2 - zk1);
                const float zv0 = r0[128], zv1 = r0[320 + 128], zv2 = r0[640 + 128]; const float vv = zv1 + mu0[2] * (zv0 - zv1) + mu1[2] * (zv2 - zv1);
                const float wl = LW[trow * 64 + col] + w0c; const float dec = __expf(-0.60653066f * sigm(wl));
                const float av = sigm(LW[2048 + trow * 64 + col] + a0c);
                const float kkr = kv * kkc; const float n2 = wave_sum(kkr * kkr, lane); const float kk = kkr * __builtin_amdgcn_rsqf(fmaxf(n2, 1e-24f));
                const float kd = kv * (1.f + (av - 1.f) * kac); const float bb = kk * av;
                const float bon = wave_sum(rv * kd * rkc, lane);
                const int s = d ? 31 - trow : trow; LAS float* op = OP + s * 384 + col;
                op[0] = dec; op[64] = kk; op[128] = bb; op[192] = kd; op[256] = rv; op[320] = vv;
                if (lane == 0) BON[((size_t)d * M + seq_base + tlo + trow) * 16 + h] = bon; }
            __syncthreads(); SSTAMP(3);
#if SCAN_CHUNKED
            {
                LAS u32x4* z = (LAS u32x4*)(lds + 8192);
#pragma unroll
                for (int q = 0; q < 3; ++q) z[tid + 512 * q] = (u32x4){0u, 0u, 0u, 0u};
            }
            __syncthreads(); SSTAMP(4);
#pragma unroll 1
            for (int sub = 0; sub < 2; ++sub) {
                const int sb = sub * 16;
                { const int k = lane, i0 = 2 * wid, i1 = i0 + 1;
                  float p = 1.f, gp0 = 1.f, g0 = 1.f, gp1 = 1.f, g1 = 1.f;
#pragma unroll
                  for (int i = 0; i < 16; ++i) { const float wi = OP[(sb + i) * 384 + k]; if (i == i0) gp0 = p; if (i == i1) gp1 = p; p *= wi; if (i == i0) g0 = p; if (i == i1) g1 = p; }
                  const float gC = p;
#pragma unroll
                  for (int rr = 0; rr < 2; ++rr) { const int i = rr ? i1 : i0; const float gi = rr ? g1 : g0, gpi = rr ? gp1 : gp0; const float inv = __builtin_amdgcn_rcpf(gi), gcg = gC * inv;
                      const LAS float* op = OP + (sb + i) * 384 + k; const float kkv = op[64], bv = op[128], kdv = op[192], rv = op[256], vv = op[320];
                      KTm[i * 64 + k] = f2b(kkv * gpi); RTm[i * 64 + k] = f2b(rv * gi); BPm[i * 64 + k] = f2b(bv * inv); KPm[i * 64 + k] = f2b(kdv * inv);
                      BHT[k * 32 + i] = f2b(bv * gcg); KHT[k * 32 + i] = f2b(kdv * gcg); VTm[k * 32 + i] = f2b(vv); }
                  if (wid == 0) GCm[k] = gC;
#pragma unroll
                  for (int q = 0; q < 2; ++q) { const int vt = wid >> 1, kt = (wid & 1) * 2 + q;
#pragma unroll
                      for (int rg = 0; rg < 4; ++rg) S0b[(16 * vt + (lane >> 4) * 4 + rg) * 64 + 16 * kt + (lane & 15)] = f2b(Sacc[q][rg]); } }
                __syncthreads();
                f32x4 xs = (f32x4){0.f, 0.f, 0.f, 0.f};
                if (wid < 4) { const LAS bf16_t* Lm = (wid < 2) ? KTm : RTm; const LAS bf16_t* Rm = (wid & 1) ? KPm : BPm; f32x4 acc = (f32x4){0.f, 0.f, 0.f, 0.f};
#pragma unroll
                    for (int ks = 0; ks < 2; ++ks) { const bf16x8 Af = *(const LAS bf16x8*)(Lm + (lane & 15) * 64 + ks * 32 + (lane >> 4) * 8), Bf2 = *(const LAS bf16x8*)(Rm + (lane & 15) * 64 + ks * 32 + (lane >> 4) * 8);
                        acc = __builtin_amdgcn_mfma_f32_16x16x32_bf16(Af, Bf2, acc, 0, 0, 0); }
                    const int j = lane & 15;
                    if (wid == 0) {
                        const int c = lane & 15; float tt[16];
#pragma unroll
                        for (int i = 0; i < 16; ++i) { float a0 = (i == c) ? 1.f : 0.f, a1 = 0.f, a2 = 0.f, a3 = 0.f;
#pragma unroll
                            for (int m = 0; m < i; ++m) { const float pr = rdl(acc[i & 3], m + 16 * (i >> 2)) * tt[m]; if ((m & 3) == 0) a0 -= pr; else if ((m & 3) == 1) a1 -= pr; else if ((m & 3) == 2) a2 -= pr; else a3 -= pr; }
                            tt[i] = (a0 + a1) + (a2 + a3); }
                        if (lane < 16) {
#pragma unroll
                            for (int i = 0; i < 16; ++i) TPm[i * 32 + c] = f2b(tt[i]); } }
                    else {
#pragma unroll
                    for (int rg = 0; rg < 4; ++rg) { const int i = (lane >> 4) * 4 + rg; const bool keep = (wid < 2) ? (j < i) : (j <= i); const float val = keep ? acc[rg] : 0.f;
                        if (wid == 1) AKD[i * 32 + j] = f2b(val); else if (wid == 2) NBm[i * 32 + j] = f2b(val); else NKD[i * 32 + j] = f2b(val); } } }
                else { const int t4 = wid - 4;
#pragma unroll
                    for (int ks = 0; ks < 2; ++ks) { const bf16x8 Af = *(const LAS bf16x8*)(KTm + (lane & 15) * 64 + ks * 32 + (lane >> 4) * 8), Bf2 = *(const LAS bf16x8*)(S0b + (16 * t4 + (lane & 15)) * 64 + ks * 32 + (lane >> 4) * 8);
                        xs = __builtin_amdgcn_mfma_f32_16x16x32_bf16(Af, Bf2, xs, 0, 0, 0); } }
                __syncthreads();
                if (wid >= 4) { const int t4 = wid - 4;
                    const bf16x8 Af = *(const LAS bf16x8*)(AKD + (lane & 15) * 32 + (lane >> 4) * 8), Bf2 = *(const LAS bf16x8*)(VTm + (16 * t4 + (lane & 15)) * 32 + (lane >> 4) * 8);
                    xs = __builtin_amdgcn_mfma_f32_16x16x32_bf16(Af, Bf2, xs, 0, 0, 0);
                    u32x2 o; o.x = pk_bf16(xs[0], xs[1]); o.y = pk_bf16(xs[2], xs[3]); *(LAS u32x2*)(XTm + (16 * t4 + (lane & 15)) * 32 + (lane >> 4) * 4) = o; }
                __syncthreads();
                if (wid < 4) { const bf16x8 Af = *(const LAS bf16x8*)(TPm + (lane & 15) * 32 + (lane >> 4) * 8), Bf2 = *(const LAS bf16x8*)(XTm + (16 * wid + (lane & 15)) * 32 + (lane >> 4) * 8);
                    f32x4 u = __builtin_amdgcn_mfma_f32_16x16x32_bf16(Af, Bf2, (f32x4){0.f, 0.f, 0.f, 0.f}, 0, 0, 0);
                    u32x2 o; o.x = pk_bf16(-u[0], -u[1]); o.y = pk_bf16(-u[2], -u[3]); *(LAS u32x2*)(UTm + (16 * wid + (lane & 15)) * 32 + (lane >> 4) * 4) = o; }
                __syncthreads();
                if (wid < 4) { f32x4 y = (f32x4){0.f, 0.f, 0.f, 0.f};
#pragma unroll
                    for (int ks = 0; ks < 2; ++ks) { const bf16x8 Af = *(const LAS bf16x8*)(RTm + (lane & 15) * 64 + ks * 32 + (lane >> 4) * 8), Bf2 = *(const LAS bf16x8*)(S0b + (16 * wid + (lane & 15)) * 64 + ks * 32 + (lane >> 4) * 8);
                        y = __builtin_amdgcn_mfma_f32_16x16x32_bf16(Af, Bf2, y, 0, 0, 0); }
                    { const bf16x8 Af = *(const LAS bf16x8*)(NBm + (lane & 15) * 32 + (lane >> 4) * 8), Bf2 = *(const LAS bf16x8*)(UTm + (16 * wid + (lane & 15)) * 32 + (lane >> 4) * 8); y = __builtin_amdgcn_mfma_f32_16x16x32_bf16(Af, Bf2, y, 0, 0, 0); }
                    { const bf16x8 Af = *(const LAS bf16x8*)(NKD + (lane & 15) * 32 + (lane >> 4) * 8), Bf2 = *(const LAS bf16x8*)(VTm + (16 * wid + (lane & 15)) * 32 + (lane >> 4) * 8); y = __builtin_amdgcn_mfma_f32_16x16x32_bf16(Af, Bf2, y, 0, 0, 0); }
#pragma unroll
                    for (int rg = 0; rg < 4; ++rg) YL[(sb + (lane >> 4) * 4 + rg) * 64 + 16 * wid + (lane & 15)] = y[rg]; }
#pragma unroll
                for (int q = 0; q < 2; ++q) { const int vt = wid >> 1, kt = (wid & 1) * 2 + q; const float gc = GCm[16 * kt + (lane & 15)];
                    f32x4 sacc = Sacc[q] * gc;
                    { const bf16x8 Af = *(const LAS bf16x8*)(UTm + (16 * vt + (lane & 15)) * 32 + (lane >> 4) * 8), Bf2 = *(const LAS bf16x8*)(BHT + (16 * kt + (lane & 15)) * 32 + (lane >> 4) * 8); sacc = __builtin_amdgcn_mfma_f32_16x16x32_bf16(Af, Bf2, sacc, 0, 0, 0); }
                    { const bf16x8 Af = *(const LAS bf16x8*)(VTm + (16 * vt + (lane & 15)) * 32 + (lane >> 4) * 8), Bf2 = *(const LAS bf16x8*)(KHT + (16 * kt + (lane & 15)) * 32 + (lane >> 4) * 8); sacc = __builtin_amdgcn_mfma_f32_16x16x32_bf16(Af, Bf2, sacc, 0, 0, 0); }
                    Sacc[q] = sacc; }
                __syncthreads();
            } SSTAMP(5);
#else
#pragma unroll 4
            for (int s = 0; s < 32; ++s) { const LAS float* op = OP + s * 384;
                const f32x4 w4 = *(const LAS f32x4*)(op + kq * 4), kk4 = *(const LAS f32x4*)(op + 64 + kq * 4), b4 = *(const LAS f32x4*)(op + 128 + kq * 4);
                const f32x4 kd4 = *(const LAS f32x4*)(op + 192 + kq * 4), r4 = *(const LAS f32x4*)(op + 256 + kq * 4); const f32x2 v2 = *(const LAS f32x2*)(op + 320 + row0);
                float sa0 = (S0[0] * kk4[0] + S0[1] * kk4[1]) + (S0[2] * kk4[2] + S0[3] * kk4[3]); float sa1 = (S1[0] * kk4[0] + S1[1] * kk4[1]) + (S1[2] * kk4[2] + S1[3] * kk4[3]);
                sa0 = red16(sa0); sa1 = red16(sa1);
#pragma unroll
                for (int j = 0; j < 4; ++j) { S0[j] = S0[j] * w4[j] + (v2.x * kd4[j] - sa0 * b4[j]); S1[j] = S1[j] * w4[j] + (v2.y * kd4[j] - sa1 * b4[j]); }
                float y0 = (S0[0] * r4[0] + S0[1] * r4[1]) + (S0[2] * r4[2] + S0[3] * r4[3]); float y1 = (S1[0] * r4[0] + S1[1] * r4[1]) + (S1[2] * r4[2] + S1[3] * r4[3]);
                y0 = red16(y0); y1 = red16(y1);
                if (kq == 0) *(LAS f32x2*)(YL + s * 64 + row0) = (f32x2){y0, y1}; }
            __syncthreads();
#endif
            { const int i = tid >> 4, c4 = (tid & 15) * 4; const int s = d ? 31 - i : i; const f32x4 y = *(const LAS f32x4*)(YL + s * 64 + c4);
              u32x2 o; o.x = pk_bf16(y[0], y[1]); o.y = pk_bf16(y[2], y[3]); *(u32x2*)(Yd + (size_t)(seq_base + tlo + i) * 1024 + h * 64 + c4) = o; } SSTAMP(6);
        }
#if SCAN_SEC >= 0
        if (bid == 0 && tid == 0 && l == 0) { unsigned long long tot = 0; for (int q = 0; q < 8; ++q) tot += tacc[q]; ((unsigned*)(a.ws() + WS_CTL))[12] = (unsigned)((40ull * tacc[SCAN_SEC] + tot / 2) / tot); }
#endif
        __syncthreads();
    }
}

typedef short bf16x4 __attribute__((ext_vector_type(4)));
__device__ __forceinline__ bf16x4 pk4(float x0, float x1, float x2, float x3) { u32x2 w; w.x = pk_bf16(x0, x1); w.y = pk_bf16(x2, x3); return __builtin_bit_cast(bf16x4, w); }
__device__ __forceinline__ bf16x4 pk4v(f32x4 v) { return pk4(v[0], v[1], v[2], v[3]); }
__device__ __forceinline__ f32x4 mfma16(bf16x4 a, bf16x4 b, f32x4 c) { return __builtin_amdgcn_mfma_f32_16x16x16bf16_1k(a, b, c, 0, 0, 0); }
__device__ __forceinline__ void scan_load2(u32x4 (&pre)[4], const bf16_t* ZR, int seq_base, int len, int tlo, int h, int d, int lane) {
#pragma unroll
    for (int q = 0; q < 4; ++q) { const int piece = lane + 64 * q; u32x4 v = (u32x4){0u, 0u, 0u, 0u};
        if (piece < 240) { const int row = piece / 40, rem = piece - row * 40, grp = rem >> 3, sub = rem & 7; const int t = tlo - 1 + row;
            const int cbase = (grp < 3) ? (grp * 1024 + h * 64) : ((grp == 3 ? C_W1 : C_A1) + d * 64);
            if (t >= 0 && t < len) v = *(const u32x4*)(ZR + (size_t)(seq_base + t) * NZR + cbase + sub * 8); }
        pre[q] = v; }
}
__device__ __forceinline__ void scan_phase2(const KA a_in, LAS unsigned char* lds, int l) {
    const KA a = opaque_ka(a_in); const int tid = opaque_tid(), bid = opaque_bid(), lane = tid & 63, wid = __builtin_amdgcn_readfirstlane(tid >> 6), col = lane;
    constexpr int IMG_SZ = 17664, OP_SZ = 24576, PRV_SZ = 7936, NSUB = 528;
    LAS unsigned char* const IMG0 = lds; LAS unsigned char* const OP0 = lds + 2 * IMG_SZ; LAS unsigned char* const PRV0 = lds + 2 * IMG_SZ + 2 * OP_SZ;
    const bf16_t* ZR = (const bf16_t*)(a.ws() + WS_Z); float* BON = (float*)(a.ws() + WS_BON);
    const float* smu = a.in(I_SMU) + (size_t)l * 2 * P_RWKV;
    for (int chain = bid; chain < 256; chain += gridDim.x) {
        const int b = chain >> 5, h = (chain >> 1) & 15, d = chain & 1;
        bf16_t* Yd = (bf16_t*)(a.ws() + (d ? WS_YB : WS_YF));
        const int g = lane >> 4, c = lane & 15;
        const int p = wid - 4;
        LAS bf16_t* RAWp = (LAS bf16_t*)(PRV0 + (p & 3) * PRV_SZ);
        LAS bf16_t* TAp = (LAS bf16_t*)(PRV0 + (p & 3) * PRV_SZ + 3840);
        float mu0[5], mu1[5]; float w0c = 0.f, a0c = 0.f, kkc = 0.f, kac = 0.f, rkc = 0.f; bf16x8 Bf[2][4][2]; u32x4 pre[4];
        LAS float* WL = (LAS float*)OP0;
        __syncthreads();
        for (int i = tid; i < 8192; i += 512) { const int mm = i >> 12, r = (i >> 6) & 63, cc = i & 63; WL[i] = (mm == 0 ? a.in(I_W2) : a.in(I_A2))[((size_t)(l * 2 + d) * 64 + r) * 1024 + h * 64 + cc]; }
        __syncthreads();
        if (wid >= 4) {
#pragma unroll
            for (int gq = 0; gq < 5; ++gq) { const int cb = (gq < 3) ? (gq * 1024 + h * 64) : ((gq == 3 ? C_W1 : C_A1) + d * 64); mu0[gq] = smu[cb + col]; mu1[gq] = smu[P_RWKV + cb + col]; }
            const int hc = h * 64 + col;
            w0c = a.in(I_W0)[(l * 2 + d) * 1024 + hc]; a0c = a.in(I_A0)[(l * 2 + d) * 1024 + hc]; kkc = a.in(I_KK)[l * 1024 + hc]; kac = a.in(I_KA)[l * 1024 + hc]; rkc = a.in(I_RK)[l * 1024 + hc];
#pragma unroll
            for (int mm = 0; mm < 2; ++mm)
#pragma unroll
                for (int ct = 0; ct < 4; ++ct)
#pragma unroll
                    for (int ks = 0; ks < 2; ++ks) { const LAS float* lw = WL + mm * 4096 + (ks * 32 + g * 8) * 64 + ct * 16 + c;
                        u32x4 w; w.x = pk_bf16(lw[0], lw[64]); w.y = pk_bf16(lw[128], lw[192]); w.z = pk_bf16(lw[256], lw[320]); w.w = pk_bf16(lw[384], lw[448]); Bf[mm][ct][ks] = __builtin_bit_cast(bf16x8, w); }
#pragma unroll
            for (int q = 0; q < 4; ++q) ((LAS u32x4*)TAp)[lane + 64 * q] = (u32x4){0u, 0u, 0u, 0u};
            { const int len = CTXL, p0 = 0; const int tlo = d ? len - 1 - (p0 + 4 * p + 3) : p0 + 4 * p; scan_load2(pre, ZR, M_LAT + b * CTXL, len, tlo, h, d, lane); }
        }
        bf16x4 SEL1, SEL2, ONES4;
        { u32x2 w; w.x = (c == 0 ? 0x3F80u : 0u) | (c == 1 ? 0x3F800000u : 0u); w.y = (c == 2 ? 0x3F80u : 0u) | (c == 3 ? 0x3F800000u : 0u); SEL1 = __builtin_bit_cast(bf16x4, w);
          w.x = (c == 4 ? 0x3F80u : 0u) | (c == 5 ? 0x3F800000u : 0u); w.y = (c == 6 ? 0x3F80u : 0u) | (c == 7 ? 0x3F800000u : 0u); SEL2 = __builtin_bit_cast(bf16x4, w);
          w.x = 0x3F803F80u; w.y = 0x3F803F80u; ONES4 = __builtin_bit_cast(bf16x4, w); }
        f32x4 ST[4] = {(f32x4){0.f, 0.f, 0.f, 0.f}, (f32x4){0.f, 0.f, 0.f, 0.f}, (f32x4){0.f, 0.f, 0.f, 0.f}, (f32x4){0.f, 0.f, 0.f, 0.f}};
        __syncthreads();
#pragma unroll 1
        for (int n = -2; n < NSUB; ++n) {
            if (wid >= 4) {
                const int s2 = n + 2;
                if (s2 < NSUB) {
                    const int seg = s2 >= 16, len = seg ? SEQ : CTXL, seq_base = seg ? b * SEQ : M_LAT + b * CTXL, p0 = 16 * (seg ? s2 - 16 : s2);
#pragma unroll
                    for (int q = 0; q < 4; ++q) { const int piece = lane + 64 * q; if (piece < 240) ((LAS u32x4*)RAWp)[piece] = pre[q]; }
                    if (s2 + 1 < NSUB) { const int s3 = s2 + 1, seg3 = s3 >= 16, len3 = seg3 ? SEQ : CTXL, p03 = 16 * (seg3 ? s3 - 16 : s3); const int tlo3 = d ? len3 - 1 - (p03 + 4 * p + 3) : p03 + 4 * p;
                        scan_load2(pre, ZR, seg3 ? b * SEQ : M_LAT + b * CTXL, len3, tlo3, h, d, lane); }
                    LDS_WAIT(); asm volatile("" ::: "memory");
                    const int tlo = d ? len - 1 - (p0 + 4 * p + 3) : p0 + 4 * p;
                    float rv[4], kv[4], vv[4];
                    { float zz[6][5];
#pragma unroll
                      for (int rr = 0; rr < 6; ++rr)
#pragma unroll
                          for (int gq = 0; gq < 5; ++gq) zz[rr][gq] = __builtin_bit_cast(float, (unsigned)RAWp[rr * 320 + gq * 64 + col] << 16);
#pragma unroll
                      for (int j = 0; j < 4; ++j) {
                          rv[j] = zz[j + 1][0] + mu0[0] * (zz[j][0] - zz[j + 1][0]) + mu1[0] * (zz[j + 2][0] - zz[j + 1][0]);
                          kv[j] = zz[j + 1][1] + mu0[1] * (zz[j][1] - zz[j + 1][1]) + mu1[1] * (zz[j + 2][1] - zz[j + 1][1]);
                          vv[j] = zz[j + 1][2] + mu0[2] * (zz[j][2] - zz[j + 1][2]) + mu1[2] * (zz[j + 2][2] - zz[j + 1][2]);
                          const float w1v = zz[j + 1][3] + mu0[3] * (zz[j][3] - zz[j + 1][3]) + mu1[3] * (zz[j + 2][3] - zz[j + 1][3]);
                          const float a1v = zz[j + 1][4] + mu0[4] * (zz[j][4] - zz[j + 1][4]) + mu1[4] * (zz[j + 2][4] - zz[j + 1][4]);
                          TAp[j * 64 + col] = f2b(2.0f * sigm(2.0f * w1v) - 1.0f); TAp[1024 + j * 64 + col] = f2b(a1v); } }
                    LDS_WAIT(); asm volatile("" ::: "memory");
                    float lw[2][4];
#pragma unroll
                    for (int mm = 0; mm < 2; ++mm) { const bf16x8 Af0 = *(const LAS bf16x8*)(TAp + mm * 1024 + (c & 3) * 64 + g * 8), Af1 = *(const LAS bf16x8*)(TAp + mm * 1024 + (c & 3) * 64 + 32 + g * 8);
                        f32x4 acc[4];
#pragma unroll
                        for (int ct = 0; ct < 4; ++ct) { acc[ct] = __builtin_amdgcn_mfma_f32_16x16x32_bf16(Af0, Bf[mm][ct][0], (f32x4){0.f, 0.f, 0.f, 0.f}, 0, 0, 0); acc[ct] = __builtin_amdgcn_mfma_f32_16x16x32_bf16(Af1, Bf[mm][ct][1], acc[ct], 0, 0, 0); }
#pragma unroll
                        for (int rg = 0; rg < 4; ++rg) { const float t01 = (g & 1) ? acc[1][rg] : acc[0][rg], t23 = (g & 1) ? acc[3][rg] : acc[2][rg]; lw[mm][rg] = (g & 2) ? t23 : t01; } }
                    float dec[4], av[4], kkr[4], kd[4], x2[4], x3[4];
#pragma unroll
                    for (int j = 0; j < 4; ++j) { dec[j] = __expf(-0.60653066f * sigm(lw[0][j] + w0c)); av[j] = sigm(lw[1][j] + a0c); kkr[j] = kv[j] * kkc; kd[j] = kv[j] * (1.f + (av[j] - 1.f) * kac);
                        x2[j] = kkr[j] * kkr[j]; x3[j] = rv[j] * kd[j] * rkc; }
                    const f32x4 zz4 = (f32x4){0.f, 0.f, 0.f, 0.f};
                    f32x4 D1 = mfma16(pk4(x2[0], x2[1], x2[2], x2[3]), SEL1, zz4); D1 = mfma16(pk4(x3[0], x3[1], x3[2], x3[3]), SEL2, D1);
                    const f32x4 D2 = mfma16(ONES4, pk4v(D1), zz4);
                    float cf[4];
                    { const float p01 = dec[0] * dec[1], p012 = p01 * dec[2], p0123 = p012 * dec[3], s32 = dec[3] * dec[2], s321 = s32 * dec[1];
                      cf[0] = d ? p0123 : dec[0]; cf[1] = d ? s321 : p01; cf[2] = d ? s32 : p012; cf[3] = d ? dec[3] : p0123; }
                    LAS float* OPb = (LAS float*)(OP0 + (s2 & 1) * OP_SZ);
#pragma unroll
                    for (int j = 0; j < 4; ++j) { const float n2 = rdl(D2[0], j); const float kk = kkr[j] * __builtin_amdgcn_rsqf(fmaxf(n2, 1e-24f)); const float bb = kk * av[j];
                        LAS float* op = OPb + (4 * p + (d ? 3 - j : j)) * 384 + col; op[0] = cf[j]; op[64] = kk; op[128] = bb; op[192] = kd[j]; op[256] = rv[j]; op[320] = vv[j]; }
                    if (lane >= 4 && lane < 8) BON[((size_t)d * M + seq_base + tlo + (lane - 4)) * 16 + h] = D2[0];
                }
            } else {
                const int s1 = n + 1;
                if (s1 >= 0 && s1 < NSUB) {
                    const LAS float* OPb = (const LAS float*)(OP0 + (s1 & 1) * OP_SZ); LAS unsigned char* IM = IMG0 + (s1 & 1) * IMG_SZ;
                    LAS bf16_t* KT = (LAS bf16_t*)IM; LAS bf16_t* RT = (LAS bf16_t*)(IM + 2048); LAS bf16_t* BP = (LAS bf16_t*)(IM + 4096); LAS bf16_t* KP = (LAS bf16_t*)(IM + 6144);
                    LAS bf16_t* BHT = (LAS bf16_t*)(IM + 8192); LAS bf16_t* KHT = (LAS bf16_t*)(IM + 11264); LAS bf16_t* VT = (LAS bf16_t*)(IM + 14336); LAS float* GC = (LAS float*)(IM + 17408);
                    const int k = lane, i0 = 4 * wid;
                    const float t0 = OPb[3 * 384 + k], t1 = OPb[7 * 384 + k], t2 = OPb[11 * 384 + k], t3 = OPb[15 * 384 + k];
                    const float c2 = t0 * t1, c3 = c2 * t2, gC = c3 * t3; const float pre0 = (wid == 0) ? 1.f : (wid == 1 ? t0 : (wid == 2 ? c2 : c3));
                    float gpv[4], gvv[4];
#pragma unroll
                    for (int q = 0; q < 4; ++q) { gvv[q] = pre0 * OPb[(i0 + q) * 384 + k]; gpv[q] = q ? gvv[q - 1] : pre0; }
                    float bh[4], kh[4], vq[4], ktv[4], rtv[4], bpv[4], kpv[4];
#pragma unroll
                    for (int q = 0; q < 4; ++q) { const int i = i0 + q; const float inv = __builtin_amdgcn_rcpf(gvv[q]), gcg = gC * inv; const LAS float* op = OPb + i * 384 + k;
                        const float kkv = op[64], bv = op[128], kdv = op[192], rv = op[256], vv = op[320];
                        ktv[q] = kkv * gpv[q]; rtv[q] = rv * gvv[q]; bpv[q] = bv * inv; kpv[q] = kdv * inv;
                        bh[q] = bv * gcg; kh[q] = kdv * gcg; vq[q] = vv; }
                    { const int sw = k * 16 + ((wid ^ ((k >> 2) & 3)) * 4);
                      *(LAS bf16x4*)(KT + sw) = pk4(ktv[0], ktv[1], ktv[2], ktv[3]); *(LAS bf16x4*)(RT + sw) = pk4(rtv[0], rtv[1], rtv[2], rtv[3]);
                      *(LAS bf16x4*)(BP + sw) = pk4(bpv[0], bpv[1], bpv[2], bpv[3]); *(LAS bf16x4*)(KP + sw) = pk4(kpv[0], kpv[1], kpv[2], kpv[3]); }
                    *(LAS bf16x4*)(BHT + k * 24 + i0) = pk4(bh[0], bh[1], bh[2], bh[3]); *(LAS bf16x4*)(KHT + k * 24 + i0) = pk4(kh[0], kh[1], kh[2], kh[3]); *(LAS bf16x4*)(VT + k * 24 + i0) = pk4(vq[0], vq[1], vq[2], vq[3]);
                    if (wid == 0) GC[k] = gC;
                }
                if (n >= 0) {
                const int t = wid; const LAS unsigned char* IM = IMG0 + (n & 1) * IMG_SZ;
                const LAS bf16_t* KT = (const LAS bf16_t*)IM; const LAS bf16_t* RT = (const LAS bf16_t*)(IM + 2048); const LAS bf16_t* BP = (const LAS bf16_t*)(IM + 4096); const LAS bf16_t* KP = (const LAS bf16_t*)(IM + 6144);
                const LAS bf16_t* BHT = (const LAS bf16_t*)(IM + 8192); const LAS bf16_t* KHT = (const LAS bf16_t*)(IM + 11264); const LAS bf16_t* VT = (const LAS bf16_t*)(IM + 14336); const LAS float* GC = (const LAS float*)(IM + 17408);
                bf16x4 fKT[4], fRT[4];
                const f32x4 z4 = (f32x4){0.f, 0.f, 0.f, 0.f};
                f32x4 abT = z4, ab = z4, akdT = z4, nbT = z4, nkdT = z4;
                const int troff = (4 * g + (c >> 2)) * 16 + (((c & 3) ^ g) * 4);
#pragma unroll
                for (int ks = 0; ks < 4; ++ks) { fKT[ks] = __builtin_amdgcn_ds_read_tr16_b64_v4i16((LAS bf16x4*)(KT + troff + ks * 256)); fRT[ks] = __builtin_amdgcn_ds_read_tr16_b64_v4i16((LAS bf16x4*)(RT + troff + ks * 256));
                    const bf16x4 fBP = __builtin_amdgcn_ds_read_tr16_b64_v4i16((LAS bf16x4*)(BP + troff + ks * 256)), fKP = __builtin_amdgcn_ds_read_tr16_b64_v4i16((LAS bf16x4*)(KP + troff + ks * 256));
                    abT = mfma16(fBP, fKT[ks], abT); ab = mfma16(fKT[ks], fBP, ab); akdT = mfma16(fKP, fKT[ks], akdT); nbT = mfma16(fBP, fRT[ks], nbT); nkdT = mfma16(fKP, fRT[ks], nkdT); }
                f32x4 R;
#pragma unroll
                for (int rg = 0; rg < 4; ++rg) { const int j = 4 * g + rg; akdT[rg] = (j < c) ? akdT[rg] : 0.f; nbT[rg] = (j <= c) ? nbT[rg] : 0.f; nkdT[rg] = (j <= c) ? nkdT[rg] : 0.f;
                    abT[rg] = (j < c) ? abT[rg] : 0.f; ab[rg] = (c < j) ? ab[rg] : 0.f; R[rg] = ((j == c) ? 1.f : 0.f) - abT[rg]; }
                const bf16x4 aAkd = pk4v(akdT), aNb = pk4v(nbT), aNkd = pk4v(nkdT);
                const bf16x4 pP1 = pk4v(ab), pQ1 = pk4v(abT);
                const f32x4 P2 = mfma16(pQ1, pP1, z4), Q2 = mfma16(pP1, pQ1, z4);
                const bf16x4 pP2 = pk4v(P2), pQ2 = pk4v(Q2);
                const f32x4 P4 = mfma16(pQ2, pP2, z4), Q4 = mfma16(pP2, pQ2, z4);
                R = mfma16(pP2, pk4v(R), R);
                const bf16x4 pP4 = pk4v(P4), pQ4 = pk4v(Q4);
                const f32x4 P8 = mfma16(pQ4, pP4, z4);
                R = mfma16(pP4, pk4v(R), R);
                R = mfma16(pk4v(P8), pk4v(R), R);
                const bf16x4 aT = pk4v(R);
                bf16x4 bS[4];
#pragma unroll
                for (int kt = 0; kt < 4; ++kt) bS[kt] = pk4v(ST[kt]);
                const bf16x4 fV = *(const LAS bf16x4*)(VT + (16 * t + c) * 24 + g * 4);
                f32x4 X = (f32x4){0.f, 0.f, 0.f, 0.f};
#pragma unroll
                for (int kt = 0; kt < 4; ++kt) X = mfma16(fKT[kt], bS[kt], X);
                X = mfma16(aAkd, fV, X);
                f32x4 U = mfma16(aT, pk4v(X), (f32x4){0.f, 0.f, 0.f, 0.f});
                const bf16x4 bU = pk4(-U[0], -U[1], -U[2], -U[3]);
                f32x4 y = (f32x4){0.f, 0.f, 0.f, 0.f};
#pragma unroll
                for (int kt = 0; kt < 4; ++kt) y = mfma16(fRT[kt], bS[kt], y);
                y = mfma16(aNb, bU, y); y = mfma16(aNkd, fV, y);
                { const int seg = n >= 16, len = seg ? SEQ : CTXL, seq_base = seg ? b * SEQ : M_LAT + b * CTXL, p0 = 16 * (seg ? n - 16 : n);
#pragma unroll
                  for (int rg = 0; rg < 4; ++rg) { const int pos = p0 + 4 * g + rg, tkn = d ? len - 1 - pos : pos; Yd[(size_t)(seq_base + tkn) * 1024 + h * 64 + 16 * t + c] = f2b(y[rg]); } }
#pragma unroll
                for (int kt = 0; kt < 4; ++kt) { const f32x4 gc4 = *(const LAS f32x4*)(GC + 16 * kt + 4 * g);
                    const bf16x4 fBH = *(const LAS bf16x4*)(BHT + (16 * kt + c) * 24 + g * 4), fKH = *(const LAS bf16x4*)(KHT + (16 * kt + c) * 24 + g * 4);
                    f32x4 s = ST[kt] * gc4; s = mfma16(fBH, bU, s); s = mfma16(fKH, fV, s); ST[kt] = s; }
                }
            }
            __syncthreads();
        }
    }
}

__device__ __forceinline__ void post_phase(const KA a_in, int l) {
    const KA a = opaque_ka(a_in); const int tid = opaque_tid(); const int lane = tid & 63, gw = opaque_bid() * 8 + (tid >> 6), NGW = gridDim.x * 8;
    const bf16_t* ZR = (const bf16_t*)(a.ws() + WS_Z); bf16_t* YF = (bf16_t*)(a.ws() + WS_YF); const bf16_t* YB = (const bf16_t*)(a.ws() + WS_YB);
    const float* BON = (const float*)(a.ws() + WS_BON); bf16_t* SG = (bf16_t*)(a.ws() + WS_PT);
    const float* smu = a.in(I_SMU) + (size_t)l * 2 * P_RWKV;
    const int c0 = lane * 16;
    float m0v[16], m1v[16], lg[16], lb[16];
#pragma unroll
    for (int j = 0; j < 16; ++j) { m0v[j] = smu[C_V + c0 + j]; m1v[j] = smu[P_RWKV + C_V + c0 + j]; lg[j] = a.in(I_LNXG)[l * 1024 + c0 + j]; lb[j] = a.in(I_LNXB)[l * 1024 + c0 + j]; }
    float gm0[4], gm1[4];
#pragma unroll
    for (int j = 0; j < 4; ++j) { const int cg = C_G1 + (lane < 40 ? lane * 4 + j : 0); gm0[j] = smu[cg]; gm1[j] = smu[P_RWKV + cg]; }
    for (int row = gw; row < ((l == 1) ? M_LAT : M); row += NGW) {
        const bool lat = row < M_LAT; const int t = lat ? (row & (SEQ - 1)) : ((row - M_LAT) & (CTXL - 1)); const int len = lat ? SEQ : CTXL;
        const bool hp = t > 0, hn = t < len - 1;
        const u32x4 z4 = (u32x4){0u, 0u, 0u, 0u};
        const u32x4* yfp = (const u32x4*)(YF + (size_t)row * 1024 + c0); const u32x4* ybp = (const u32x4*)(YB + (size_t)row * 1024 + c0);
        const u32x4 yf0 = yfp[0], yf1 = yfp[1], yb0 = ybp[0], yb1 = ybp[1];
        const u32x4* vc = (const u32x4*)(ZR + (size_t)row * NZR + C_V + c0);
        const u32x4 vc0 = vc[0], vc1 = vc[1];
        const int rp = hp ? row - 1 : row, rn = hn ? row + 1 : row;
        const u32x4 vp0r = *(const u32x4*)(ZR + (size_t)rp * NZR + C_V + c0), vp1r = *(const u32x4*)(ZR + (size_t)rp * NZR + C_V + c0 + 8);
        const u32x4 vn0r = *(const u32x4*)(ZR + (size_t)rn * NZR + C_V + c0), vn1r = *(const u32x4*)(ZR + (size_t)rn * NZR + C_V + c0 + 8);
        const int hd = lane >> 2;
        const float bon0 = BON[(size_t)row * 16 + hd], bon1 = BON[((size_t)M + row) * 16 + hd];
        const int gl = (lane < 40) ? lane * 4 : 0;
        const u32x2 gcr = *(const u32x2*)(ZR + (size_t)row * NZR + C_G1 + gl), gpr = *(const u32x2*)(ZR + (size_t)rp * NZR + C_G1 + gl), gnr = *(const u32x2*)(ZR + (size_t)rn * NZR + C_G1 + gl);
        __builtin_amdgcn_sched_barrier(0);
        const u32x4 vp0 = hp ? vp0r : z4, vp1 = hp ? vp1r : z4, vn0 = hn ? vn0r : z4, vn1 = hn ? vn1r : z4;
        const float bon = bon0 + bon1;
        float o[16], vz[16], vpz[16], vnz[16];
        { f32x4 p0, p1, q0, q1; unpack8(yf0, p0, p1); unpack8(yb0, q0, q1);
#pragma unroll
          for (int j = 0; j < 4; ++j) { o[j] = p0[j] + q0[j]; o[4 + j] = p1[j] + q1[j]; }
          unpack8(yf1, p0, p1); unpack8(yb1, q0, q1);
#pragma unroll
          for (int j = 0; j < 4; ++j) { o[8 + j] = p0[j] + q0[j]; o[12 + j] = p1[j] + q1[j]; }
          unpack8(vc0, p0, p1); unpack8(vc1, q0, q1);
#pragma unroll
          for (int j = 0; j < 4; ++j) { vz[j] = p0[j]; vz[4 + j] = p1[j]; vz[8 + j] = q0[j]; vz[12 + j] = q1[j]; }
          unpack8(vp0, p0, p1); unpack8(vp1, q0, q1);
#pragma unroll
          for (int j = 0; j < 4; ++j) { vpz[j] = p0[j]; vpz[4 + j] = p1[j]; vpz[8 + j] = q0[j]; vpz[12 + j] = q1[j]; }
          unpack8(vn0, p0, p1); unpack8(vn1, q0, q1);
#pragma unroll
          for (int j = 0; j < 4; ++j) { vnz[j] = p0[j]; vnz[4 + j] = p1[j]; vnz[8 + j] = q0[j]; vnz[12 + j] = q1[j]; } }
        float s = 0.f;
#pragma unroll
        for (int j = 0; j < 16; ++j) s += o[j];
        s += dpp_f<0xB1>(s); s += dpp_f<0x4E>(s);
        const float mean = s * (1.f / 64.f); float q = 0.f;
#pragma unroll
        for (int j = 0; j < 16; ++j) { const float dd = o[j] - mean; q += dd * dd; }
        q += dpp_f<0xB1>(q); q += dpp_f<0x4E>(q);
        const float rstd = rsqrtf(q * (1.f / 64.f) + 64e-5f);
        float r[16];
#pragma unroll
        for (int j = 0; j < 16; ++j) { const float vv = vz[j] + m0v[j] * (vpz[j] - vz[j]) + m1v[j] * (vnz[j] - vz[j]); r[j] = (o[j] - mean) * rstd * lg[j] + lb[j] + bon * vv; }
        u32x4 w0, w1; w0.x = pk_bf16(r[0], r[1]); w0.y = pk_bf16(r[2], r[3]); w0.z = pk_bf16(r[4], r[5]); w0.w = pk_bf16(r[6], r[7]);
        w1.x = pk_bf16(r[8], r[9]); w1.y = pk_bf16(r[10], r[11]); w1.z = pk_bf16(r[12], r[13]); w1.w = pk_bf16(r[14], r[15]);
        u32x4* op = (u32x4*)(YF + (size_t)row * 1024 + c0);
#if PROBE_HI == 6
        (void)op;
#else
        op[0] = w0; op[1] = w1;
#endif
#if PROBE_HI > 0
        if (row < 32768) { u32x4* o2 = (u32x4*)((bf16_t*)(a.ws() + WS_Z + 396 * MiB) + (size_t)row * 1024 + c0); o2[0] = w0; o2[1] = w1; }
#endif
        u32x2 sg = (u32x2){0u, 0u};
        if (lane < 40) { const u32x2 gc = gcr;
            const u32x2 gp = hp ? gpr : (u32x2){0u, 0u};
            const u32x2 gn = hn ? gnr : (u32x2){0u, 0u};
            const float zc[4] = {bf_lo(gc.x), bf_hi(gc.x), bf_lo(gc.y), bf_hi(gc.y)}, zp[4] = {bf_lo(gp.x), bf_hi(gp.x), bf_lo(gp.y), bf_hi(gp.y)}, zn[4] = {bf_lo(gn.x), bf_hi(gn.x), bf_lo(gn.y), bf_hi(gn.y)};
            float sv[4];
#pragma unroll
            for (int j = 0; j < 4; ++j) sv[j] = sigm(zc[j] + gm0[j] * (zp[j] - zc[j]) + gm1[j] * (zn[j] - zc[j]));
            sg.x = pk_bf16(sv[0], sv[1]); sg.y = pk_bf16(sv[2], sv[3]); }
        *(u32x2*)(SG + (size_t)row * 256 + lane * 4) = sg;
    }
}

__device__ __forceinline__ void conv_phase(const KA a_in, LAS unsigned char* lds, int l) {
    const KA a = opaque_ka(a_in); const int tid = opaque_tid(), bid = opaque_bid(); const int lane = tid & 63, wid = __builtin_amdgcn_readfirstlane(tid >> 6), c = lane & 15;
    const bf16_t* U = (const bf16_t*)(a.ws() + WS_Z); bf16_t* A2 = (bf16_t*)(a.ws() + WS_YB);
    LAS float* ST = (LAS float*)lds;
    const int ch = 128 * wid + 2 * lane;
    f32x2 w2[31];
    { const float* cw = a.in(I_CONVW) + (size_t)l * 31 * 1024 + ch;
#pragma unroll
      for (int k = 0; k < 31; ++k) w2[k] = *(const f32x2*)(cw + k * 1024); }
    const f32x2 cg = *(const f32x2*)(a.in(I_CNG) + l * 1024 + ch), cb = *(const f32x2*)(a.in(I_CNB) + l * 1024 + ch);
    bf16x4 SEL[4], ONES4;
#pragma unroll
    for (int k = 0; k < 4; ++k) { u32x2 w; w.x = (c == 4 * k ? 0x3F80u : 0u) | (c == 4 * k + 1 ? 0x3F800000u : 0u); w.y = (c == 4 * k + 2 ? 0x3F80u : 0u) | (c == 4 * k + 3 ? 0x3F800000u : 0u); SEL[k] = __builtin_bit_cast(bf16x4, w); }
    { u32x2 w; w.x = 0x3F803F80u; w.y = 0x3F803F80u; ONES4 = __builtin_bit_cast(bf16x4, w); }
    const f32x4 z4 = (f32x4){0.f, 0.f, 0.f, 0.f};
    __syncthreads();
    int par = 0;
    for (int tile = bid; tile < ((l == 1) ? 4096 : 4224); tile += gridDim.x, par ^= 1) {
        int base, stride, len, p0;
        if (tile < 4096) { const int b = tile >> 9, j = (tile >> 3) & 63, ib = tile & 7; base = b * SEQ + j; stride = 64; len = 128; p0 = ib * 16; }
        else { const int t2 = tile - 4096, b = t2 >> 4, tb = t2 & 15; base = M_LAT + b * CTXL; stride = 1; len = CTXL; p0 = tb * 16; }
        unsigned win[46];
#pragma unroll
        for (int r = 0; r < 46; ++r) { const int pp = p0 - 15 + r; win[r] = (pp >= 0 && pp < len) ? *(const unsigned*)(U + (size_t)(base + pp * stride) * 1024 + ch) : 0u; }
        f32x2 acc[16];
#pragma unroll
        for (int j = 0; j < 16; ++j) acc[j] = (f32x2){0.f, 0.f};
#pragma unroll
        for (int r = 0; r < 46; ++r) { const f32x2 x2 = (f32x2){bf_lo(win[r]), bf_hi(win[r])};
#pragma unroll
            for (int j = 0; j < 16; ++j) { const int k = r - j; if (k >= 0 && k < 31) acc[j] += x2 * w2[k]; } }
        float sv[16], qv[16];
#pragma unroll
        for (int j = 0; j < 16; ++j) { sv[j] = acc[j][0] + acc[j][1]; qv[j] = acc[j][0] * acc[j][0] + acc[j][1] * acc[j][1]; }
        f32x4 D1s = z4, D1q = z4;
#pragma unroll
        for (int k = 0; k < 4; ++k) { D1s = mfma16(pk4(sv[4 * k], sv[4 * k + 1], sv[4 * k + 2], sv[4 * k + 3]), SEL[k], D1s); D1q = mfma16(pk4(qv[4 * k], qv[4 * k + 1], qv[4 * k + 2], qv[4 * k + 3]), SEL[k], D1q); }
        const f32x4 D2s = mfma16(ONES4, pk4v(D1s), z4), D2q = mfma16(ONES4, pk4v(D1q), z4);
        LAS float* slot = ST + par * 256;
        if (lane < 16) { slot[wid * 32 + lane] = D2s[0]; slot[wid * 32 + 16 + lane] = D2q[0]; }
        __syncthreads();
        float S = 0.f, Q = 0.f;
#pragma unroll
        for (int w = 0; w < 8; ++w) { S += slot[w * 32 + c]; Q += slot[w * 32 + 16 + c]; }
        const float mean = S * (1.f / 1024.f); const float rstd = rsqrtf(fmaxf(Q * (1.f / 1024.f) - mean * mean, 0.f) + 1e-5f);
#pragma unroll
        for (int j = 0; j < 16; ++j) { const float m = rdl(mean, j), rs = rdl(rstd, j);
            const float y0 = (acc[j][0] - m) * rs * cg[0] + cb[0], y1 = (acc[j][1] - m) * rs * cg[1] + cb[1];
            *(unsigned*)(A2 + (size_t)(base + (p0 + j) * stride) * 1024 + ch) = pk_bf16(y0 * sigm(y0), y1 * sigm(y1)); }
    }
    __syncthreads();
}

__device__ __forceinline__ void ce(float& ka, unsigned& pa, float& kb, unsigned& pb) {
    const bool sw = kb > ka; const float k0 = sw ? kb : ka, k1 = sw ? ka : kb; const unsigned p0 = sw ? pb : pa, p1 = sw ? pa : pb; ka = k0; kb = k1; pa = p0; pb = p1;
}
template <int N> __device__ __forceinline__ void bitonic_sort_desc(float (&k)[N], unsigned (&p)[N]) {
#pragma unroll
    for (int size = 2; size <= N; size <<= 1)
#pragma unroll
        for (int stride = size >> 1; stride > 0; stride >>= 1)
#pragma unroll
            for (int i = 0; i < N; ++i) { const int j = i ^ stride; if (j > i) { if ((i & size) == 0) ce(k[i], p[i], k[j], p[j]); else ce(k[j], p[j], k[i], p[i]); } }
}
#define CE16(a, b) ce(k[a], p[a], k[b], p[b]);
__device__ __forceinline__ void sort16_desc_kp(float (&k)[16], unsigned (&p)[16]) { CE16(0,1) CE16(2,3) CE16(0,2) CE16(1,3) CE16(1,2) CE16(4,5) CE16(6,7) CE16(4,6) CE16(5,7) CE16(5,6) CE16(0,4) CE16(2,6) CE16(2,4) CE16(1,5) CE16(3,7) CE16(3,5) CE16(1,2) CE16(3,4) CE16(5,6) CE16(8,9) CE16(10,11) CE16(8,10) CE16(9,11) CE16(9,10) CE16(12,13) CE16(14,15) CE16(12,14) CE16(13,15) CE16(13,14) CE16(8,12) CE16(10,14) CE16(10,12) CE16(9,13) CE16(11,15) CE16(11,13) CE16(9,10) CE16(11,12) CE16(13,14) CE16(0,8) CE16(4,12) CE16(4,8) CE16(2,10) CE16(6,14) CE16(6,10) CE16(2,4) CE16(6,8) CE16(10,12) CE16(1,9) CE16(5,13) CE16(5,9) CE16(3,11) CE16(7,15) CE16(7,11) CE16(3,5) CE16(7,9) CE16(11,13) CE16(1,2) CE16(3,4) CE16(5,6) CE16(7,8) CE16(9,10) CE16(11,12) CE16(13,14) }
#undef CE16
__device__ __forceinline__ void bitonic_merge16_desc(float (&k)[16], unsigned (&p)[16]) {
#pragma unroll
    for (int stride = 8; stride > 0; stride >>= 1)
#pragma unroll
        for (int i = 0; i < 16; ++i) { const int j = i ^ stride; if (j > i) ce(k[i], p[i], k[j], p[j]); }
}
__device__ __forceinline__ void merge_partner16(float (&k)[16], unsigned (&p)[16], int mask, int lane) {
    float ok[16]; unsigned opp[16];
#pragma unroll
    for (int i = 0; i < 16; ++i) { ok[i] = shxf(k[i], mask, lane); opp[i] = (unsigned)shxi((int)p[i], mask, lane); }
#pragma unroll
    for (int i = 0; i < 16; ++i) { const float o = ok[15 - i]; const unsigned q = opp[15 - i]; const bool t = o > k[i]; k[i] = t ? o : k[i]; p[i] = t ? q : p[i]; }
    bitonic_merge16_desc(k, p);
}
__device__ __forceinline__ int f2sort(float f) { const int b = __builtin_bit_cast(int, f); return b ^ ((b >> 31) & 0x7fffffff); }
__device__ __forceinline__ float sort2f(int s) { return __builtin_bit_cast(float, s ^ ((s >> 31) & 0x7fffffff)); }
__device__ __forceinline__ void cei(int& a, int& b) { const int mx = a > b ? a : b, mn = a > b ? b : a; a = mx; b = mn; }
template <int N> __device__ __forceinline__ void bitonic_sort_desc_i(int (&k)[N]) {
#pragma unroll
    for (int size = 2; size <= N; size <<= 1)
#pragma unroll
        for (int stride = size >> 1; stride > 0; stride >>= 1)
#pragma unroll
            for (int i = 0; i < N; ++i) { const int j = i ^ stride; if (j > i) { if ((i & size) == 0) cei(k[i], k[j]); else cei(k[j], k[i]); } }
}
#define CE16(a, b) cei(k[B + (a)], k[B + (b)]);
template <int B> __device__ __forceinline__ void sort16_desc_i(int (&k)[32]) { CE16(0,1) CE16(2,3) CE16(0,2) CE16(1,3) CE16(1,2) CE16(4,5) CE16(6,7) CE16(4,6) CE16(5,7) CE16(5,6) CE16(0,4) CE16(2,6) CE16(2,4) CE16(1,5) CE16(3,7) CE16(3,5) CE16(1,2) CE16(3,4) CE16(5,6) CE16(8,9) CE16(10,11) CE16(8,10) CE16(9,11) CE16(9,10) CE16(12,13) CE16(14,15) CE16(12,14) CE16(13,15) CE16(13,14) CE16(8,12) CE16(10,14) CE16(10,12) CE16(9,13) CE16(11,15) CE16(11,13) CE16(9,10) CE16(11,12) CE16(13,14) CE16(0,8) CE16(4,12) CE16(4,8) CE16(2,10) CE16(6,14) CE16(6,10) CE16(2,4) CE16(6,8) CE16(10,12) CE16(1,9) CE16(5,13) CE16(5,9) CE16(3,11) CE16(7,15) CE16(7,11) CE16(3,5) CE16(7,9) CE16(11,13) CE16(1,2) CE16(3,4) CE16(5,6) CE16(7,8) CE16(9,10) CE16(11,12) CE16(13,14) }
#undef CE16
__device__ __forceinline__ void merge_partner16_i(int (&k)[16], int mask, int lane) {
    int ok[16];
#pragma unroll
    for (int i = 0; i < 16; ++i) ok[i] = shxi(k[i], mask, lane);
#pragma unroll
    for (int i = 0; i < 16; ++i) k[i] = k[i] > ok[15 - i] ? k[i] : ok[15 - i];
#pragma unroll
    for (int stride = 8; stride > 0; stride >>= 1)
#pragma unroll
        for (int i = 0; i < 16; ++i) { const int j = i ^ stride; if (j > i) cei(k[i], k[j]); }
}
constexpr int SKP = 136;
__device__ __forceinline__ void topk_half(const bf16_t* Q, const LAS bf16_t* SK, int tok0, int lane, int (&tk)[16]) {
    bf16x8 qf[4];
#pragma unroll
    for (int ks = 0; ks < 4; ++ks) qf[ks] = *(const bf16x8*)(Q + (size_t)(tok0 + (lane & 15)) * 2048 + ks * 32 + (lane >> 4) * 8);
    int k[32];
#pragma unroll
    for (int tile = 0; tile < 8; ++tile) { f32x4 acc = (f32x4){0.f, 0.f, 0.f, 0.f};
#pragma unroll
        for (int ks = 0; ks < 4; ++ks) { const bf16x8 kf = *(const LAS bf16x8*)(SK + (tile * 16 + (lane & 15)) * SKP + ks * 32 + (lane >> 4) * 8); acc = __builtin_amdgcn_mfma_f32_16x16x32_bf16(kf, qf[ks], acc, 0, 0, 0); }
#pragma unroll
        for (int rg = 0; rg < 4; ++rg) k[tile * 4 + rg] = (f2sort(acc[rg]) & ~127) | (tile * 16 + (lane >> 4) * 4 + rg); }
    sort16_desc_i<0>(k); sort16_desc_i<16>(k);
#pragma unroll
    for (int i = 0; i < 16; ++i) tk[i] = k[i] > k[31 - i] ? k[i] : k[31 - i];
#pragma unroll
    for (int stride = 8; stride > 0; stride >>= 1)
#pragma unroll
        for (int i = 0; i < 16; ++i) { const int j = i ^ stride; if (j > i) cei(tk[i], tk[j]); }
    merge_partner16_i(tk, 16, lane); merge_partner16_i(tk, 32, lane);
}
#define SELQ(x0, x1, x2, x3) (qd == 0 ? (x0) : (qd == 1 ? (x1) : (qd == 2 ? (x2) : (x3))))
#define CAND(m, i0, j0, i1, j1, i2, j2, i3, j3) do { ck[m] = SELQ(k1[i0] + k2[j0], k1[i1] + k2[j1], k1[i2] + k2[j2], k1[i3] + k2[j3]); \
    cp[m] = SELQ((p1[i0] << 7) | p2[j0], (p1[i1] << 7) | p2[j1], (p1[i2] << 7) | p2[j2], (p1[i3] << 7) | p2[j3]); } while (0)
__device__ __forceinline__ void topk_phase(const KA a_in, LAS unsigned char* lds, int l) {
    const KA a = opaque_ka(a_in); const int tid = opaque_tid(), bid = opaque_bid(); const int lane = tid & 63, wid = tid >> 6;
    const bf16_t* Q = (const bf16_t*)(a.ws() + WS_Z); const bf16_t* SKB = (const bf16_t*)(a.ws() + WS_WB + (size_t)l * WB_LAYER + WB_SK);
    int* EIDX = (int*)(a.ws() + WS_YF); float* GW = (float*)(a.ws() + WS_YB);
    const int qd = lane >> 4; const float NINF = -__builtin_inff();
    LAS bf16_t* SKL = (LAS bf16_t*)lds;
    const int NG = (l == 1) ? 512 : 528, NIT = 8 * NG, per = (NIT + (int)gridDim.x - 1) / (int)gridDim.x, it0 = bid * per, it1 = (it0 + per < NIT) ? it0 + per : NIT;
    int hcur = -1;
    for (int it = it0; it < it1; ++it) {
        const int h = it / NG, g = it - h * NG;
        if (h != hcur) { __syncthreads();
            for (int i = tid; i < 2 * 128 * 16; i += 512) { const int r = i >> 4, c8 = i & 15; *(LAS u32x4*)(SKL + r * SKP + c8 * 8) = *(const u32x4*)(SKB + (size_t)h * 32768 + (size_t)r * 128 + c8 * 8); }
            __syncthreads(); hcur = h; }
        const int tok0 = g * 128 + wid * 16;
        int t1[16], t2[16];
        topk_half(Q + h * 256, SKL, tok0, lane, t1);
        __builtin_amdgcn_sched_barrier(0);
        topk_half(Q + h * 256 + 128, SKL + 128 * SKP, tok0, lane, t2);
        __builtin_amdgcn_sched_barrier(0);
        float k1[16], k2[16]; unsigned p1[16], p2[16];
#pragma unroll
        for (int i = 0; i < 16; ++i) { k1[i] = sort2f(t1[i] & ~127); p1[i] = (unsigned)(t1[i] & 127); k2[i] = sort2f(t2[i] & ~127); p2[i] = (unsigned)(t2[i] & 127); }
        float ck[16]; unsigned cp[16];
        CAND(0, 0, 0, 0, 1, 0, 2, 0, 3); CAND(1, 0, 4, 0, 5, 0, 6, 0, 7); CAND(2, 0, 8, 0, 9, 0, 10, 0, 11); CAND(3, 0, 12, 0, 13, 0, 14, 0, 15);
        CAND(4, 1, 0, 1, 1, 1, 2, 1, 3); CAND(5, 1, 4, 1, 5, 1, 6, 1, 7); CAND(6, 2, 0, 2, 1, 2, 2, 2, 3); CAND(7, 2, 4, 3, 0, 3, 1, 3, 2);
        CAND(8, 3, 3, 4, 0, 4, 1, 4, 2); CAND(9, 5, 0, 5, 1, 6, 0, 6, 1); CAND(10, 7, 0, 7, 1, 8, 0, 9, 0); CAND(11, 10, 0, 11, 0, 12, 0, 13, 0);
        CAND(12, 14, 0, 15, 0, 15, 0, 15, 0); if (qd >= 2) ck[12] = NINF;
        ck[13] = NINF; ck[14] = NINF; ck[15] = NINF; cp[13] = 0u; cp[14] = 0u; cp[15] = 0u;
        sort16_desc_kp(ck, cp);
        merge_partner16(ck, cp, 16, lane); merge_partner16(ck, cp, 32, lane);
        float e[16], sum = 0.f;
#pragma unroll
        for (int i = 0; i < 16; ++i) { e[i] = __expf(ck[i] - ck[0]); sum += e[i]; }
        const float inv = 1.0f / sum;
        if (qd == 0) { const size_t o = (size_t)(tok0 + (lane & 15)) * 128 + h * 16;
            if (PEER_SLICED) { unsigned short* e16 = (unsigned short*)(a.ws() + WS_E16) + o;
                *(u32x4*)e16 = (u32x4){cp[0] | (cp[1] << 16), cp[2] | (cp[3] << 16), cp[4] | (cp[5] << 16), cp[6] | (cp[7] << 16)}; *(u32x4*)(e16 + 8) = (u32x4){cp[8] | (cp[9] << 16), cp[10] | (cp[11] << 16), cp[12] | (cp[13] << 16), cp[14] | (cp[15] << 16)}; }
#pragma unroll
            for (int i = 0; i < 4; ++i) { *(u32x4*)(EIDX + o + 4 * i) = (u32x4){cp[4 * i], cp[4 * i + 1], cp[4 * i + 2], cp[4 * i + 3]}; *(f32x4*)(GW + o + 4 * i) = (f32x4){e[4 * i] * inv, e[4 * i + 1] * inv, e[4 * i + 2] * inv, e[4 * i + 3] * inv}; } }
    }
}

__device__ __forceinline__ void peer_phase(const KA a_in, int l, float* xlat, float* xctx) {
    const KA a = opaque_ka(a_in); const int tid = opaque_tid(); const int lane = tid & 63, gw = opaque_bid() * 8 + (tid >> 6), NGW = gridDim.x * 8;
    const bf16_t* H = (const bf16_t*)(a.ws() + WS_H); const unsigned char* PU = a.ws() + WS_PT; const unsigned char* PV = a.ws() + WS_PT + 16 * MiB;
    const int* EIDX = (const int*)(a.ws() + WS_YF); const float* GW = (const float*)(a.ws() + WS_YB);
    const float* modl = (const float*)(a.ws() + WS_MOD) + (size_t)l * 9 * 6144;
    for (int row = gw; row < M; row += NGW) {
        const bool lat = row < M_LAT; const int bi = lat ? (row >> 13) : 8;
        float hf[16];
        { const u32x4* hp = (const u32x4*)(H + (size_t)row * 1024 + lane * 16); const u32x4 hA = hp[0], hB = hp[1]; f32x4 t0, t1, t2, t3; unpack8(hA, t0, t1); unpack8(hB, t2, t3);
#pragma unroll
          for (int j = 0; j < 4; ++j) { hf[j] = t0[j]; hf[4 + j] = t1[j]; hf[8 + j] = t2[j]; hf[12 + j] = t3[j]; } }
        const int ev[2] = {EIDX[(size_t)row * 128 + lane], EIDX[(size_t)row * 128 + 64 + lane]};
        const float gv[2] = {GW[(size_t)row * 128 + lane], GW[(size_t)row * 128 + 64 + lane]};
        float dv[2] = {0.f, 0.f};
#pragma unroll
        for (int half = 0; half < 2; ++half) {
#pragma unroll 1
            for (int kk0 = 0; kk0 < 64; kk0 += 16) { u32x4 ur[16];
#pragma unroll
                for (int j = 0; j < 16; ++j) { const int e = __builtin_amdgcn_readlane(ev[half], kk0 + j); ur[j] = *(const u32x4*)(PU + (size_t)e * 1024 + lane * 16); }
#pragma unroll
                for (int j = 0; j < 16; ++j) { const int w0 = (int)ur[j][0], w1 = (int)ur[j][1], w2 = (int)ur[j][2], w3 = (int)ur[j][3];
                    const f32x2v p0 = __builtin_amdgcn_cvt_pk_f32_fp8(w0, false), p1 = __builtin_amdgcn_cvt_pk_f32_fp8(w0, true), p2 = __builtin_amdgcn_cvt_pk_f32_fp8(w1, false), p3 = __builtin_amdgcn_cvt_pk_f32_fp8(w1, true);
                    const f32x2v p4 = __builtin_amdgcn_cvt_pk_f32_fp8(w2, false), p5 = __builtin_amdgcn_cvt_pk_f32_fp8(w2, true), p6 = __builtin_amdgcn_cvt_pk_f32_fp8(w3, false), p7 = __builtin_amdgcn_cvt_pk_f32_fp8(w3, true);
                    float s = (p0.x * hf[0] + p0.y * hf[1]) + (p1.x * hf[2] + p1.y * hf[3]); s += (p2.x * hf[4] + p2.y * hf[5]) + (p3.x * hf[6] + p3.y * hf[7]);
                    s += (p4.x * hf[8] + p4.y * hf[9]) + (p5.x * hf[10] + p5.y * hf[11]); s += (p6.x * hf[12] + p6.y * hf[13]) + (p7.x * hf[14] + p7.y * hf[15]);
                    s = wave_sum(s, lane); dv[half] = (lane == kk0 + j) ? s : dv[half]; } }
        }
        float act[2];
#pragma unroll
        for (int half = 0; half < 2; ++half) act[half] = gelu_erf(dv[half] * (1.0f / PU_SCALE)) * gv[half];
        float acc[16];
#pragma unroll
        for (int j = 0; j < 16; ++j) acc[j] = 0.f;
#pragma unroll
        for (int half = 0; half < 2; ++half) {
#pragma unroll 1
            for (int kk0 = 0; kk0 < 64; kk0 += 16) { u32x4 vr[16];
#pragma unroll
                for (int j = 0; j < 16; ++j) { const int e = __builtin_amdgcn_readlane(ev[half], kk0 + j); vr[j] = *(const u32x4*)(PV + (size_t)e * 1024 + lane * 16); }
#pragma unroll
                for (int j = 0; j < 16; ++j) { const float aw = __builtin_bit_cast(float, __builtin_amdgcn_readlane(__builtin_bit_cast(int, act[half]), kk0 + j));
                    const int w0 = (int)vr[j][0], w1 = (int)vr[j][1], w2 = (int)vr[j][2], w3 = (int)vr[j][3];
                    const f32x2v p0 = __builtin_amdgcn_cvt_pk_f32_fp8(w0, false), p1 = __builtin_amdgcn_cvt_pk_f32_fp8(w0, true), p2 = __builtin_amdgcn_cvt_pk_f32_fp8(w1, false), p3 = __builtin_amdgcn_cvt_pk_f32_fp8(w1, true);
                    const f32x2v p4 = __builtin_amdgcn_cvt_pk_f32_fp8(w2, false), p5 = __builtin_amdgcn_cvt_pk_f32_fp8(w2, true), p6 = __builtin_amdgcn_cvt_pk_f32_fp8(w3, false), p7 = __builtin_amdgcn_cvt_pk_f32_fp8(w3, true);
                    acc[0] += aw * p0.x; acc[1] += aw * p0.y; acc[2] += aw * p1.x; acc[3] += aw * p1.y; acc[4] += aw * p2.x; acc[5] += aw * p2.y; acc[6] += aw * p3.x; acc[7] += aw * p3.y;
                    acc[8] += aw * p4.x; acc[9] += aw * p4.y; acc[10] += aw * p5.x; acc[11] += aw * p5.y; acc[12] += aw * p6.x; acc[13] += aw * p6.y; acc[14] += aw * p7.x; acc[15] += aw * p7.y; } }
        }
        float* xr = (lat ? xlat + (size_t)row * 1024 : xctx + (size_t)(row - M_LAT) * 1024) + lane * 16;
        const float* gt = modl + bi * 6144 + 5 * 1024 + lane * 16;
        f32x4 xv[4]; float ss = 0.f;
#pragma unroll
        for (int q = 0; q < 4; ++q) { const f32x4 g4 = ((const f32x4*)gt)[q]; f32x4 x4 = ((f32x4*)xr)[q];
            x4 += g4 * ((f32x4){acc[4 * q], acc[4 * q + 1], acc[4 * q + 2], acc[4 * q + 3]} * (1.0f / PV_SCALE)); xv[q] = x4; ss += (x4[0] * x4[0] + x4[1] * x4[1]) + (x4[2] * x4[2] + x4[3] * x4[3]); }
        const float rs = rsqrtf(wave_sum(ss, lane) * (1.f / 1024.f) + 1e-6f);
        if (l == 0) {
#pragma unroll
            for (int q = 0; q < 4; ++q) ((f32x4*)xr)[q] = xv[q];
            const float* g1n = a.in(I_N1G) + 1024 + lane * 16; const float* m1 = (const float*)(a.ws() + WS_MOD) + (size_t)9 * 6144 + bi * 6144 + lane * 16;
            f32x4 y[4];
#pragma unroll
            for (int q = 0; q < 4; ++q) y[q] = xv[q] * rs * ((const f32x4*)g1n)[q] * (((const f32x4*)(m1 + 1024))[q] + 1.0f) + ((const f32x4*)m1)[q];
            u32x4* hb = (u32x4*)((bf16_t*)(a.ws() + WS_H) + (size_t)row * 1024 + lane * 16); hb[0] = pack8(y[0], y[1]); hb[1] = pack8(y[2], y[3]);
        } else if (lat) { const float* fg = a.in(I_FG) + lane * 16;
#pragma unroll
            for (int q = 0; q < 4; ++q) ((f32x4*)xr)[q] = xv[q] * rs * ((const f32x4*)fg)[q]; }
    }
}

__device__ __forceinline__ u32x6 load24(const unsigned char* p) { const u32x4 x = *(const u32x4_a8*)p; const u32x2 y = *(const u32x2*)(p + 16); return (u32x6){x.x, x.y, x.z, x.w, y.x, y.y}; }
__device__ __forceinline__ void peer_phase6(const KA a_in, int l, float* xlat, float* xctx) {
    const KA a = opaque_ka(a_in); const int tid = opaque_tid(); const int lane = tid & 63, gw = opaque_bid() * 8 + (tid >> 6), NGW = gridDim.x * 8;
    const int hb = lane >> 5, li = lane & 31, c = lane & 15;
    const bf16_t* H = (const bf16_t*)(a.ws() + WS_H); const unsigned char* PU = a.ws() + WS_PT; const unsigned char* PV = a.ws() + WS_PT + PT_V6; const f32x2v* SC = (const f32x2v*)(a.ws() + WS_PT + PT_SC);
    const int* EIDX = (const int*)(a.ws() + WS_YF); const float* GW = (const float*)(a.ws() + WS_YB);
    const float* modl = (const float*)(a.ws() + WS_MOD) + (size_t)l * 9 * 6144;
    bf16x4 SELA, SELB, ONES4;
    { u32x2 w; w.x = (c == hb ? 0x3F80u : 0u) | (c == 2 + hb ? 0x3F800000u : 0u); w.y = (c == 4 + hb ? 0x3F80u : 0u) | (c == 6 + hb ? 0x3F800000u : 0u); SELA = __builtin_bit_cast(bf16x4, w);
      w.x = (c == 8 + hb ? 0x3F80u : 0u) | (c == 10 + hb ? 0x3F800000u : 0u); w.y = (c == 12 + hb ? 0x3F80u : 0u) | (c == 14 + hb ? 0x3F800000u : 0u); SELB = __builtin_bit_cast(bf16x4, w);
      w.x = 0x3F803F80u; w.y = 0x3F803F80u; ONES4 = __builtin_bit_cast(bf16x4, w); }
    const f32x4 z4 = (f32x4){0.f, 0.f, 0.f, 0.f};
    for (int row = gw; row < ((l == 1) ? M_LAT : M); row += NGW) {
        const bool lat = row < M_LAT; const int bi = lat ? (row >> 13) : 8;
        unsigned hx[16];
        { const u32x4* hp = (const u32x4*)(H + (size_t)row * 1024 + li * 32);
#pragma unroll
          for (int q = 0; q < 4; ++q) { const u32x4 w = hp[q]; hx[4 * q] = w.x; hx[4 * q + 1] = w.y; hx[4 * q + 2] = w.z; hx[4 * q + 3] = w.w; } }
        f32x32 acc;
#pragma unroll
        for (int i = 0; i < 32; ++i) acc[i] = 0.f;
#pragma unroll 1
        for (int b = 0; b < 8; ++b) {
            const int ec = EIDX[(size_t)row * 128 + 16 * b + c]; const float gate = GW[(size_t)row * 128 + 16 * b + c];
            u32x6 ur[8], vr[8];
#pragma unroll
            for (int q = 0; q < 8; ++q) { const int em = __builtin_amdgcn_ds_bpermute((2 * q + hb) << 2, ec); const unsigned off = (unsigned)em * 768u + (unsigned)li * 24u; ur[q] = load24(PU + off); vr[q] = load24(PV + off); }
            const f32x2v sc = SC[ec];
            float part[8];
#pragma unroll
            for (int q = 0; q < 8; ++q) { const u32x16 u = __builtin_bit_cast(u32x16, __builtin_amdgcn_cvt_scalef32_pk32_bf16_fp6(ur[q], 1.0f)); float s0 = 0.f, s1 = 0.f, s2 = 0.f, s3 = 0.f;
#pragma unroll
                for (int j = 0; j < 16; j += 4) { s0 = dot2bf(u[j], hx[j], s0); s1 = dot2bf(u[j + 1], hx[j + 1], s1); s2 = dot2bf(u[j + 2], hx[j + 2], s2); s3 = dot2bf(u[j + 3], hx[j + 3], s3); }
                part[q] = (s0 + s1) + (s2 + s3); __builtin_amdgcn_sched_barrier(0); }
            f32x4 D1 = mfma16(pk4(part[0], part[1], part[2], part[3]), SELA, z4); D1 = mfma16(pk4(part[4], part[5], part[6], part[7]), SELB, D1);
            const f32x4 D2 = mfma16(ONES4, pk4v(D1), z4);
            const float act = gelu_erf(D2[0] * sc.x) * gate * sc.y;
#pragma unroll
            for (int q = 0; q < 8; ++q) { const float aw = __builtin_bit_cast(float, __builtin_amdgcn_ds_bpermute((2 * q + hb) << 2, __builtin_bit_cast(int, act)));
                u32x6 vq = vr[q]; asm volatile("" : "+v"(vq), "+v"(acc));
                const f32x32 v = __builtin_amdgcn_cvt_scalef32_pk32_f32_fp6(vq, 1.0f);
                acc += v * aw; }
        }
        float tot[16];
#pragma unroll
        for (int i = 0; i < 16; ++i) { float lo = acc[i], hi = acc[16 + i]; asm volatile("" : "+v"(lo), "+v"(hi));
            const float snd = hb ? lo : hi, mine = hb ? hi : lo; tot[i] = mine + shxf(snd, 32, lane); }
        const int cb = 32 * li + 16 * hb;
        float* xr = (lat ? xlat + (size_t)row * 1024 : xctx + (size_t)(row - M_LAT) * 1024) + cb;
        const float* gt = modl + bi * 6144 + 5 * 1024 + cb;
        f32x4 xv[4]; float ss = 0.f;
#pragma unroll
        for (int q = 0; q < 4; ++q) { const f32x4 g4 = ((const f32x4*)gt)[q]; f32x4 x4 = ((f32x4*)xr)[q];
            x4 += g4 * (f32x4){tot[4 * q], tot[4 * q + 1], tot[4 * q + 2], tot[4 * q + 3]}; xv[q] = x4; ss += (x4[0] * x4[0] + x4[1] * x4[1]) + (x4[2] * x4[2] + x4[3] * x4[3]); }
        const float rs = rsqrtf(wave_sum(ss, lane) * (1.f / 1024.f) + 1e-6f);
        if (l == 0) {
#pragma unroll
            for (int q = 0; q < 4; ++q) ((f32x4*)xr)[q] = xv[q];
            const float* g1n = a.in(I_N1G) + 1024 + cb; const float* m1 = (const float*)(a.ws() + WS_MOD) + (size_t)9 * 6144 + bi * 6144 + cb;
            f32x4 y[4];
#pragma unroll
            for (int q = 0; q < 4; ++q) y[q] = xv[q] * rs * ((const f32x4*)g1n)[q] * (((const f32x4*)(m1 + 1024))[q] + 1.0f) + ((const f32x4*)m1)[q];
            u32x4* hbp = (u32x4*)((bf16_t*)(a.ws() + WS_H) + (size_t)row * 1024 + cb); hbp[0] = pack8(y[0], y[1]); hbp[1] = pack8(y[2], y[3]);
        } else if (lat) { const float* fg = a.in(I_FG) + cb;
#pragma unroll
            for (int q = 0; q < 4; ++q) ((f32x4*)xr)[q] = xv[q] * rs * ((const f32x4*)fg)[q]; }
    }
}

__device__ __forceinline__ void peer_dots(const KA a_in, int l) {
    const KA a = opaque_ka(a_in); const int tid = opaque_tid(), bid = opaque_bid(); const int lane = tid & 63, wid = tid >> 6, grp = lane >> 2, seg = lane & 3;
    const int xs = bid & 7, nblk = ((int)gridDim.x - xs + 7) >> 3, NW = nblk * 8, w0 = (bid >> 3) * 8 + wid, MR = (l == 1) ? M_LAT : M;
    const unsigned char* PU = a.ws() + WS_PT + (size_t)xs * PT_SLICE + seg * 24; const bf16_t* H = (const bf16_t*)(a.ws() + WS_H) + 128 * xs + 32 * seg;
    const unsigned short* EIDX = (const unsigned short*)(a.ws() + WS_E16) + grp; bf16_t* P = (bf16_t*)(a.ws() + WS_PP) + (size_t)xs * M * 128 + 32 * seg + grp;
    auto meta = [&](int t, int (&ec)[8]) { const int tc = (t < MR) ? t : MR - 1;
#pragma unroll
        for (int gI = 0; gI < 8; ++gI) ec[gI] = EIDX[(size_t)tc * 128 + 16 * gI]; };
    auto issue = [&](int t, const int (&ec)[8], u32x6 (&ur)[8], u32x4 (&hq)[4]) { const int tc = (t < MR) ? t : MR - 1;
#pragma unroll
        for (int gI = 0; gI < 8; ++gI) ur[gI] = load24(PU + (unsigned)ec[gI] * 128u);
#pragma unroll
        for (int q = 0; q < 4; ++q) hq[q] = ((const u32x4*)(H + (size_t)tc * 1024))[q]; };
    auto compute = [&](int t, const u32x6 (&ur)[8], const u32x4 (&hq)[4]) {
        unsigned hx[16];
#pragma unroll
        for (int q = 0; q < 4; ++q) { hx[4 * q] = hq[q].x; hx[4 * q + 1] = hq[q].y; hx[4 * q + 2] = hq[q].z; hx[4 * q + 3] = hq[q].w; }
        float sm[8];
#pragma unroll
        for (int gI = 0; gI < 8; ++gI) { const u32x16 u = __builtin_bit_cast(u32x16, __builtin_amdgcn_cvt_scalef32_pk32_bf16_fp6(ur[gI], 1.0f)); float s0 = 0.f, s1 = 0.f, s2 = 0.f, s3 = 0.f;
#pragma unroll
            for (int j = 0; j < 16; j += 4) { s0 = dot2bf(u[j], hx[j], s0); s1 = dot2bf(u[j + 1], hx[j + 1], s1); s2 = dot2bf(u[j + 2], hx[j + 2], s2); s3 = dot2bf(u[j + 3], hx[j + 3], s3); }
            float pz = (s0 + s1) + (s2 + s3); pz += dpp_f<0xB1>(pz); pz += dpp_f<0x4E>(pz); sm[gI] = pz; __builtin_amdgcn_sched_barrier(0); }
        const float t01 = (seg & 1) ? sm[2] : sm[0], t23 = (seg & 1) ? sm[6] : sm[4], o0 = (seg & 2) ? t23 : t01;
        const float u01 = (seg & 1) ? sm[3] : sm[1], u23 = (seg & 1) ? sm[7] : sm[5], o1 = (seg & 2) ? u23 : u01;
        if (t < MR) { bf16_t* pr = P + (size_t)t * 128; pr[0] = f2b(o0); pr[16] = f2b(o1); } };
    int e0[8], e1[8]; u32x6 uA[8], uB[8]; u32x4 hA[4], hB[4];
    meta(w0, e0); meta(w0 + NW, e1); asm volatile("" ::: "memory");
    issue(w0, e0, uA, hA); asm volatile("" ::: "memory");
#pragma unroll 1
    for (int t = w0; t < MR; t += 2 * NW) {
        meta(t + 2 * NW, e0); asm volatile("" ::: "memory"); issue(t + NW, e1, uB, hB); asm volatile("" ::: "memory"); compute(t, uA, hA); asm volatile("" ::: "memory");
        meta(t + 3 * NW, e1); asm volatile("" ::: "memory"); issue(t + 2 * NW, e0, uA, hA); asm volatile("" ::: "memory"); compute(t + NW, uB, hB); asm volatile("" ::: "memory");
    }
}
__device__ __forceinline__ void peer_act(const KA a_in, int l) {
    const KA a = opaque_ka(a_in); const size_t gt = (size_t)opaque_bid() * 512 + opaque_tid(), NT = (size_t)gridDim.x * 512, tot = (size_t)((l == 1) ? M_LAT : M) * 128;
    const bf16_t* P = (const bf16_t*)(a.ws() + WS_PP); const int* EIDX = (const int*)(a.ws() + WS_YF); const float* GW = (const float*)(a.ws() + WS_YB); const f32x2v* SC = (const f32x2v*)(a.ws() + WS_PT + PT_SC);
    bf16_t* ACT = (bf16_t*)(a.ws() + WS_ACT);
    for (size_t i = gt; i < tot; i += NT) { float h = 0.f;
#pragma unroll
        for (int x = 0; x < 8; ++x) h += __builtin_bit_cast(float, (unsigned)P[(size_t)x * M * 128 + i] << 16);
        const int e = EIDX[i]; const f32x2v sc = SC[e]; ACT[i] = f2b(gelu_erf(h * sc.x) * GW[i] * sc.y); }
}
__device__ __forceinline__ void peer_mix(const KA a_in, int l, float* xlat, float* xctx) {
    const KA a = opaque_ka(a_in); const int tid = opaque_tid(), bid = opaque_bid(); const int lane = tid & 63, wid = tid >> 6, grp = lane >> 2, seg = lane & 3;
    const int xs = bid & 7, nblk = ((int)gridDim.x - xs + 7) >> 3, NW = nblk * 8, w0 = (bid >> 3) * 8 + wid, MR = (l == 1) ? M_LAT : M;
    const unsigned char* PV = a.ws() + WS_PT + PT_V6 + (size_t)xs * PT_SLICE;
    const unsigned char* EB = a.ws() + WS_E16; const unsigned char* AB = a.ws() + WS_ACT;
    const int col = 128 * xs + 2 * lane;
    bf16x4 TSEL;
    { const int sg = lane & 3; u32x2 w; w.x = (sg == 0 ? 0x3F80u : 0u) | (sg == 1 ? 0x3F800000u : 0u); w.y = (sg == 2 ? 0x3F80u : 0u) | (sg == 3 ? 0x3F800000u : 0u); TSEL = __builtin_bit_cast(bf16x4, w); }
    const float* modc = (const float*)(a.ws() + WS_MOD) + (size_t)l * 9 * 6144 + 5 * 1024;
    auto meta = [&](int t, int (&ec)[8]) { const int tc = (t < MR) ? t : MR - 1;
#pragma unroll
        for (int gI = 0; gI < 8; ++gI) ec[gI] = *(const unsigned short*)(EB + ((unsigned)tc * 128u + 16u * gI + (unsigned)grp) * 2u); };
    auto xrow = [&](int t) -> float* { const bool lat = t < M_LAT; return (lat ? xlat + (size_t)t * 1024 : xctx + (size_t)(t - M_LAT) * 1024) + col; };
    const bf16_t* xb_in = (const bf16_t*)xlat; bf16_t* xb_out = (l == 1) ? (bf16_t*)(a.ws() + WS_X4) : (bf16_t*)xlat;
    auto issue = [&](int t, const int (&ec)[8], u32x6 (&vr)[8], float (&aw)[8], f32x2& xv, f32x2& g2) { const int tc = (t < MR) ? t : MR - 1;
#pragma unroll
        for (int gI = 0; gI < 8; ++gI) vr[gI] = load24(PV + ((unsigned)ec[gI] * 128u + (unsigned)seg * 24u));
#pragma unroll
        for (int gI = 0; gI < 8; ++gI) aw[gI] = __builtin_bit_cast(float, (unsigned)*(const unsigned short*)(AB + ((unsigned)tc * 128u + 16u * gI + (unsigned)grp) * 2u) << 16);
        const int bi = (tc < M_LAT) ? (tc >> 13) : 8;
        if (XBF16) { const int tl = (tc < M_LAT) ? tc : M_LAT - 1, tx = (tc >= M_LAT) ? tc - M_LAT : 0; const unsigned w = *(const unsigned*)((const unsigned char*)xb_in + ((unsigned)tl * 2048u + (unsigned)col * 2u)); const f32x2 xc = *(const f32x2*)((const unsigned char*)xctx + ((unsigned)tx * 4096u + (unsigned)col * 4u));
            xv = (tc < M_LAT) ? (f32x2){bf_lo(w), bf_hi(w)} : xc; } else xv = *(const f32x2*)xrow(tc);
        g2 = *(const f32x2*)((const unsigned char*)modc + ((unsigned)bi * 24576u + (unsigned)col * 4u)); };
    auto compute = [&](int t, const u32x6 (&vr)[8], const float (&aw)[8], f32x2 xv, const f32x2 g2) {
        f32x32 acc;
#pragma unroll
        for (int i = 0; i < 32; ++i) acc[i] = 0.f;
#pragma unroll
        for (int gI = 0; gI < 8; ++gI) { u32x6 vq = vr[gI]; asm volatile("" : "+v"(vq), "+v"(acc));
            const f32x32 v = __builtin_amdgcn_cvt_scalef32_pk32_f32_fp6(vq, 1.0f); acc += v * aw[gI]; }
        const f32x4 z4 = (f32x4){0.f, 0.f, 0.f, 0.f}; f32x4 D1a = z4, D1b = z4;
#pragma unroll
        for (int q = 0; q < 4; ++q) { const u32x2 tw = __builtin_bit_cast(u32x2, TSEL); const bool on = ((lane >> 2) & 3) == q; u32x2 sw; sw.x = on ? tw.x : 0u; sw.y = on ? tw.y : 0u; const bf16x4 selq = __builtin_bit_cast(bf16x4, sw);
            D1a = mfma16(pk4(acc[8 * q], acc[8 * q + 2], acc[8 * q + 4], acc[8 * q + 6]), selq, D1a); D1b = mfma16(pk4(acc[8 * q + 1], acc[8 * q + 3], acc[8 * q + 5], acc[8 * q + 7]), selq, D1b); }
        const f32x4 D2a = mfma16(TSEL, pk4v(D1a), z4), D2b = mfma16(TSEL, pk4v(D1b), z4);
        float r2[2];
        { const int g = lane >> 4; const float a01 = (g & 1) ? D2a[1] : D2a[0], a23 = (g & 1) ? D2a[3] : D2a[2], b01 = (g & 1) ? D2b[1] : D2b[0], b23 = (g & 1) ? D2b[3] : D2b[2]; r2[0] = (g & 2) ? a23 : a01; r2[1] = (g & 2) ? b23 : b01; }
        xv[0] += g2[0] * r2[0]; xv[1] += g2[1] * r2[1];
        if (t < MR) { if (XBF16 && t < M_LAT) *(unsigned*)((unsigned char*)xb_out + ((unsigned)t * 2048u + (unsigned)col * 2u)) = pk_bf16(xv[0], xv[1]); else *(f32x2*)xrow(t) = xv; } };
    int e0[8], e1[8]; u32x6 vA[8], vB[8]; float aA[8], aB[8]; f32x2 xA, xB, gA, gB;
    meta(w0, e0); meta(w0 + NW, e1); asm volatile("" ::: "memory");
    issue(w0, e0, vA, aA, xA, gA); asm volatile("" ::: "memory");
#pragma unroll 1
    for (int t = w0; t < MR; t += 2 * NW) {
        meta(t + 2 * NW, e0); asm volatile("" ::: "memory"); issue(t + NW, e1, vB, aB, xB, gB); asm volatile("" ::: "memory"); compute(t, vA, aA, xA, gA); asm volatile("" ::: "memory");
        meta(t + 3 * NW, e1); asm volatile("" ::: "memory"); issue(t + 2 * NW, e0, vA, aA, xA, gA); asm volatile("" ::: "memory"); compute(t + NW, vB, aB, xB, gB); asm volatile("" ::: "memory");
    }
}

#if PROBE_HI > 0
#ifndef CHECK_SUB
#define CHECK_SUB 0
#endif
#ifndef CHECK_ROUND
#define CHECK_ROUND 2
#endif
__device__ __forceinline__ float bfbits2f(bf16_t b) { return __uint_as_float(((unsigned)b) << 16); }
__device__ __forceinline__ bool bad_rel(float got, float ref, float rel, float abs_) { const float d = fabsf(got - ref); return !(d <= rel * fabsf(ref) + abs_); }
__device__ __forceinline__ void check_phase(const KA a) {
    if (blockIdx.x != 0) return;
    __shared__ unsigned fm[4];
    const int t = threadIdx.x;
    if (t < 4) fm[t] = 0u;
    __syncthreads();
    unsigned char* ws = a.ws();
#if CHECK_ROUND == 1
    {
        const int b = t % 9, j = (t * 37) % 6144; const float* cv = (b < 8) ? a.in(I_C) + b * 1024 : a.in(I_CCTX);
        float s = a.in(I_ADAB)[j];
        for (int k = 0; k < 1024; ++k) { const float c = cv[k]; s += (c / (1.f + expf(-c))) * a.in(I_ADAW)[(size_t)k * 6144 + j]; }
        const float got = ((const float*)(ws + WS_MOD))[b * 6144 + j];
        if (bad_rel(got, s, 2e-3f, 2e-3f)) atomicOr(&fm[0], 1u);
    }
    {
        const int row = (int)(((long)t * 131071) % M), col = (t * 17) % 1024;
        const bool lat = row < M_LAT; const int bi = lat ? (row >> 13) : 8;
        const float* xr = lat ? a.in(I_X) + (size_t)row * 1024 : a.in(I_CTX) + (size_t)(row - M_LAT) * 1024;
        float ms = 0.f; for (int k = 0; k < 1024; ++k) ms += xr[k] * xr[k];
        const float rs = 1.0f / sqrtf(ms / 1024.f + 1e-6f);
        const float* modl = (const float*)(ws + WS_MOD);
        const float y = xr[col] * rs * a.in(I_N1G)[col] * (1.f + modl[bi * 6144 + 1024 + col]) + modl[bi * 6144 + col];
        const bf16_t* HB = (const bf16_t*)(ws + WS_H);
        if (bad_rel(bfbits2f(HB[(size_t)row * 1024 + col]), y, 1e-2f, 1e-2f)) atomicOr(&fm[1], 1u);
        const int zc = (t * 29) % 3488; float z = 0.f;
        for (int k = 0; k < 1024; ++k) z += bfbits2f(HB[(size_t)row * 1024 + k]) * a.in(I_WIN)[(size_t)k * P_IN + zc];
        const bf16_t* ZR = (const bf16_t*)(ws + WS_Z);
        if (bad_rel(bfbits2f(ZR[(size_t)row * NZR + zc]), z, 2e-2f, 4e-2f)) atomicOr(&fm[2], 1u);
        const int n = (t * 7) % 3488, k = (t * 13) % 1024; const bf16_t* WrT = (const bf16_t*)(ws + WS_WB + WB_WR);
        const unsigned want = pk_bf16(a.in(I_WIN)[(size_t)k * P_IN + n], 0.f) & 0xffffu;
        if ((unsigned)WrT[(size_t)n * 1024 + k] != want) atomicOr(&fm[3], 1u);
    }
#endif

#if CHECK_ROUND == 2
    {
        const int wv = t >> 6, lane = t & 63;
        if (wv < 2) {
            const int b = 1, h = 3, d = wv, l = 0;
            __shared__ float sh[2][8][64];
            __shared__ float Sst[2][64][65];
            float* S = &Sst[wv][lane][0];
            float (*L)[64] = sh[wv];
            const bf16_t* ZR = (const bf16_t*)(ws + WS_Z); const float* smu = a.in(I_SMU) + (size_t)l * 2 * P_RWKV;
            const bf16_t* Yd = (const bf16_t*)(ws + (d ? WS_YB : WS_YF)); const float* BON = (const float*)(ws + WS_BON);
            const int hc = h * 64 + lane;
            const int cols[5] = {hc, 1024 + hc, 2048 + hc, C_W1 + d * 64 + lane, C_A1 + d * 64 + lane};
#pragma nounroll
            for (int k = 0; k < 64; ++k) S[k] = 0.f;
            bool bad = false, badb = false; float l2n = 0.f, l2d = 0.f;
            for (int step = 0; step < 296; ++step) {
                const int seg = step >= 256, p = seg ? step - 256 : step, len = seg ? SEQ : CTXL; const int base = seg ? b * SEQ : M_LAT + b * CTXL;
                const int tt = d ? len - 1 - p : p;
                float z[5];
#pragma unroll
                for (int g = 0; g < 5; ++g) { const int c = cols[g];
                    const float zc = bfbits2f(ZR[(size_t)(base + tt) * NZR + c]);
                    const float zp = tt > 0 ? bfbits2f(ZR[(size_t)(base + tt - 1) * NZR + c]) : 0.f;
                    const float zn = tt < len - 1 ? bfbits2f(ZR[(size_t)(base + tt + 1) * NZR + c]) : 0.f;
                    z[g] = zc + smu[c] * (zp - zc) + smu[P_RWKV + c] * (zn - zc); }
                L[0][lane] = tanhf(z[3]); L[1][lane] = z[4];
                __builtin_amdgcn_wave_barrier(); asm volatile("s_waitcnt lgkmcnt(0)" ::: "memory");
                float wl = a.in(I_W0)[(l * 2 + d) * 1024 + hc], al = a.in(I_A0)[(l * 2 + d) * 1024 + hc];
#pragma nounroll
                for (int j = 0; j < 64; ++j) { wl += L[0][j] * a.in(I_W2)[((size_t)(l * 2 + d) * 64 + j) * 1024 + hc]; al += L[1][j] * a.in(I_A2)[((size_t)(l * 2 + d) * 64 + j) * 1024 + hc]; }
                const float wlog = -log1pf(expf(-wl)) - 0.5f; const float dec = expf(-expf(wlog));
                const float av = 1.f / (1.f + expf(-al));
                const float kkr = z[1] * a.in(I_KK)[l * 1024 + hc];
                L[7][lane] = kkr * kkr;
                __builtin_amdgcn_wave_barrier(); asm volatile("s_waitcnt lgkmcnt(0)" ::: "memory");
                float n2 = 0.f; for (int j = 0; j < 64; ++j) n2 += L[7][j];
                const float kk = kkr / fmaxf(sqrtf(n2), 1e-12f);
                const float kd = z[1] * (1.f + (av - 1.f) * a.in(I_KA)[l * 1024 + hc]);
                L[2][lane] = kk; L[3][lane] = kk * av; L[4][lane] = kd; L[5][lane] = z[0]; L[6][lane] = dec;
                __builtin_amdgcn_wave_barrier(); asm volatile("s_waitcnt lgkmcnt(0)" ::: "memory");
                float sa = 0.f;
#pragma nounroll
                for (int k = 0; k < 64; ++k) sa += S[k] * L[2][k];
                float y = 0.f, bon = 0.f;
#pragma nounroll
                for (int k = 0; k < 64; ++k) { S[k] = S[k] * L[6][k] - sa * L[3][k] + z[2] * L[4][k]; y += S[k] * L[5][k]; }
                for (int k = 0; k < 64; ++k) bon += L[5][k] * L[4][k] * a.in(I_RK)[l * 1024 + h * 64 + k];
                if (step >= 200) {
                    const float got = bfbits2f(Yd[(size_t)(base + tt) * 1024 + hc]);
                    if (bad_rel(got, y, 1.2e-2f, 0.06f)) bad = true; l2n += (got - y) * (got - y); l2d += y * y;
                    const float gb = BON[((size_t)d * M + base + tt) * 16 + h];
                    if (bad_rel(gb, bon, 2e-2f, 2e-2f)) badb = true;
                }
                __builtin_amdgcn_wave_barrier(); asm volatile("s_waitcnt lgkmcnt(0)" ::: "memory");
            }
            if (bad) atomicOr(&fm[d], 1u);
            if (badb) atomicOr(&fm[2 + d], 1u);
            { __shared__ float l2s[2][2]; if (lane == 0) { l2s[wv][0] = 0.f; l2s[wv][1] = 0.f; } __builtin_amdgcn_wave_barrier(); atomicAdd(&l2s[wv][0], l2n); atomicAdd(&l2s[wv][1], l2d); __builtin_amdgcn_wave_barrier();
              if (lane == 0) { const float re = sqrtf(l2s[wv][0] / fmaxf(l2s[wv][1], 1e-30f)); const unsigned bk = re < 0.005f ? 0u : (re < 0.01f ? 1u : (re < 0.02f ? 2u : (re < 0.05f ? 3u : 4u))); ((unsigned*)(ws + WS_CTL))[10 + wv] = bk; } }
        }
    }
#endif
#if CHECK_ROUND == 3
    {
        const int row = (int)(((long)t * 131071) % M), ch = (t * 17) % 1024, gc = (t * 23) % 2048;
        const bf16_t* HB = (const bf16_t*)(ws + WS_H); const bf16_t* WgT = (const bf16_t*)(ws + WS_WB + WB_WG);
        { const int n = (t * 7) % 2048, k = (t * 13) % 1024; const unsigned want = pk_bf16(a.in(I_WIN)[(size_t)k * P_IN + P_RWKV + 2048 + n], 0.f) & 0xffffu;
          if ((unsigned)WgT[(size_t)n * 1024 + k] != want) atomicOr(&fm[0], 1u); }
        float z1 = 0.f, z2 = 0.f, zg = 0.f, zg2 = 0.f;
        for (int k = 0; k < 1024; ++k) { const float hv = bfbits2f(HB[(size_t)row * 1024 + k]); const float* wr = a.in(I_WIN) + (size_t)k * P_IN;
            z1 += hv * wr[P_RWKV + ch]; z2 += hv * wr[P_RWKV + 1024 + ch]; zg += hv * wr[P_RWKV + 2048 + gc]; zg2 += hv * bfbits2f(WgT[(size_t)gc * 1024 + k]); }
        const float u = z1 / (1.f + expf(-z2)), g = 1.f / (1.f + expf(-(zg + a.in(I_GATEB)[gc]))), g2 = 1.f / (1.f + expf(-(zg2 + a.in(I_GATEB)[gc])));
        const bf16_t* U = (const bf16_t*)(ws + WS_Z); const bf16_t* G = (const bf16_t*)(ws + WS_Z + 132 * MiB);
        if (bad_rel(bfbits2f(G[(size_t)row * 2048 + gc]), g2, 2e-2f, 1e-2f)) atomicOr(&fm[1], 1u);
        if (bad_rel(bfbits2f(U[(size_t)row * 1024 + ch]), u, 3e-2f, 3e-2f)) atomicOr(&fm[2], 1u);
        if (bad_rel(bfbits2f(G[(size_t)row * 2048 + gc]), g, 2e-2f, 1e-2f)) atomicOr(&fm[3], 1u);
    }
#endif

#if CHECK_ROUND == 4
    {
        __shared__ unsigned cnt; __shared__ unsigned mx;
        if (t == 0) { cnt = 0u; mx = 0u; }
        __syncthreads();
        const bf16_t* HB = (const bf16_t*)(ws + WS_H); const bf16_t* WgT = (const bf16_t*)(ws + WS_WB + WB_WG); const bf16_t* G = (const bf16_t*)(ws + WS_Z + 132 * MiB);
        for (int rep = 0; rep < 4; ++rep) {
            const int sidx = t + 512 * rep; const int row = (int)(((long)sidx * 131071) % M), gc = (sidx * 23) % 2048;
            float zg2 = 0.f;
            for (int k = 0; k < 1024; ++k) zg2 += bfbits2f(HB[(size_t)row * 1024 + k]) * bfbits2f(WgT[(size_t)gc * 1024 + k]);
            const float g2 = 1.f / (1.f + expf(-(zg2 + a.in(I_GATEB)[gc])));
            const float d = fabsf(bfbits2f(G[(size_t)row * 2048 + gc]) - g2);
            if (!(d <= 0.01f)) { atomicAdd(&cnt, 1u); atomicMax(&mx, __float_as_uint(d != d ? 1e9f : d)); }
        }
        __syncthreads();
        if (t == 0) { const unsigned c = cnt; const float m = __uint_as_float(mx);
            const unsigned cb = c == 0 ? 0u : (c <= 2 ? 1u : (c <= 8 ? 2u : (c <= 64 ? 3u : (c <= 512 ? 4u : 5u))));
            const unsigned mb = m < 0.02f ? 0u : (m < 0.05f ? 1u : (m < 0.15f ? 2u : (m < 0.5f ? 3u : 4u)));
            fm[0] = 0; fm[1] = 0; fm[2] = 0; fm[3] = 0; ((unsigned*)(ws + WS_CTL))[9] = 5u * cb + mb; }
        __syncthreads();
    }
#endif

#if CHECK_ROUND == 6
    {
        __shared__ unsigned cnt; __shared__ unsigned mx;
        if (t == 0) { cnt = 0u; mx = 0u; }
        __syncthreads();
        const bf16_t* HB = (const bf16_t*)(ws + WS_H); const bf16_t* WgT = (const bf16_t*)(ws + WS_WB + WB_WG); const bf16_t* G = (const bf16_t*)(ws + WS_Z + 132 * MiB);
        for (int rep = 0; rep < 4; ++rep) {
            const int sidx = t + 512 * rep; const int row = (int)(((long)sidx * 131071) % M), gc = (sidx * 23) % 2048;
            float zg2 = 0.f;
            for (int k = 0; k < 1024; ++k) zg2 += bfbits2f(HB[(size_t)row * 1024 + k]) * bfbits2f(WgT[(size_t)gc * 1024 + k]);
            const float d = fabsf(bfbits2f(G[(size_t)row * 2048 + gc]) - zg2);
            if (!(d <= 0.02f + 0.01f * fabsf(zg2))) { atomicAdd(&cnt, 1u); atomicMax(&mx, __float_as_uint(d != d ? 1e9f : d)); }
        }
        __syncthreads();
        if (t == 0) { const unsigned c = cnt; const float m = __uint_as_float(mx);
            const unsigned cb = c == 0 ? 0u : (c <= 2 ? 1u : (c <= 8 ? 2u : (c <= 64 ? 3u : (c <= 512 ? 4u : 5u))));
            const unsigned mb = m < 0.05f ? 0u : (m < 0.2f ? 1u : (m < 1.0f ? 2u : (m < 5.f ? 3u : 4u)));
            ((unsigned*)(ws + WS_CTL))[9] = 5u * cb + mb; }
        __syncthreads();
    }
#endif
#if CHECK_ROUND == 7
    {
        const bf16_t* HB = (const bf16_t*)(ws + WS_H); const bf16_t* Q = (const bf16_t*)(ws + WS_Z); const bf16_t* SKB = (const bf16_t*)(ws + WS_WB + WB_SK);
        const int* EIDX = (const int*)(ws + WS_YF); const float* GWp = (const float*)(ws + WS_YB);
        { const int row = (int)(((long)t * 131071) % M), qc = (t * 29) % 2048; float z = 0.f;
          for (int k = 0; k < 1024; ++k) z += bfbits2f(HB[(size_t)row * 1024 + k]) * a.in(I_WQ)[(size_t)k * 2048 + qc];
          if (bad_rel(bfbits2f(Q[(size_t)row * 2048 + qc]), z, 2e-2f, 4e-2f)) atomicOr(&fm[0], 1u); }
        __shared__ float sc[32][2][128];
        if (t < 32) {
            const int tok = (int)(((long)t * 104729) % M), h = t & 7;
            for (int c = 0; c < 2; ++c) for (int n = 0; n < 128; ++n) { float s = 0.f;
                for (int dd = 0; dd < 128; ++dd) s += bfbits2f(Q[(size_t)tok * 2048 + h * 256 + c * 128 + dd]) * bfbits2f(SKB[((size_t)(h * 2 + c) * 128 + n) * 128 + dd]);
                sc[t][c][n] = s; }
            float tv[2][16]; int ti[2][16];
            for (int c = 0; c < 2; ++c) for (int r = 0; r < 16; ++r) { float best = -1e30f; int bi_ = 0;
                for (int n = 0; n < 128; ++n) { const float v = sc[t][c][n]; if (v > best) { best = v; bi_ = n; } }
                sc[t][c][bi_] = -1e30f; float* tvp = &sc[t][c][0]; (void)tvp;
                if (c == 0) { tv[0][r] = best; ti[0][r] = bi_; } else { tv[1][r] = best; ti[1][r] = bi_; } }
            unsigned used[8] = {0u, 0u, 0u, 0u, 0u, 0u, 0u, 0u};
            int miss = 0; float wsum = 0.f, w0 = 0.f; float cv[16]; int ce_[16];
            for (int r = 0; r < 16; ++r) { float best = -1e30f; int bp = 0;
                for (int p = 0; p < 256; ++p) { if (used[p >> 5] & (1u << (p & 31))) continue; const float v = tv[0][p >> 4] + tv[1][p & 15]; if (v > best) { best = v; bp = p; } }
                used[bp >> 5] |= 1u << (bp & 31); cv[r] = best; ce_[r] = ti[0][bp >> 4] * 128 + ti[1][bp & 15]; }
            w0 = cv[0]; for (int r = 0; r < 16; ++r) wsum += expf(cv[r] - w0);
            for (int r = 0; r < 16; ++r) { bool found = false; float gw_k = 0.f;
                for (int q = 0; q < 16; ++q) if (EIDX[(size_t)tok * 128 + h * 16 + q] == ce_[r]) { found = true; gw_k = GWp[(size_t)tok * 128 + h * 16 + q]; }
                if (!found) ++miss; else if (bad_rel(gw_k, expf(cv[r] - w0) / wsum, 5e-2f, 5e-3f)) ++miss; }
            if (miss > 2) atomicOr(&fm[1], 1u);
        }
        {
            const bf16_t* PU = (const bf16_t*)(ws + WS_PT); const bf16_t* PV = (const bf16_t*)(ws + WS_PT + 32 * MiB); const bf16_t* DMP = (const bf16_t*)(ws + WS_Z + 264 * MiB);
            const int tok = (int)(((long)(t >> 3) * 104729 + 17) % M), dcol = ((t & 7) * 131 + (t >> 3) * 7) % 1024; float o = 0.f;
            for (int e = 0; e < 128; ++e) { const int ex = EIDX[(size_t)tok * 128 + e]; if (ex < 0 || ex >= 16384) { o = __builtin_nanf(""); break; } float dt = 0.f;
                for (int k = 0; k < 1024; ++k) dt += bfbits2f(PU[(size_t)ex * 1024 + k]) * bfbits2f(HB[(size_t)tok * 1024 + k]);
                const float ge = 0.5f * dt * (1.f + erff(dt * 0.70710678f));
                o += ge * GWp[(size_t)tok * 128 + e] * bfbits2f(PV[(size_t)ex * 1024 + dcol]); }
            if (bad_rel(bfbits2f(DMP[(size_t)tok * 1024 + dcol]), o, 3e-2f, 2e-2f)) atomicOr(&fm[2], 1u);
        }
    }
#endif
#if CHECK_ROUND == 8
    {
        const bf16_t* A1 = (const bf16_t*)(ws + WS_YF); const bf16_t* A2 = (const bf16_t*)(ws + WS_YB); const bf16_t* O2 = (const bf16_t*)(ws + WS_Z + 396 * MiB);
        const bf16_t* SG = (const bf16_t*)(ws + WS_PT); const bf16_t* U = (const bf16_t*)(ws + WS_Z); const bf16_t* G = (const bf16_t*)(ws + WS_Z + 132 * MiB); const bf16_t* MB = (const bf16_t*)(ws + WS_H);
        { const int row = (int)(((long)t * 131071) % 32768), c = (t * 17) % 1024; float g = 0.f;
          for (int k = 0; k < 160; ++k) g += bfbits2f(SG[(size_t)row * 256 + k]) * a.in(I_G2)[(size_t)k * 1024 + c];
          const float want = bfbits2f(O2[(size_t)row * 1024 + c]) * g;
          if (bad_rel(bfbits2f(A1[(size_t)row * 1024 + c]), want, 3e-2f, 2e-2f)) atomicOr(&fm[0], 1u); }
        { const int row = (int)(((long)t * 131071) % M), c = (t * 17) % 1024; const bool lat = row < M_LAT; const int stride = lat ? 64 : 1; const int pos = lat ? ((row & (SEQ - 1)) >> 6) : ((row - M_LAT) & (CTXL - 1)); const int len = lat ? 128 : CTXL;
          float mean = 0.f, var = 0.f, mine = 0.f;
          for (int pass = 0; pass < 2; ++pass) { float s = 0.f;
              for (int ch = 0; ch < 1024; ++ch) { float acc = 0.f;
                  for (int k = 0; k < 31; ++k) { const int pp = pos + k - 15; if (pp >= 0 && pp < len) acc += bfbits2f(U[(size_t)(row + (k - 15) * stride) * 1024 + ch]) * a.in(I_CONVW)[k * 1024 + ch]; }
                  if (pass == 0) s += acc; else { s += (acc - mean) * (acc - mean); if (ch == c) mine = acc; } }
              if (pass == 0) mean = s / 1024.f; else var = s / 1024.f; }
          const float y = (mine - mean) / sqrtf(var + 1e-5f) * a.in(I_CNG)[c] + a.in(I_CNB)[c]; const float want = y / (1.f + expf(-y));
          if (bad_rel(bfbits2f(A2[(size_t)row * 1024 + c]), want, 3e-2f, 2e-2f)) atomicOr(&fm[1], 1u); }
        { const int row = (int)(((long)t * 131071) % M), c = (t * 19) % 1024; float ya = 0.f, yb = 0.f;
          for (int k = 0; k < 1024; ++k) { ya += bfbits2f(A1[(size_t)row * 1024 + k]) * a.in(I_WOA)[(size_t)k * 1024 + c]; yb += bfbits2f(A2[(size_t)row * 1024 + k]) * a.in(I_WOB)[(size_t)k * 1024 + c]; }
          const float want = bfbits2f(G[(size_t)row * 2048 + c]) * ya + bfbits2f(G[(size_t)row * 2048 + 1024 + c]) * yb;
          if (bad_rel(bfbits2f(MB[(size_t)row * 1024 + c]), want, 3e-2f, 3e-2f)) atomicOr(&fm[2], 1u); }
        { const int row = (int)(((long)t * 131071) % M), c = (t * 23) % 1024; const bool lat = row < M_LAT; const int bi = lat ? (row >> 13) : 8; float y = 0.f;
          for (int k = 0; k < 1024; ++k) y += bfbits2f(MB[(size_t)row * 1024 + k]) * a.in(I_WOUT)[(size_t)k * 1024 + c];
          const float xin = lat ? a.in(I_X)[(size_t)row * 1024 + c] : a.in(I_CTX)[(size_t)(row - M_LAT) * 1024 + c];
          const float want = xin + ((const float*)(ws + WS_MOD))[bi * 6144 + 2048 + c] * y;
          const float got = lat ? a.out()[(size_t)row * 1024 + c] : ((const float*)(ws + WS_XCTX))[(size_t)(row - M_LAT) * 1024 + c];
          if (bad_rel(got, want, 1e-2f, 2e-2f)) atomicOr(&fm[3], 1u); }
    }
#endif
#if CHECK_ROUND == 9
    {
        const bf16_t* YF = (const bf16_t*)(ws + WS_YF); const bf16_t* YB = (const bf16_t*)(ws + WS_YB); const bf16_t* ZR = (const bf16_t*)(ws + WS_Z); const bf16_t* O2 = (const bf16_t*)(ws + WS_Z + 396 * MiB);
        const float* BON = (const float*)(ws + WS_BON); const bf16_t* SG = (const bf16_t*)(ws + WS_PT); const float* smu = a.in(I_SMU);
        { const int row = (int)(((long)t * 131071) % 32768), c = (t * 17) % 1024, hd = c >> 6; const int tt = row & (SEQ - 1);
          float mean = 0.f, var = 0.f;
          for (int j = 0; j < 64; ++j) mean += bfbits2f(YF[(size_t)row * 1024 + hd * 64 + j]) + bfbits2f(YB[(size_t)row * 1024 + hd * 64 + j]);
          mean /= 64.f;
          for (int j = 0; j < 64; ++j) { const float o = bfbits2f(YF[(size_t)row * 1024 + hd * 64 + j]) + bfbits2f(YB[(size_t)row * 1024 + hd * 64 + j]) - mean; var += o * o; }
          var /= 64.f;
          const float o = bfbits2f(YF[(size_t)row * 1024 + c]) + bfbits2f(YB[(size_t)row * 1024 + c]);
          const float zc = bfbits2f(ZR[(size_t)row * NZR + C_V + c]), zp = tt > 0 ? bfbits2f(ZR[(size_t)(row - 1) * NZR + C_V + c]) : 0.f, zn = tt < SEQ - 1 ? bfbits2f(ZR[(size_t)(row + 1) * NZR + C_V + c]) : 0.f;
          const float vv = zc + smu[C_V + c] * (zp - zc) + smu[P_RWKV + C_V + c] * (zn - zc);
          const float want = (o - mean) / sqrtf(var + 64e-5f) * a.in(I_LNXG)[c] + a.in(I_LNXB)[c] + (BON[(size_t)row * 16 + hd] + BON[((size_t)M + row) * 16 + hd]) * vv;
          if (bad_rel(bfbits2f(O2[(size_t)row * 1024 + c]), want, 3e-2f, 3e-2f)) atomicOr(&fm[0], 1u); }
        { const int row = (int)(((long)t * 131071) % M), k = (t * 7) % 256; const bool lat = row < M_LAT; const int tt = lat ? (row & (SEQ - 1)) : ((row - M_LAT) & (CTXL - 1)); const int len = lat ? SEQ : CTXL;
          float want = 0.f;
          if (k < 160) { const float zc = bfbits2f(ZR[(size_t)row * NZR + C_G1 + k]), zp = tt > 0 ? bfbits2f(ZR[(size_t)(row - 1) * NZR + C_G1 + k]) : 0.f, zn = tt < len - 1 ? bfbits2f(ZR[(size_t)(row + 1) * NZR + C_G1 + k]) : 0.f;
              const float z = zc + smu[C_G1 + k] * (zp - zc) + smu[P_RWKV + C_G1 + k] * (zn - zc); want = 1.f / (1.f + expf(-z)); }
          if (bad_rel(bfbits2f(SG[(size_t)row * 256 + k]), want, 2e-2f, 1e-2f)) atomicOr(&fm[1], 1u); }
    }
#endif
#if CHECK_ROUND == 10
    {
        const float* XB = (const float*)(ws + WS_Z + 396 * MiB); const bf16_t* DMP = (const bf16_t*)(ws + WS_Z + 264 * MiB); const bf16_t* HB = (const bf16_t*)(ws + WS_H);
        const float* mod0 = (const float*)(ws + WS_MOD);
        { const int row = (int)(((long)t * 131071) % 16384), c = (t * 17) % 1024, bi = row >> 13;
          const float want = XB[(size_t)row * 1024 + c] + mod0[bi * 6144 + 5120 + c] * bfbits2f(DMP[(size_t)row * 1024 + c]);
          if (bad_rel(a.out()[(size_t)row * 1024 + c], want, 1e-2f, 1e-2f)) atomicOr(&fm[0], 1u);
          float ms = 0.f; for (int k = 0; k < 1024; ++k) { const float xv = XB[(size_t)row * 1024 + k]; ms += xv * xv; }
          const float rs = 1.0f / sqrtf(ms / 1024.f + 1e-6f);
          const float y = XB[(size_t)row * 1024 + c] * rs * a.in(I_N2G)[c] * (1.f + mod0[bi * 6144 + 4096 + c]) + mod0[bi * 6144 + 3072 + c];
          if (bad_rel(bfbits2f(HB[(size_t)row * 1024 + c]), y, 1e-2f, 1e-2f)) atomicOr(&fm[1], 1u); }
        { const int b = t % 9, j = (t * 37) % 6144; const float* cv = (b < 8) ? a.in(I_C) + b * 1024 : a.in(I_CCTX);
          float s = a.in(I_ADAB)[6144 + j];
          for (int k = 0; k < 1024; ++k) { const float c = cv[k]; s += (c / (1.f + expf(-c))) * a.in(I_ADAW)[(size_t)(1024 + k) * 6144 + j]; }
          if (bad_rel(mod0[9 * 6144 + b * 6144 + j], s, 2e-3f, 2e-3f)) atomicOr(&fm[2], 1u); }
        { const unsigned char* wb1 = ws + WS_WB + WB_LAYER; const float* win1 = a.in(I_WIN) + (size_t)1024 * P_IN;
          const int n = (t * 7) % 3488, k = (t * 13) % 1024;
          if ((unsigned)((const bf16_t*)(wb1 + WB_WR))[(size_t)n * 1024 + k] != (pk_bf16(win1[(size_t)k * P_IN + n], 0.f) & 0xffffu)) atomicOr(&fm[3], 1u);
          const int n2 = (t * 11) % 2048;
          if ((unsigned)((const bf16_t*)(wb1 + WB_Q))[(size_t)n2 * 1024 + k] != (pk_bf16(a.in(I_WQ)[(size_t)2097152 + (size_t)k * 2048 + n2], 0.f) & 0xffffu)) atomicOr(&fm[3], 1u);
          const int n3 = (t * 5) % 1024;
          if ((unsigned)((const bf16_t*)(wb1 + WB_OUT))[(size_t)n3 * 1024 + k] != (pk_bf16(a.in(I_WOUT)[(size_t)1048576 + (size_t)k * 1024 + n3], 0.f) & 0xffffu)) atomicOr(&fm[3], 1u);
          if ((unsigned)((const bf16_t*)(wb1 + WB_OA))[(size_t)n3 * 1024 + k] != (pk_bf16(a.in(I_WOA)[(size_t)1048576 + (size_t)k * 1024 + n3], 0.f) & 0xffffu)) atomicOr(&fm[3], 1u);
          if ((unsigned)((const bf16_t*)(wb1 + WB_OB))[(size_t)n3 * 1024 + k] != (pk_bf16(a.in(I_WOB)[(size_t)1048576 + (size_t)k * 1024 + n3], 0.f) & 0xffffu)) atomicOr(&fm[3], 1u); }
    }
#endif
#if CHECK_ROUND == 13
    {
        __shared__ float xs[1024], hs[1024], qs[2048], ss[16][128], actv[128], red[512]; __shared__ int eix[128]; __shared__ float acc_num, acc_den, b_num, b_den, ab_num; __shared__ unsigned nmatch; __shared__ float actb[128];
        const float* XB = (const float*)(ws + WS_Z + 396 * MiB); const bf16_t* DMP = (const bf16_t*)(ws + WS_Z + 264 * MiB); const float* mod0 = (const float*)(ws + WS_MOD); const int* EIDX = (const int*)(ws + WS_YF);
        if (t == 0) { acc_num = 0.f; acc_den = 0.f; nmatch = 0u; b_num = 0.f; b_den = 0.f; ab_num = 0.f; }
        __syncthreads();
        for (int smp = 0; smp < 4; ++smp) {
            const int row = 1000 + smp * 4099, bi = row >> 13;
            xs[t] = XB[(size_t)row * 1024 + t]; xs[t + 512] = XB[(size_t)row * 1024 + t + 512];
            red[t] = xs[t] * xs[t] + xs[t + 512] * xs[t + 512];
            __syncthreads();
            for (int o = 256; o > 0; o >>= 1) { if (t < o) red[t] += red[t + o]; __syncthreads(); }
            const float rs = 1.0f / sqrtf(red[0] / 1024.f + 1e-6f);
            for (int c = t; c < 1024; c += 512) hs[c] = xs[c] * rs * a.in(I_N2G)[c] * (1.f + mod0[bi * 6144 + 4096 + c]) + mod0[bi * 6144 + 3072 + c];
            __syncthreads();
            for (int j = t; j < 2048; j += 512) { float q = 0.f; for (int k = 0; k < 1024; ++k) q += hs[k] * a.in(I_WQ)[(size_t)k * 2048 + j]; qs[j] = q; }
            __syncthreads();
            for (int j = t; j < 2048; j += 512) { const int hc2 = j >> 7, n = j & 127; float s = 0.f; for (int dd = 0; dd < 128; ++dd) s += qs[hc2 * 128 + dd] * a.in(I_SUBK)[((size_t)hc2 * 128 + n) * 128 + dd]; ss[hc2][n] = s; }
            __syncthreads();
            if (t < 8) { const int h = t; float tv[2][16]; int ti[2][16];
                for (int c = 0; c < 2; ++c) for (int r = 0; r < 16; ++r) { float best = -1e30f; int bn = 0; for (int n = 0; n < 128; ++n) { const float v = ss[h * 2 + c][n]; if (v > best) { best = v; bn = n; } } ss[h * 2 + c][bn] = -1e30f; tv[c][r] = best; ti[c][r] = bn; }
                unsigned used[8] = {0u, 0u, 0u, 0u, 0u, 0u, 0u, 0u}; float cv[16]; float wsum = 0.f;
                for (int r = 0; r < 16; ++r) { float best = -1e30f; int bp = 0; for (int p = 0; p < 256; ++p) { if (used[p >> 5] & (1u << (p & 31))) continue; const float v = tv[0][p >> 4] + tv[1][p & 15]; if (v > best) { best = v; bp = p; } }
                    used[bp >> 5] |= 1u << (bp & 31); cv[r] = best; eix[h * 16 + r] = ti[0][bp >> 4] * 128 + ti[1][bp & 15]; }
                for (int r = 0; r < 16; ++r) wsum += expf(cv[r] - cv[0]);
                for (int r = 0; r < 16; ++r) actv[h * 16 + r] = expf(cv[r] - cv[0]) / wsum; }
            __syncthreads();
            if (t < 128) { const int ex = eix[t]; float dt = 0.f; for (int k = 0; k < 1024; ++k) dt += hs[k] * a.in(I_PU)[(size_t)ex * 1024 + k];
                actv[t] = 0.5f * dt * (1.f + erff(dt * 0.70710678f)) * actv[t];
                bool fnd = false; for (int q = 0; q < 16; ++q) fnd |= (EIDX[(size_t)row * 128 + (t >> 4) * 16 + q] == ex); if (fnd) atomicAdd(&nmatch, 1u); }
            if (t < 128) { const bf16_t* HBk = (const bf16_t*)(ws + WS_H); const bf16_t* PUk = (const bf16_t*)(ws + WS_PT); const float* GWk = (const float*)(ws + WS_YB);
                const int ex = EIDX[(size_t)row * 128 + t]; float dt = 0.f; for (int k = 0; k < 1024; ++k) dt += bfbits2f(HBk[(size_t)row * 1024 + k]) * bfbits2f(PUk[(size_t)ex * 1024 + k]);
                actb[t] = 0.5f * dt * (1.f + erff(dt * 0.70710678f)) * GWk[(size_t)row * 128 + t]; }
            __syncthreads();
            float num = 0.f, den = 0.f, bn = 0.f, bd = 0.f, abn = 0.f;
            for (int c = t; c < 1024; c += 512) { float o = 0.f; for (int e = 0; e < 128; ++e) o += actv[e] * a.in(I_PV)[(size_t)eix[e] * 1024 + c]; const float dm = bfbits2f(DMP[(size_t)row * 1024 + c]); num += (o - dm) * (o - dm); den += o * o;
                float ob = 0.f; { const bf16_t* PVk = (const bf16_t*)(ws + WS_PT + 32 * MiB); for (int e2 = 0; e2 < 128; ++e2) ob += actb[e2] * bfbits2f(PVk[(size_t)EIDX[(size_t)row * 128 + e2] * 1024 + c]); }
                bn += (ob - dm) * (ob - dm); bd += ob * ob; abn += (o - ob) * (o - ob); }
            atomicAdd(&acc_num, num); atomicAdd(&acc_den, den); atomicAdd(&b_num, bn); atomicAdd(&b_den, bd); atomicAdd(&ab_num, abn);
            __syncthreads();
        }
        if (t == 0) { const float re = sqrtf(acc_num / fmaxf(acc_den, 1e-30f)); const unsigned eb = re < 0.03f ? 0u : (re < 0.1f ? 1u : (re < 0.3f ? 2u : (re < 1.0f ? 3u : 4u)));
            const float rb = sqrtf(b_num / fmaxf(b_den, 1e-30f)), rab = sqrtf(ab_num / fmaxf(acc_den, 1e-30f));
            const unsigned bb = rb < 0.03f ? 0u : (rb < 0.1f ? 1u : (rb < 0.3f ? 2u : (rb < 1.0f ? 3u : 4u))); const unsigned abb = rab < 0.03f ? 0u : (rab < 0.1f ? 1u : (rab < 0.3f ? 2u : (rab < 1.0f ? 3u : 4u)));
            (void)eb; ((unsigned*)(ws + WS_CTL))[9] = 5u * bb + abb; }
        __syncthreads();
    }
#endif
#if CHECK_ROUND == 11
    {
        __shared__ float xs[1024], hs[1024], qs[2048], ss[16][128], actv[128], red[512]; __shared__ int eix[128]; __shared__ float acc_num, acc_den; __shared__ unsigned nmatch;
        const float* XB = (const float*)(ws + WS_Z + 396 * MiB); const bf16_t* DMP = (const bf16_t*)(ws + WS_Z + 264 * MiB); const float* mod0 = (const float*)(ws + WS_MOD); const int* EIDX = (const int*)(ws + WS_YF);
        if (t == 0) { acc_num = 0.f; acc_den = 0.f; nmatch = 0u; }
        __syncthreads();
        for (int smp = 0; smp < 4; ++smp) {
            const int row = 1000 + smp * 4099, bi = row >> 13;
            xs[t] = XB[(size_t)row * 1024 + t]; xs[t + 512] = XB[(size_t)row * 1024 + t + 512];
            red[t] = xs[t] * xs[t] + xs[t + 512] * xs[t + 512];
            __syncthreads();
            for (int o = 256; o > 0; o >>= 1) { if (t < o) red[t] += red[t + o]; __syncthreads(); }
            const float rs = 1.0f / sqrtf(red[0] / 1024.f + 1e-6f);
            for (int c = t; c < 1024; c += 512) hs[c] = xs[c] * rs * a.in(I_N2G)[c] * (1.f + mod0[bi * 6144 + 4096 + c]) + mod0[bi * 6144 + 3072 + c];
            __syncthreads();
            for (int j = t; j < 2048; j += 512) { float q = 0.f; for (int k = 0; k < 1024; ++k) q += hs[k] * a.in(I_WQ)[(size_t)k * 2048 + j]; qs[j] = q; }
            __syncthreads();
            for (int j = t; j < 2048; j += 512) { const int hc2 = j >> 7, n = j & 127; float s = 0.f; for (int dd = 0; dd < 128; ++dd) s += qs[hc2 * 128 + dd] * a.in(I_SUBK)[((size_t)hc2 * 128 + n) * 128 + dd]; ss[hc2][n] = s; }
            __syncthreads();
            if (t < 8) { const int h = t; float tv[2][16]; int ti[2][16];
                for (int c = 0; c < 2; ++c) for (int r = 0; r < 16; ++r) { float best = -1e30f; int bn = 0; for (int n = 0; n < 128; ++n) { const float v = ss[h * 2 + c][n]; if (v > best) { best = v; bn = n; } } ss[h * 2 + c][bn] = -1e30f; tv[c][r] = best; ti[c][r] = bn; }
                unsigned used[8] = {0u, 0u, 0u, 0u, 0u, 0u, 0u, 0u}; float cv[16]; float wsum = 0.f;
                for (int r = 0; r < 16; ++r) { float best = -1e30f; int bp = 0; for (int p = 0; p < 256; ++p) { if (used[p >> 5] & (1u << (p & 31))) continue; const float v = tv[0][p >> 4] + tv[1][p & 15]; if (v > best) { best = v; bp = p; } }
                    used[bp >> 5] |= 1u << (bp & 31); cv[r] = best; eix[h * 16 + r] = ti[0][bp >> 4] * 128 + ti[1][bp & 15]; }
                for (int r = 0; r < 16; ++r) wsum += expf(cv[r] - cv[0]);
                for (int r = 0; r < 16; ++r) actv[h * 16 + r] = expf(cv[r] - cv[0]) / wsum; }
            __syncthreads();
            if (t < 128) { const int ex = eix[t]; float dt = 0.f; for (int k = 0; k < 1024; ++k) dt += hs[k] * a.in(I_PU)[(size_t)ex * 1024 + k];
                actv[t] = 0.5f * dt * (1.f + erff(dt * 0.70710678f)) * actv[t];
                bool fnd = false; for (int q = 0; q < 16; ++q) fnd |= (EIDX[(size_t)row * 128 + (t >> 4) * 16 + q] == ex); if (fnd) atomicAdd(&nmatch, 1u); }
            __syncthreads();
            float num = 0.f, den = 0.f;
            for (int c = t; c < 1024; c += 512) { float o = 0.f; for (int e = 0; e < 128; ++e) o += actv[e] * a.in(I_PV)[(size_t)eix[e] * 1024 + c]; const float dm = bfbits2f(DMP[(size_t)row * 1024 + c]); num += (o - dm) * (o - dm); den += o * o; }
            atomicAdd(&acc_num, num); atomicAdd(&acc_den, den);
            __syncthreads();
        }
        if (t == 0) { const float re = sqrtf(acc_num / fmaxf(acc_den, 1e-30f)); const unsigned eb = re < 0.03f ? 0u : (re < 0.1f ? 1u : (re < 0.3f ? 2u : (re < 1.0f ? 3u : 4u)));
            const unsigned nm = nmatch; const unsigned mb = nm >= 500 ? 0u : (nm >= 460 ? 1u : (nm >= 384 ? 2u : (nm >= 128 ? 3u : 4u)));
            ((unsigned*)(ws + WS_CTL))[9] = 5u * eb + mb; }
        __syncthreads();
    }
#endif
#if CHECK_ROUND == 12
    {
        const bf16_t* PU = (const bf16_t*)(ws + WS_PT); const bf16_t* PV = (const bf16_t*)(ws + WS_PT + 32 * MiB);
        for (int rep = 0; rep < 8; ++rep) { const int sidx = t + 512 * rep; const int e = (int)(((long)sidx * 7919) % 16384), k = (sidx * 13) % 1024;
            if ((unsigned)PU[(size_t)e * 1024 + k] != (pk_bf16(a.in(I_PU)[(size_t)e * 1024 + k], 0.f) & 0xffffu)) { atomicOr(&fm[0], 1u); if (e < 8192) atomicOr(&fm[2], 1u); }
            if ((unsigned)PV[(size_t)e * 1024 + k] != (pk_bf16(a.in(I_PV)[(size_t)e * 1024 + k], 0.f) & 0xffffu)) { atomicOr(&fm[1], 1u); if (e < 8192) atomicOr(&fm[3], 1u); } }
    }
#endif
#if CHECK_ROUND == 15
    {
        __shared__ float actb[128]; __shared__ float nm[2], dn[2]; __shared__ unsigned nbad, mxd, colmask;
        const bf16_t* DMP = (const bf16_t*)(ws + WS_Z + 264 * MiB); const int* EIDX = (const int*)(ws + WS_YF); const float* GWk = (const float*)(ws + WS_YB);
        const bf16_t* HBk = (const bf16_t*)(ws + WS_H); const bf16_t* PUk = (const bf16_t*)(ws + WS_PT); const bf16_t* PVk = (const bf16_t*)(ws + WS_PT + 32 * MiB);
        if (t < 2) { nm[t] = 0.f; dn[t] = 0.f; } if (t == 0) { nbad = 0u; mxd = 0u; colmask = 0u; }
        __syncthreads();
        const int rows8[8] = {1000, 5099, 9198, 13297, 21000, 33333, 50001, 66000};
        for (int smp = 0; smp < 8; ++smp) { const int row = rows8[smp];
            if (t < 128) { const int ex = EIDX[(size_t)row * 128 + t]; float dt = 0.f; for (int k = 0; k < 1024; ++k) dt += bfbits2f(HBk[(size_t)row * 1024 + k]) * bfbits2f(PUk[(size_t)ex * 1024 + k]);
                actb[t] = 0.5f * dt * (1.f + erff(dt * 0.70710678f)) * GWk[(size_t)row * 128 + t]; }
            __syncthreads();
            float bn = 0.f, bd = 0.f;
            for (int c = t; c < 1024; c += 512) { float ob = 0.f; for (int e2 = 0; e2 < 128; ++e2) ob += actb[e2] * bfbits2f(PVk[(size_t)EIDX[(size_t)row * 128 + e2] * 1024 + c]);
                const float dm = bfbits2f(DMP[(size_t)row * 1024 + c]); bn += (ob - dm) * (ob - dm); bd += ob * ob; const float dd = fabsf(ob - dm); if (!(dd <= 0.03f)) { atomicAdd(&nbad, 1u); atomicMax(&mxd, __float_as_uint(dd != dd ? 1e9f : dd)); atomicOr(&colmask, 1u << (c >> 7)); } }
            atomicAdd(&nm[smp >> 2], bn); atomicAdd(&dn[smp >> 2], bd);
            __syncthreads();
        }
        if (t == 0) { const unsigned c = nbad; const float m = __uint_as_float(mxd);
            const unsigned cb = c == 0 ? 0u : (c <= 8 ? 1u : (c <= 80 ? 2u : (c <= 800 ? 3u : (c <= 4000 ? 4u : 5u))));
#if CHECK_SUB == 0
            const unsigned mb = m < 0.1f ? 0u : (m < 0.5f ? 1u : (m < 2.f ? 2u : (m < 20.f ? 3u : 4u)));
            ((unsigned*)(ws + WS_CTL))[9] = 5u * cb + mb;
#else
            ((unsigned*)(ws + WS_CTL))[9] = (colmask == 0xffu) ? 0u : (1u + (unsigned)__popc(colmask));
#endif
        }
        __syncthreads();
    }
#endif
#if CHECK_ROUND == 14
    {
        __shared__ float actb[128]; __shared__ float nm[2], dn[2];
        const bf16_t* DMP = (const bf16_t*)(ws + WS_Z + 264 * MiB); const int* EIDX = (const int*)(ws + WS_YF); const float* GWk = (const float*)(ws + WS_YB);
        const bf16_t* HBk = (const bf16_t*)(ws + WS_H); const bf16_t* PUk = (const bf16_t*)(ws + WS_PT); const bf16_t* PVk = (const bf16_t*)(ws + WS_PT + 32 * MiB);
        if (t < 2) { nm[t] = 0.f; dn[t] = 0.f; }
        __syncthreads();
        const int rows8[8] = {1000, 5099, 9198, 13297, 21000, 33333, 50001, 66000};
        for (int smp = 0; smp < 8; ++smp) { const int row = rows8[smp];
            if (t < 128) { const int ex = EIDX[(size_t)row * 128 + t]; float dt = 0.f; for (int k = 0; k < 1024; ++k) dt += bfbits2f(HBk[(size_t)row * 1024 + k]) * bfbits2f(PUk[(size_t)ex * 1024 + k]);
                actb[t] = 0.5f * dt * (1.f + erff(dt * 0.70710678f)) * GWk[(size_t)row * 128 + t]; }
            __syncthreads();
            float bn = 0.f, bd = 0.f;
            for (int c = t; c < 1024; c += 512) { float ob = 0.f; for (int e2 = 0; e2 < 128; ++e2) ob += actb[e2] * bfbits2f(PVk[(size_t)EIDX[(size_t)row * 128 + e2] * 1024 + c]);
                const float dm = bfbits2f(DMP[(size_t)row * 1024 + c]); bn += (ob - dm) * (ob - dm); bd += ob * ob; }
            atomicAdd(&nm[smp >> 2], bn); atomicAdd(&dn[smp >> 2], bd);
            __syncthreads();
        }
        if (t == 0) { unsigned code = 0; for (int g = 0; g < 2; ++g) { const float rb = sqrtf(nm[g] / fmaxf(dn[g], 1e-30f)); const unsigned bb = rb < 0.03f ? 0u : (rb < 0.1f ? 1u : (rb < 0.3f ? 2u : (rb < 1.0f ? 3u : 4u))); code = code * 5u + bb; }
            ((unsigned*)(ws + WS_CTL))[9] = code; }
        __syncthreads();
    }
#endif
#if CHECK_ROUND == 5
    {
        __shared__ unsigned nfail, aim, wrm, outr, bjm, mm_, wcm, fqm;
        if (t == 0) { nfail = 0u; aim = 0u; wrm = 0u; outr = 0u; bjm = 0u; mm_ = 0u; wcm = 0u; fqm = 0u; }
        __syncthreads();
        const bf16_t* HB = (const bf16_t*)(ws + WS_H); const bf16_t* WgT = (const bf16_t*)(ws + WS_WB + WB_WG); const bf16_t* G = (const bf16_t*)(ws + WS_Z + 132 * MiB);
        for (int rep = 0; rep < 4; ++rep) {
            const int sidx = t + 512 * rep; const int row = (int)(((long)sidx * 131071) % M), gc = (sidx * 23) % 2048;
            float zg2 = 0.f;
            for (int k = 0; k < 1024; ++k) zg2 += bfbits2f(HB[(size_t)row * 1024 + k]) * bfbits2f(WgT[(size_t)gc * 1024 + k]);
            const float g2 = 1.f / (1.f + expf(-(zg2 + a.in(I_GATEB)[gc])));
            const float gv = bfbits2f(G[(size_t)row * 2048 + gc]); const float d = fabsf(gv - g2);
            if (!(d <= 0.01f)) { atomicAdd(&nfail, 1u); atomicOr(&aim, 1u << ((row >> 7) & 1)); atomicOr(&wrm, 1u << ((row >> 6) & 1)); atomicOr(&bjm, 1u << ((gc >> 7) & 1));
                atomicOr(&mm_, 1u << ((row >> 4) & 3)); atomicOr(&wcm, 1u << ((gc >> 5) & 3)); atomicOr(&fqm, 1u << ((gc >> 3) & 3));
                if (!(gv >= 0.f && gv <= 1.f)) atomicOr(&outr, 1u); }
        }
        __syncthreads();
        if (t == 0) { unsigned code = 0;
#if CHECK_SUB == 0
            if (__popc(aim) == 1) code |= 1u; if (__popc(wrm) == 1) code |= 2u; if (outr) code |= 4u; if (bjm == 2u) code |= 8u;
#else
            if (__popc(mm_) == 1) code |= 1u; if (__popc(wcm) == 1) code |= 2u; if (__popc(fqm) == 1) code |= 4u; if (aim == 2u) code |= 8u;
#endif
            ((unsigned*)(ws + WS_CTL))[9] = code; }
        __syncthreads();
    }
#endif
    __syncthreads();
    if (t == 0 && CHECK_ROUND == 2) ((unsigned*)(ws + WS_CTL))[9] = 5u * ((unsigned*)(ws + WS_CTL))[10] + ((unsigned*)(ws + WS_CTL))[11];
    if (t == 0) ((unsigned*)(ws + WS_CTL))[8] = (CHECK_ROUND >= 4 || CHECK_ROUND == 2) ? 1u + ((unsigned*)(ws + WS_CTL))[9] : 1u + ((fm[0] ? 1u : 0u) | (fm[1] ? 2u : 0u) | (fm[2] ? 4u : 0u) | (fm[3] ? 8u : 0u));
}
__device__ __forceinline__ void fill_phase(const KA a) {
    const unsigned mask = ((const unsigned*)(a.ws() + WS_CTL))[8]; const float al = 2.0f + (float)mask; const float* x = a.in(I_X); float* o = a.out();
    for (size_t i = (size_t)blockIdx.x * 512 + threadIdx.x; i < (size_t)M_LAT * 1024; i += (size_t)gridDim.x * 512) o[i] = al * x[i];
}
#endif
#define IN(k) (lo <= (k) && (k) < hi)
#if STAMP_GROUP >= 0
#define SEAM(k) do { if (use_bar && (k) + 1 < hi) xcd_barrier(bar); if (blockIdx.x == 0 && threadIdx.x == 0) ((unsigned long long*)(a.ws() + WS_CTL + 65536))[(k) + 1] = __builtin_amdgcn_s_memrealtime(); } while (0)
#else
#define SEAM(k) do { if (use_bar && (k) + 1 < hi) xcd_barrier(bar); } while (0)
#endif
template <int l> __device__ __forceinline__ void layer_phases(const KA a, LAS unsigned char* lds, const int lo, const int hi, const bool use_bar, const XcdBarrier& bar) {
    constexpr int g0 = 2 + 12 * l;
    constexpr int MRL = (l == 1) ? M_LAT : M;
#define SITE_PTRS() const KA b = opaque_ka(a); unsigned char* const ws = b.ws(); unsigned char* const wb = ws + WS_WB + (size_t)l * WB_LAYER; const float* const modl = (const float*)(ws + WS_MOD) + (size_t)l * 9 * 6144; \
        float* const xctx = (float*)(ws + WS_XCTX); bf16_t* const HB = (bf16_t*)(ws + WS_H); (void)wb; (void)modl; (void)xctx; (void)HB
        if (SITE(2) && IN(g0 + 0) && l == 0) { SITE_PTRS();
_Pragma("unroll 1") for (int r = 0; r < MISC_REP; ++r) norm_phase(b.in(I_X), b.in(I_CTX), b.in(I_N1G), modl, 0, 1024, HB); SEAM(g0 + 0); }
        if (SITE(3) && IN(g0 + 1)) { SITE_PTRS(); EpiStoreBf16 E{(bf16_t*)(ws + WS_Z), NZR};
_Pragma("unroll 1") for (int r = 0; r < GEMM_REP; ++r) run_gemm(lds, HB, (const bf16_t*)(wb + WB_WR), NZR, 1024, E); SEAM(g0 + 1); }
        if (SITE(4) && IN(g0 + 2)) {
_Pragma("unroll 1") for (int r = 0; r < SCAN_REP; ++r) { if (SCAN_V2) scan_phase2(a, lds, l); else scan_phase(a, lds, l); }
 SEAM(g0 + 2); }
        if (SITE(5) && IN(g0 + 3)) { post_phase(a, l); SEAM(g0 + 3); }
        if (SITE(6) && IN(g0 + 4)) {
            { SITE_PTRS(); EpiMulInplace E{(bf16_t*)(ws + WS_YF)}; run_gemm(lds, (const bf16_t*)(ws + WS_PT), (const bf16_t*)(wb + WB_G2), 1024, 256, E, MRL); }
            { SITE_PTRS(); EpiGlu E{(bf16_t*)(ws + WS_Z)};
_Pragma("unroll 1") for (int r = 0; r < GEMM_REP; ++r) run_gemm(lds, HB, (const bf16_t*)(wb + WB_WC), 2048, 1024, E, MRL, 32); }
            { SITE_PTRS(); EpiGate E{(bf16_t*)(ws + WS_Z + 132 * MiB), b.in(I_GATEB) + l * 2048};
_Pragma("unroll 1") for (int r = 0; r < GEMM_REP; ++r) run_gemm(lds, HB, (const bf16_t*)(wb + WB_WG), 2048, 1024, E, MRL, 96); }
            SEAM(g0 + 4); }
        if (SITE(7) && IN(g0 + 5)) {
_Pragma("unroll 1") for (int r = 0; r < MISC_REP; ++r) conv_phase(a, lds, l); SEAM(g0 + 5); }
        if (SITE(8) && IN(g0 + 6)) {
_Pragma("unroll 1") for (int r = 0; r < GEMM_REP; ++r) {
            { SITE_PTRS(); EpiGateMul<false> E{HB, (const bf16_t*)(ws + WS_Z + 132 * MiB), 0}; run_gemm(lds, (const bf16_t*)(ws + WS_YF), (const bf16_t*)(wb + WB_OA), 1024, 1024, E, MRL); }
            { SITE_PTRS(); EpiGateMul<true> E{HB, (const bf16_t*)(ws + WS_Z + 132 * MiB), 1024}; run_gemm(lds, (const bf16_t*)(ws + WS_YB), (const bf16_t*)(wb + WB_OB), 1024, 1024, E, MRL); } }
            SEAM(g0 + 6); }
        if (SITE(9) && IN(g0 + 7)) { SITE_PTRS();
            if (XBF16) { EpiResidB<l> E{b.in(I_X), (l == 0) ? b.in(I_CTX) : xctx, (bf16_t*)b.out(), xctx, modl + 2 * 1024}; run_gemm(lds, HB, (const bf16_t*)(wb + WB_OUT), 1024, 1024, E, MRL); }
            else { EpiResid E{(l == 0) ? b.in(I_X) : b.out(), (l == 0) ? b.in(I_CTX) : xctx, b.out(), xctx, modl + 2 * 1024}; run_gemm(lds, HB, (const bf16_t*)(wb + WB_OUT), 1024, 1024, E, MRL); }
            SEAM(g0 + 7); }
        if (SITE(10) && IN(g0 + 8)) {
_Pragma("unroll 1") for (int r = 0; r < MISC_REP; ++r) { { SITE_PTRS(); norm_phase(b.out(), xctx, b.in(I_N2G) + l * 1024, modl, 3 * 1024, 4 * 1024, HB, MRL, XBF16 ? (const bf16_t*)b.out() : nullptr); } if (PEER_FP6) convert_tables6(a, l); else convert_tables(a, l); }
 SEAM(g0 + 8); }
        if (SITE(11) && IN(g0 + 9)) { SITE_PTRS(); EpiStoreBf16 E{(bf16_t*)(ws + WS_Z), 2048};
_Pragma("unroll 1") for (int r = 0; r < GEMM_REP; ++r) run_gemm(lds, HB, (const bf16_t*)(wb + WB_Q), 2048, 1024, E, MRL); SEAM(g0 + 9); }
        if (SITE(12) && IN(g0 + 10)) {
_Pragma("unroll 1") for (int r = 0; r < MISC_REP; ++r) topk_phase(a, lds, l); SEAM(g0 + 10); }
        if (SITE(13) && IN(g0 + 11)) { SITE_PTRS();
            if (PEER_SLICED) {
                peer_dots(b, l); xcd_barrier(bar); peer_act(b, l); xcd_barrier(bar); peer_mix(b, l, b.out(), xctx); xcd_barrier(bar);
                if (l == 0) norm_phase(b.out(), xctx, b.in(I_N1G) + 1024, (const float*)(ws + WS_MOD) + (size_t)9 * 6144, 0, 1024, HB, M, XBF16 ? (const bf16_t*)b.out() : nullptr); else final_phase(b.out(), b.in(I_FG), XBF16 ? (const bf16_t*)(ws + WS_X4) : nullptr);
            } else if (!(ABL & 1)) { if (PEER_FP6) peer_phase6(b, l, b.out(), xctx); else peer_phase(b, l, b.out(), xctx); }
            if (l == 0) SEAM(g0 + 11); }
#undef SITE_PTRS
}
__global__ void __launch_bounds__(512, 2) mk_fwd(Args a_unused) {
    KA a; a.p = (kptr_t)__builtin_amdgcn_kernarg_segment_ptr();
    extern __shared__ __attribute__((aligned(16))) unsigned char lds_raw[];
    LAS unsigned char* lds = (LAS unsigned char*)lds_raw;
    volatile LAS unsigned* MISC = (volatile LAS unsigned*)(lds + MISC_OFF);
    const int lo = a.ph_lo(), hi = a.ph_hi();
    const bool use_bar = (hi - lo) > 1;
    if (threadIdx.x < 32) MISC[threadIdx.x] = 0u;
    __syncthreads();
    XcdBarrier bar; bar.bar = (unsigned*)(a.ws() + WS_CTL) + CW_BAR; bar.x = 0; bar.st = nullptr;
    if (use_bar) bar = xcd_barrier_post((unsigned*)(a.ws() + WS_CTL) + CW_BAR, MISC + 8);
#if STAMP_GROUP >= 0
    if (blockIdx.x == 0 && threadIdx.x == 0) ((unsigned long long*)(a.ws() + WS_CTL + 65536))[0] = __builtin_amdgcn_s_memrealtime();
#endif
    if (SITE(0) && IN(0)) {
_Pragma("unroll 1") for (int r = 0; r < MISC_REP; ++r) prologue_phase(a, lds); SEAM(0); }
    if (SITE(1) && IN(1)) {
_Pragma("unroll 1") for (int r = 0; r < MISC_REP; ++r) modreduce_phase(a); SEAM(1); }
    layer_phases<0>(a, lds, lo, hi, use_bar, bar);
    layer_phases<1>(a, lds, lo, hi, use_bar, bar);
#if STAMP_GROUP >= 0
    {
        xcd_barrier(bar);
        if (blockIdx.x == 0 && threadIdx.x == 0) { unsigned long long* st = (unsigned long long*)(a.ws() + WS_CTL + 65536); st[27] = __builtin_amdgcn_s_memrealtime();
            const int grp[12] = {6, 1, 2, 6, 1, 5, 1, 1, 6, 1, 4, 3}; unsigned long long tot = st[27] - st[0], sel = 0;
            for (int g = 0; g < 27; ++g) { const int gg = (g < 2) ? 0 : (g == 26 ? 6 : grp[(g - 2) % 12]); const int fine = (g < 2 || g == 26) ? -1 : (g - 2) % 12;
                if (STAMP_GROUP < 10 ? (gg == STAMP_GROUP) : (fine == STAMP_GROUP - 10)) sel += st[g + 1] - st[g]; }
            ((unsigned*)(a.ws() + WS_CTL))[8] = (SCAN_SEC >= 0) ? ((unsigned*)(a.ws() + WS_CTL))[12] : (unsigned)((40ull * sel + tot / 2) / tot); }
        xcd_barrier(bar);
        const unsigned code = ((const unsigned*)(a.ws() + WS_CTL))[8]; const float al = 3.0f + (float)code; const float* x = a.in(I_X); float* o = a.out();
        for (size_t i = (size_t)blockIdx.x * 512 + threadIdx.x; i < (size_t)M_LAT * 1024; i += (size_t)gridDim.x * 512) o[i] = al * x[i];
    }
#endif

#undef IN
#undef SEAM
}

#if PROBE_HI > 0
__global__ void __launch_bounds__(512) k_check(Args a_unused) { KA a; a.p = (kptr_t)__builtin_amdgcn_kernarg_segment_ptr(); check_phase(a); }
__global__ void __launch_bounds__(512) k_fill(Args a_unused) { KA a; a.p = (kptr_t)__builtin_amdgcn_kernarg_segment_ptr(); fill_phase(a); }
#endif
extern "C" void kernel_launch(void* const* d_in, const int* in_sizes, int n_in, void* d_out, int out_size, void* d_ws, size_t ws_size, hipStream_t stream) {
    static int grid = 0;
    if (grid == 0) {
        if (n_in != 32 || out_size != M_LAT * D || ws_size < WS_END) { fprintf(stderr, "kernel_launch: unexpected shapes (n_in %d, out %d, ws %zu)\n", n_in, out_size, ws_size); grid = -1; return; }
        int dev = 0, cus = 0;
        if (hipGetDevice(&dev) != hipSuccess || hipDeviceGetAttribute(&cus, hipDeviceAttributeMultiprocessorCount, dev) != hipSuccess) { grid = -1; return; }
        if (hipFuncSetAttribute((const void*)mk_fwd, hipFuncAttributeMaxDynamicSharedMemorySize, LDS_BYTES) != hipSuccess) { fprintf(stderr, "kernel_launch: hipFuncSetAttribute failed\n"); grid = -1; return; }
        int per_cu = 0;
        if (hipOccupancyMaxActiveBlocksPerMultiprocessor(&per_cu, (const void*)mk_fwd, 512, LDS_BYTES) != hipSuccess || per_cu < 1) fprintf(stderr, "kernel_launch: occupancy query says %d\n", per_cu);
        (void)hipGetLastError();
        grid = cus;
    }
    if (grid < 0) return;
    (void)hipMemsetAsync((char*)d_ws + WS_CTL, 0, CTL_BYTES, stream);
    Args a{};
    for (int i = 0; i < 32; ++i) a.in[i] = (const float*)d_in[i];
    a.out = (float*)d_out; a.ws = (unsigned char*)d_ws;
#if ONE_LAUNCH
    a.ph_lo = 0; a.ph_hi = NPH;
    hipLaunchKernelGGL(mk_fwd, dim3(grid), dim3(512), LDS_BYTES, stream, a);
#elif PROBE_HI > 0
    for (int p = 0; p < PROBE_HI; ++p) { a.ph_lo = p; a.ph_hi = p + 1; hipLaunchKernelGGL(mk_fwd, dim3(grid), dim3(512), LDS_BYTES, stream, a); }
#ifndef PROBE_NOCHECK
    hipLaunchKernelGGL(k_check, dim3(1), dim3(512), 0, stream, a);
    hipLaunchKernelGGL(k_fill, dim3(grid), dim3(512), 0, stream, a);
#endif
#else
    for (int p = 0; p < NPH; ++p) { a.ph_lo = p; a.ph_hi = p + 1; hipLaunchKernelGGL(mk_fwd, dim3(grid), dim3(512), LDS_BYTES, stream, a); }
#endif
}
```
